# Optimizing an MI355X kernel written in HIP

```python
import jax, jax.numpy as jnp
from jax import lax
import numpy as np

D_MODEL = 1024
BATCH = 8
SEQ = 4096
DEPTH = 2
DEC_BATCH = 1
DEC_SEQ = 16384
PAST_LEN = 128

N_MEM = 256
D_FF = 2816
CONV_DIM = 512
CONV_WIDTH = 31
RET_HEADS = 8
RET_HEAD_DIM = 64
RET_DIM = RET_HEADS * RET_HEAD_DIM
RET_CHUNK = 128
XATTN_HEADS = 4
XATTN_HEAD_DIM = D_MODEL // XATTN_HEADS
ROPE_BASE = 10000.0
NORM_EPS = 1e-6
N_NORMS = 8
IN_COLS = 2 * CONV_DIM + 4 * RET_DIM + 2 * D_MODEL

kernel_name = 'hybrid_conv_retention_encoder'


def rmsnorm(x, g):
    xf = x.astype(jnp.float32)
    y = xf * lax.rsqrt(jnp.mean(xf * xf, axis=-1, keepdims=True) + NORM_EPS)
    return (y * g.astype(jnp.float32)).astype(x.dtype)


def swiglu_ffn(h, w_gu, w_down):
    gate, up = jnp.split(h @ w_gu, 2, axis=-1)
    return (jax.nn.silu(gate) * up) @ w_down


def rotary(x):
    s, dh = x.shape[1], x.shape[-1]
    half = dh // 2
    inv_freq = ROPE_BASE ** (-jnp.arange(half, dtype=jnp.float32) / half)
    ang = jnp.arange(s, dtype=jnp.float32)[:, None] * inv_freq[None, :]
    cos = jnp.cos(ang)[None, :, None, :]
    sin = jnp.sin(ang)[None, :, None, :]
    xf = x.astype(jnp.float32)
    x1, x2 = xf[..., :half], xf[..., half:]
    return jnp.concatenate([x1 * cos - x2 * sin, x1 * sin + x2 * cos], axis=-1)


def retention_direction(q, k, v, decay_param, include_diag):
    b, s, h, dh = q.shape
    c = RET_CHUNK
    n = s // c
    qc = q.reshape(b, n, c, h, dh)
    kc = k.reshape(b, n, c, h, dh)
    vc = v.reshape(b, n, c, h, dh)
    log_gamma = -jnp.exp(decay_param.astype(jnp.float32))
    pos = jnp.arange(c, dtype=jnp.float32)
    rel = pos[:, None] - pos[None, :]
    mask = (rel >= 0) if include_diag else (rel > 0)
    intra_decay = jnp.where(mask[None], jnp.exp(log_gamma[:, None, None] * jnp.where(mask, rel, 0.0)[None]), 0.0)
    scores = jnp.einsum('bnihd,bnjhd->bnhij', qc, kc) * intra_decay[None, None]
    intra = jnp.einsum('bnhij,bnjhd->bnihd', scores, vc)
    k_dec = jnp.exp(log_gamma[None, :] * (c - 1.0 - pos)[:, None])
    chunk_kv = jnp.einsum('bnjhd,bnjhe->nbhde', kc * k_dec[None, None, :, :, None], vc)
    chunk_decay = jnp.exp(log_gamma * c)[None, :, None, None]

    def step(state, kv):
        return state * chunk_decay + kv, state

    _, prev = lax.scan(step, jnp.zeros((b, h, dh, dh), jnp.float32), chunk_kv)
    q_dec = jnp.exp(log_gamma[None, :] * (pos + 1.0)[:, None])
    cross = jnp.einsum('bnihd,nbhde->bnihe', qc * q_dec[None, None, :, :, None], prev)
    return (intra + cross).reshape(b, s, h, dh)


def retention_branch(q, k, v, g, decay_fwd, decay_bwd, gn_g, w_out):
    b, s, _ = q.shape
    shp = (b, s, RET_HEADS, RET_HEAD_DIM)
    qr = rotary(q.reshape(shp))
    kr = rotary(k.reshape(shp)) * (RET_HEAD_DIM ** -0.5)
    vf = v.reshape(shp).astype(jnp.float32)
    fwd = retention_direction(qr, kr, vf, decay_fwd, True)
    bwd = jnp.flip(retention_direction(jnp.flip(qr, 1), jnp.flip(kr, 1), jnp.flip(vf, 1), decay_bwd, False), 1)
    y = fwd + bwd
    mu = jnp.mean(y, axis=-1, keepdims=True)
    var = jnp.mean(jnp.square(y - mu), axis=-1, keepdims=True)
    y = (y - mu) * lax.rsqrt(var + NORM_EPS) * gn_g.astype(jnp.float32).reshape(RET_HEADS, RET_HEAD_DIM)
    y = y.reshape(b, s, RET_DIM).astype(q.dtype)
    return (jax.nn.silu(g) * y) @ w_out


def conformer_conv_branch(a, dw_w, dw_b, ln_g, ln_b, w_pw):
    val, gate = jnp.split(a, 2, axis=-1)
    u = val * jax.nn.sigmoid(gate)
    pad = CONV_WIDTH // 2
    u = lax.conv_general_dilated(u, dw_w[:, None, :].astype(u.dtype), window_strides=(1,), padding=[(pad, pad)],
                                 dimension_numbers=('NWC', 'WIO', 'NWC'), feature_group_count=CONV_DIM) + dw_b
    uf = u.astype(jnp.float32)
    mu = jnp.mean(uf, axis=-1, keepdims=True)
    var = jnp.mean(jnp.square(uf - mu), axis=-1, keepdims=True)
    uf = (uf - mu) * lax.rsqrt(var + NORM_EPS) * ln_g.astype(jnp.float32) + ln_b.astype(jnp.float32)
    return jax.nn.silu(uf).astype(a.dtype) @ w_pw


def memory_cross_attention(h, mem, mem_g, w_q, w_kv, w_o):
    b, s, _ = h.shape
    m = mem.shape[1]
    q = (h @ w_q).reshape(b, s, XATTN_HEADS, XATTN_HEAD_DIM)
    kv = (rmsnorm(mem, mem_g) @ w_kv).reshape(b, m, 2, XATTN_HEADS, XATTN_HEAD_DIM)
    k, v = kv[:, :, 0], kv[:, :, 1]
    logits = jnp.einsum('bshd,bmhd->bhsm', q.astype(jnp.float32), k.astype(jnp.float32)) * (XATTN_HEAD_DIM ** -0.5)
    p = jax.nn.softmax(logits, axis=-1).astype(v.dtype)
    o = jnp.einsum('bhsm,bmhd->bshd', p, v).reshape(b, s, D_MODEL)
    return o @ w_o


def trunk(x, mem, norm_g, ffn1_w_gu, ffn1_w_down, w_in, conv_dw_w, conv_dw_b, conv_ln_g, conv_ln_b, conv_w_pw,
          ret_decay_fwd, ret_decay_bwd, ret_gn_g, ret_w_out, gate_b, w_mix_out, mem_norm_g,
          xattn_w_q, xattn_w_kv, xattn_w_o, ffn2_w_gu, ffn2_w_down):
    splits = [2 * CONV_DIM, 2 * CONV_DIM + RET_DIM, 2 * CONV_DIM + 2 * RET_DIM,
              2 * CONV_DIM + 3 * RET_DIM, 2 * CONV_DIM + 4 * RET_DIM]
    for l in range(DEPTH):
        f = swiglu_ffn(rmsnorm(x, norm_g[l, 0]), ffn1_w_gu[l], ffn1_w_down[l])
        x = x + 0.5 * rmsnorm(f, norm_g[l, 1])
        h = rmsnorm(x, norm_g[l, 2])
        proj = h @ w_in[l]
        conv_in, q, k, v, g, gate_logits = jnp.split(proj, splits, axis=-1)
        conv_out = conformer_conv_branch(conv_in, conv_dw_w[l], conv_dw_b[l], conv_ln_g[l], conv_ln_b[l], conv_w_pw[l])
        ret_out = retention_branch(q, k, v, g, ret_decay_fwd[l], ret_decay_bwd[l], ret_gn_g[l], ret_w_out[l])
        gate_conv, gate_ret = jnp.split(jax.nn.sigmoid(gate_logits + gate_b[l]), 2, axis=-1)
        mixed = (gate_conv * conv_out + gate_ret * ret_out) @ w_mix_out[l]
        x = x + rmsnorm(mixed, norm_g[l, 3])
        a = memory_cross_attention(rmsnorm(x, norm_g[l, 4]), mem, mem_norm_g[l], xattn_w_q[l], xattn_w_kv[l], xattn_w_o[l])
        x = x + rmsnorm(a, norm_g[l, 5])
        f = swiglu_ffn(rmsnorm(x, norm_g[l, 6]), ffn2_w_gu[l], ffn2_w_down[l])
        x = x + 0.5 * rmsnorm(f, norm_g[l, 7])
    return x


def setup_inputs(seed: int = 0) -> dict:
    key = jax.random.key(seed)
    ks = jax.random.split(key, 32)

    def w(k, shape, fan_in):
        return jax.random.normal(k, shape, jnp.float32) * (fan_in ** -0.5)

    def gain(k, shape):
        return 1.0 + 0.05 * jax.random.normal(k, shape, jnp.float32)

    def small(k, shape):
        return 0.02 * jax.random.normal(k, shape, jnp.float32)

    decay_base = jnp.log(-jnp.log1p(-(2.0 ** (-5.0 - jnp.arange(RET_HEADS, dtype=jnp.float32)))))
    return {
        'x_prompt': jax.random.normal(ks[0], (BATCH, SEQ, D_MODEL), jnp.float32),
        'x_sample': jax.random.normal(ks[1], (DEC_BATCH, DEC_SEQ, D_MODEL), jnp.float32),
        'mem_prompt': jax.random.normal(ks[2], (BATCH, N_MEM, D_MODEL), jnp.float32),
        'mem_sample': jax.random.normal(ks[3], (DEC_BATCH, N_MEM, D_MODEL), jnp.float32),
        'norm_g': gain(ks[4], (DEPTH, N_NORMS, D_MODEL)),
        'ffn1_w_gu': w(ks[5], (DEPTH, D_MODEL, 2 * D_FF), D_MODEL),
        'ffn1_w_down': w(ks[6], (DEPTH, D_FF, D_MODEL), D_FF),
        'w_in': w(ks[7], (DEPTH, D_MODEL, IN_COLS), D_MODEL),
        'conv_dw_w': w(ks[8], (DEPTH, CONV_WIDTH, CONV_DIM), CONV_WIDTH),
        'conv_dw_b': small(ks[9], (DEPTH, CONV_DIM)),
        'conv_ln_g': gain(ks[10], (DEPTH, CONV_DIM)),
        'conv_ln_b': small(ks[11], (DEPTH, CONV_DIM)),
        'conv_w_pw': w(ks[12], (DEPTH, CONV_DIM, D_MODEL), CONV_DIM),
        'ret_decay_fwd': decay_base[None, :] + 0.1 * jax.random.normal(ks[13], (DEPTH, RET_HEADS), jnp.float32),
        'ret_decay_bwd': decay_base[None, :] + 0.1 * jax.random.normal(ks[14], (DEPTH, RET_HEADS), jnp.float32),
        'ret_gn_g': gain(ks[15], (DEPTH, RET_DIM)),
        'ret_w_out': w(ks[16], (DEPTH, RET_DIM, D_MODEL), RET_DIM),
        'gate_b': small(ks[17], (DEPTH, 2 * D_MODEL)),
        'w_mix_out': w(ks[18], (DEPTH, D_MODEL, D_MODEL), D_MODEL),
        'mem_norm_g': gain(ks[19], (DEPTH, D_MODEL)),
        'xattn_w_q': w(ks[20], (DEPTH, D_MODEL, D_MODEL), D_MODEL),
        'xattn_w_kv': w(ks[21], (DEPTH, D_MODEL, 2 * D_MODEL), D_MODEL),
        'xattn_w_o': w(ks[22], (DEPTH, D_MODEL, D_MODEL), D_MODEL),
        'ffn2_w_gu': w(ks[23], (DEPTH, D_MODEL, 2 * D_FF), D_MODEL),
        'ffn2_w_down': w(ks[24], (DEPTH, D_FF, D_MODEL), D_FF),
    }


def reference(x_prompt, x_sample, mem_prompt, mem_sample, norm_g, ffn1_w_gu, ffn1_w_down, w_in,
              conv_dw_w, conv_dw_b, conv_ln_g, conv_ln_b, conv_w_pw, ret_decay_fwd, ret_decay_bwd,
              ret_gn_g, ret_w_out, gate_b, w_mix_out, mem_norm_g, xattn_w_q, xattn_w_kv, xattn_w_o,
              ffn2_w_gu, ffn2_w_down):
    y_prompt = trunk(x_prompt, mem_prompt, norm_g, ffn1_w_gu, ffn1_w_down, w_in, conv_dw_w, conv_dw_b,
                     conv_ln_g, conv_ln_b, conv_w_pw, ret_decay_fwd, ret_decay_bwd, ret_gn_g, ret_w_out,
                     gate_b, w_mix_out, mem_norm_g, xattn_w_q, xattn_w_kv, xattn_w_o, ffn2_w_gu, ffn2_w_down)
    y_sample = trunk(x_sample, mem_sample, norm_g, ffn1_w_gu, ffn1_w_down, w_in, conv_dw_w, conv_dw_b,
                     conv_ln_g, conv_ln_b, conv_w_pw, ret_decay_fwd, ret_decay_bwd, ret_gn_g, ret_w_out,
                     gate_b, w_mix_out, mem_norm_g, xattn_w_q, xattn_w_kv, xattn_w_o, ffn2_w_gu, ffn2_w_down)
    return (y_prompt, y_sample)
```

```cpp
#include <hip/hip_runtime.h>
#include <hip/hip_bf16.h>
#include <hip/hip_cooperative_groups.h>
#include <cstdio>
#include <cmath>
namespace cg = cooperative_groups;

#ifndef SINGLE_LAUNCH
#define SINGLE_LAUNCH 1
#endif

#define DEV __device__ __forceinline__
typedef unsigned short bf16_t;
typedef short bf16x8 __attribute__((ext_vector_type(8)));
typedef short bf16x4 __attribute__((ext_vector_type(4)));
typedef float f32x4 __attribute__((ext_vector_type(4)));
typedef unsigned u32x4 __attribute__((ext_vector_type(4)));
typedef unsigned u32x2 __attribute__((ext_vector_type(2)));

constexpr int TG = 16384;
constexpr int NGRP = 3;
constexpr int PC = 5120;
constexpr int C_Q = 1024, C_K = 1536, C_V = 2048, C_G = 2560, C_GC = 3072, C_GR = 4096;
constexpr int NTHREADS = 512;
constexpr int LDS_BYTES = 131072;

constexpr size_t O_GU1 = 0, O_D1 = 5767168, O_IN = 8650752, O_PW = 13893632, O_RO = 14417920, O_MIX = 14942208,
                 O_Q = 15990784, O_KV = 17039360, O_O = 19136512, O_GU2 = 20185088, O_D2 = 25952256, WL = 28835840;
constexpr size_t WS_WT = 0;
constexpr size_t WS_ROT = WS_WT + 2 * WL * 2;
constexpr size_t WS_MEMN = WS_ROT + (size_t)16384 * 32 * 8;
constexpr size_t WS_KMEM = WS_MEMN + (size_t)2 * 2304 * 1024 * 2;
constexpr size_t WS_VMEMT = WS_KMEM + (size_t)2 * 2304 * 1024 * 2;
constexpr size_t WS_H = WS_VMEMT + (size_t)2 * 2304 * 1024 * 2;
constexpr size_t WS_HID = WS_H + (size_t)TG * 1024 * 2;
constexpr size_t WS_KVST = WS_HID;
constexpr size_t WS_PREV = WS_HID + 33554432;
constexpr size_t WS_MIXB = WS_HID + 50331648;
constexpr size_t WS_PROJ = WS_HID + (size_t)TG * 2816 * 2;
constexpr size_t WS_F = WS_PROJ;
constexpr size_t WS_QB = WS_PROJ + 67108864;
constexpr size_t WS_OB = WS_PROJ + 100663296;
constexpr size_t WS_CV = WS_PROJ + (size_t)TG * PC * 2;
constexpr size_t WS_RT = WS_CV + (size_t)TG * 512 * 2;
constexpr size_t WS_END = WS_RT + (size_t)TG * 512 * 2;

struct Params {
    const float* in[25];
    float* out;
    unsigned char* ws;
    float inv_freq[32];
    int ph_begin, ph_end;
};

extern __shared__ __attribute__((aligned(16))) unsigned char g_lds[];

DEV unsigned cvt_pk_bf16(float lo, float hi) { unsigned r; asm("v_cvt_pk_bf16_f32 %0, %1, %2" : "=v"(r) : "v"(lo), "v"(hi)); return r; }
DEV bf16_t f2bf(float v) { return (bf16_t)(cvt_pk_bf16(v, 0.f) & 0xffffu); }
DEV float bf2f(bf16_t v) { return __uint_as_float((unsigned)v << 16); }
DEV float bflo(unsigned v) { return __uint_as_float(v << 16); }
DEV float bfhi(unsigned v) { return __uint_as_float(v & 0xffff0000u); }
DEV float sigmoidf_(float x) { return __builtin_amdgcn_rcpf(1.f + __expf(-x)); }
DEV float siluf_(float x) { return x * __builtin_amdgcn_rcpf(1.f + __expf(-x)); }
DEV float wave_sum(float v) {
#pragma unroll
    for (int o = 32; o > 0; o >>= 1) v += __shfl_xor(v, o);
    return v;
}

DEV int launder_v(int v) { asm volatile("" : "+v"(v)); return v; }
DEV int launder_s(int v) { asm volatile("" : "+s"(v)); return v; }
#define TIDX launder_v((int)threadIdx.x)
#define BIDX launder_s((int)blockIdx.x)
constexpr int BM = 256, BK = 64, HALF = 128, HT = HALF * BK, NXCD = 8, WGM = 8;
DEV int lds_byte(int r, int c) {
    int st = (r >> 4) * 2 + (c >> 5), rr = r & 15, cc = c & 31, ob = rr * 64 + cc * 2;
    return st * 1024 + (ob ^ (((ob >> 9) & 1) << 5));
}
DEV void stage_rc(int b, int& R, int& C) {
    int st = b / 1024, sb = b % 1024, swz = sb ^ (((sb >> 9) & 1) << 5);
    R = (st >> 1) * 16 + swz / 64; C = (st & 1) * 32 + (swz % 64) / 2;
}

#define LAS __attribute__((address_space(3)))
enum { EPI_F32 = 0, EPI_BF16 = 1, EPI_SWIGLU = 2, EPI_PROJ = 3, EPI_MIX = 4, EPI_KV = 5 };

struct GemmDesc {
    const bf16_t* A; const bf16_t* Bt; int M, N, K, epi;
    void* out;
    const bf16_t* A2; const bf16_t* Bt2; int K2;
    const bf16_t* proj;
    const float* gate_b;
    bf16_t* out2;
    size_t bt_layer_stride;
};

template <int EPI> DEV void gemm_phase(const GemmDesc& g) {
    LAS unsigned char* lds = (LAS unsigned char*)g_lds;
    const int tid = TIDX, wid = __builtin_amdgcn_readfirstlane(tid >> 6), lane = tid & 63, wr = wid >> 2, wc = wid & 3, fr = lane & 15, fq = lane >> 4;
    const int K = g.K, nt = K / BK;
    const int nM = g.M / BM, nN = g.N / BM, nwg = nM * nN, G = gridDim.x, cblk = BIDX;
    const bool dual = (EPI == EPI_MIX);
    unsigned voff[2];
#pragma unroll
    for (int i = 0; i < 2; ++i) { int R, C; stage_rc(tid * 16 + i * 8192, R, C); voff[i] = (unsigned)(R * K + C) * 2u; }
    const size_t kstep = (size_t)(BK * 2), hstep = (size_t)HALF * K * 2, tstep = 2 * hstep;
    const unsigned ldsw = (unsigned)wid * 1024u;
    const int aoff = lds_byte(wr * 64 + fr, fq * 8), boff = lds_byte(wc * 32 + fr, fq * 8);
#define PG_SA(b, h) (((b) * 2 + (h)) * (HT * 2))
#define PG_SB(b, h) ((4 + (b) * 2 + (h)) * (HT * 2))
#define PG_STAGE(bufoff, gbase) do { _Pragma("unroll") for (int _i = 0; _i < 2; ++_i) \
        __builtin_amdgcn_global_load_lds((const unsigned*)((const char*)(gbase) + voff[_i]), (LAS unsigned*)(lds + (bufoff) + ldsw + _i * 8192), 16, 0, 0); } while (0)
#define PG_LDA(dst, b, h) do { _Pragma("unroll") for (int m = 0; m < 4; ++m) _Pragma("unroll") for (int k = 0; k < 2; ++k) dst[m][k] = *(const LAS bf16x8*)(lds + PG_SA(b, h) + aoff + m * 2048 + k * 1024); } while (0)
#define PG_LDB(dst, b, h) do { _Pragma("unroll") for (int n = 0; n < 2; ++n) _Pragma("unroll") for (int k = 0; k < 2; ++k) dst[n][k] = *(const LAS bf16x8*)(lds + PG_SB(b, h) + boff + n * 2048 + k * 1024); } while (0)
#define PG_MMA(ai, bj, Af, Bf) do { __builtin_amdgcn_s_setprio(1); _Pragma("unroll") for (int m = 0; m < 4; ++m) _Pragma("unroll") for (int n = 0; n < 2; ++n) _Pragma("unroll") for (int k = 0; k < 2; ++k) \
        acc[ai][bj][m][n] = __builtin_amdgcn_mfma_f32_16x16x32_bf16(Bf[n][k], Af[m][k], acc[ai][bj][m][n], 0, 0, 0); __builtin_amdgcn_s_setprio(0); } while (0)
#define PG_WAIT_V(n) asm volatile("s_waitcnt vmcnt(" #n ")" ::: "memory")
#define PG_WAIT_L(n) asm volatile("s_waitcnt lgkmcnt(" #n ")" ::: "memory")
#define PG_BAR __builtin_amdgcn_s_barrier()
#define PG_SCHED __builtin_amdgcn_sched_barrier(0)
#define PG_NEXT(i, pm_, pn_, seg_, ok_) do { const int _ti = dual ? ((i) >> 1) : (i); seg_ = dual ? ((i) & 1) : 0; const int _L = _ti * G + cblk; ok_ = _L < nwg; \
        if (ok_) { int wgid = _L; { const int q = nwg / NXCD, r = nwg % NXCD, xcd = wgid % NXCD, off = wgid / NXCD; wgid = (xcd < r ? xcd * (q + 1) : r * (q + 1) + (xcd - r) * q) + off; } \
          const int nig = WGM * nN, gid = wgid / nig, fm = gid * WGM, gsz = (nM - fm) < WGM ? (nM - fm) : WGM; pm_ = fm + ((wgid % nig) % gsz); pn_ = (wgid % nig) / gsz; } } while (0)
#define PG_ABASE(pm_, seg_) ((const char*)((seg_) ? g.A2 : g.A) + (size_t)(pm_) * tstep)
#define PG_BBASE(pm_, pn_, seg_) ((const char*)((seg_) ? g.Bt2 : g.Bt) + ((EPI == EPI_KV && (pm_) >= 9) ? g.bt_layer_stride * 2 : (size_t)0) + (size_t)(pn_) * tstep)
    int pm = 0, pn = 0, seg = 0, npm = 0, npn = 0, nseg = 0, ui = 0; bool ok;
    PG_NEXT(0, pm, pn, seg, ok);
    if (!ok) return;
    f32x4 acc[2][2][4][2];
#pragma unroll
    for (int a = 0; a < 2; ++a)
#pragma unroll
        for (int b = 0; b < 2; ++b)
#pragma unroll
            for (int m = 0; m < 4; ++m)
#pragma unroll
                for (int n = 0; n < 2; ++n) acc[a][b][m][n] = (f32x4){0.f, 0.f, 0.f, 0.f};
    bf16x8 At[4][2], B0[2][2], B1[2][2];
    const char* cA = PG_ABASE(pm, seg); const char* cB = PG_BBASE(pm, pn, seg);
    asm volatile("s_waitcnt vmcnt(0) lgkmcnt(0)" ::: "memory"); PG_BAR; PG_SCHED;
    PG_STAGE(PG_SB(0, 0), cB); PG_STAGE(PG_SA(0, 0), cA); PG_STAGE(PG_SB(0, 1), cB + hstep); PG_STAGE(PG_SA(0, 1), cA + hstep);
    if (wr == 1) PG_BAR;
    PG_WAIT_V(4); PG_BAR;
    PG_STAGE(PG_SB(1, 0), cB + kstep); PG_STAGE(PG_SA(1, 0), cA + kstep); PG_STAGE(PG_SB(1, 1), cB + hstep + kstep);
    PG_WAIT_V(6); PG_BAR;
    for (;;) {
        bool has_next; PG_NEXT(ui + 1, npm, npn, nseg, has_next);
        const char* nA = has_next ? PG_ABASE(npm, nseg) : cA; const char* nB = has_next ? PG_BBASE(npm, npn, nseg) : cB;
        for (int t = 0; t < nt; t += 2) {
            const bool last = (t == nt - 2);
            const char* a1 = cA + (size_t)(t + 1) * kstep;
            const char* a2 = last ? nA : cA + (size_t)(t + 2) * kstep; const char* b2 = last ? nB : cB + (size_t)(t + 2) * kstep;
            const char* a3 = a2 + kstep; const char* b3 = b2 + kstep;
            PG_LDB(B0, 0, 0); PG_SCHED; PG_LDA(At, 0, 0); PG_STAGE(PG_SA(1, 1), a1 + hstep);
            PG_WAIT_L(8); PG_BAR; PG_WAIT_L(0); PG_MMA(0, 0, At, B0); PG_BAR; PG_SCHED;
            PG_LDB(B1, 0, 1); PG_STAGE(PG_SB(0, 0), b2);
            PG_BAR; PG_WAIT_L(0); PG_MMA(0, 1, At, B1); PG_BAR;
            PG_LDA(At, 0, 1); PG_STAGE(PG_SA(0, 0), a2);
            PG_BAR; PG_WAIT_L(0); PG_MMA(1, 0, At, B0); PG_BAR; PG_SCHED;
            PG_STAGE(PG_SB(0, 1), b2 + hstep);
            PG_WAIT_V(6); PG_BAR; PG_MMA(1, 1, At, B1); PG_BAR;
            PG_LDB(B0, 1, 0); PG_SCHED; PG_LDA(At, 1, 0); PG_STAGE(PG_SA(0, 1), a2 + hstep);
            PG_WAIT_L(8); PG_BAR; PG_WAIT_L(0); PG_MMA(0, 0, At, B0); PG_BAR; PG_SCHED;
            PG_LDB(B1, 1, 1); PG_STAGE(PG_SB(1, 0), b3);
            PG_BAR; PG_WAIT_L(0); PG_MMA(0, 1, At, B1); PG_BAR;
            PG_LDA(At, 1, 1); PG_STAGE(PG_SA(1, 0), a3);
            PG_BAR; PG_WAIT_L(0); PG_MMA(1, 0, At, B0); PG_BAR; PG_SCHED;
            PG_STAGE(PG_SB(1, 1), b3 + hstep);
            PG_WAIT_V(6); PG_BAR; PG_MMA(1, 1, At, B1); PG_BAR;
        }
        const int brow = pm * BM, bcol = pn * BM;
        const int r0 = brow + wr * 64 + fr, c0 = bcol + wc * 32 + fq * 4;
        if (EPI == EPI_MIX) {
          if (seg == 0) {
#pragma unroll
            for (int ai = 0; ai < 2; ++ai)
#pragma unroll
                for (int m = 0; m < 4; ++m) {
                    const bf16_t* pr = g.proj + (size_t)(r0 + ai * 128 + m * 16) * PC + c0;
#pragma unroll
                    for (int bj = 0; bj < 2; ++bj)
#pragma unroll
                        for (int n = 0; n < 2; ++n) {
                            const u32x2 gc = *(const u32x2*)(pr + C_GC + bj * 128 + n * 16), gr = *(const u32x2*)(pr + C_GR + bj * 128 + n * 16);
                            f32x4 v = acc[ai][bj][m][n];
                            v[0] *= bflo(gc[0]) * __builtin_amdgcn_rcpf(bflo(gr[0])); v[1] *= bfhi(gc[0]) * __builtin_amdgcn_rcpf(bfhi(gr[0]));
                            v[2] *= bflo(gc[1]) * __builtin_amdgcn_rcpf(bflo(gr[1])); v[3] *= bfhi(gc[1]) * __builtin_amdgcn_rcpf(bfhi(gr[1]));
                            acc[ai][bj][m][n] = v;
                        }
                }
          } else {
#pragma unroll
            for (int ai = 0; ai < 2; ++ai)
#pragma unroll
                for (int m = 0; m < 4; ++m) {
                    const size_t row = (size_t)(r0 + ai * 128 + m * 16);
                    const bf16_t* pr = g.proj + row * PC + c0;
                    bf16_t* o = (bf16_t*)g.out + row * 1024 + c0;
#pragma unroll
                    for (int bj = 0; bj < 2; ++bj)
#pragma unroll
                        for (int n = 0; n < 2; ++n) {
                            const u32x2 gr = *(const u32x2*)(pr + C_GR + bj * 128 + n * 16);
                            const f32x4 v = acc[ai][bj][m][n];
                            u32x2 w; w[0] = cvt_pk_bf16(v[0] * bflo(gr[0]), v[1] * bfhi(gr[0])); w[1] = cvt_pk_bf16(v[2] * bflo(gr[1]), v[3] * bfhi(gr[1]));
                            *(u32x2*)(o + bj * 128 + n * 16) = w;
                        }
                }
          }
        } else if (EPI == EPI_F32) {
#pragma unroll
            for (int ai = 0; ai < 2; ++ai)
#pragma unroll
                for (int m = 0; m < 4; ++m) {
                    float* o = (float*)g.out + (size_t)(r0 + ai * 128 + m * 16) * g.N + c0;
#pragma unroll
                    for (int bj = 0; bj < 2; ++bj)
#pragma unroll
                        for (int n = 0; n < 2; ++n) *(f32x4*)(o + bj * 128 + n * 16) = acc[ai][bj][m][n];
                }
        } else if (EPI == EPI_BF16 || EPI == EPI_PROJ) {
            const bool sg = (EPI == EPI_PROJ) && (bcol >= C_GC);
#pragma unroll
            for (int ai = 0; ai < 2; ++ai)
#pragma unroll
                for (int m = 0; m < 4; ++m) {
                    bf16_t* o = (bf16_t*)g.out + (size_t)(r0 + ai * 128 + m * 16) * g.N + c0;
#pragma unroll
                    for (int bj = 0; bj < 2; ++bj)
#pragma unroll
                        for (int n = 0; n < 2; ++n) {
                            f32x4 v = acc[ai][bj][m][n];
                            if (sg) {
                                const f32x4 b = *(const f32x4*)(g.gate_b + (c0 - C_GC) + bj * 128 + n * 16);
#pragma unroll
                                for (int j = 0; j < 4; ++j) v[j] = sigmoidf_(v[j] + b[j]);
                            }
                            u32x2 w; w[0] = cvt_pk_bf16(v[0], v[1]); w[1] = cvt_pk_bf16(v[2], v[3]);
                            *(u32x2*)(o + bj * 128 + n * 16) = w;
                        }
                }
        } else if (EPI == EPI_SWIGLU) {
            const int hc0 = (bcol >> 1) + wc * 32 + fq * 4;
#pragma unroll
            for (int ai = 0; ai < 2; ++ai)
#pragma unroll
                for (int m = 0; m < 4; ++m) {
                    bf16_t* o = (bf16_t*)g.out + (size_t)(r0 + ai * 128 + m * 16) * (g.N >> 1) + hc0;
#pragma unroll
                    for (int n = 0; n < 2; ++n) {
                        const f32x4 ga = acc[ai][0][m][n], up = acc[ai][1][m][n];
                        u32x2 w; w[0] = cvt_pk_bf16(siluf_(ga[0]) * up[0], siluf_(ga[1]) * up[1]); w[1] = cvt_pk_bf16(siluf_(ga[2]) * up[2], siluf_(ga[3]) * up[3]);
                        *(u32x2*)(o + n * 16) = w;
                    }
                }
        } else {
#pragma unroll
            for (int ai = 0; ai < 2; ++ai)
#pragma unroll
                for (int m = 0; m < 4; ++m) {
                    const int row = r0 + ai * 128 + m * 16;
#pragma unroll
                    for (int bj = 0; bj < 2; ++bj)
#pragma unroll
                        for (int n = 0; n < 2; ++n) {
                            const f32x4 v = acc[ai][bj][m][n];
                            const int col = c0 + bj * 128 + n * 16;
                            if (bcol < 1024) {
                                u32x2 w; w[0] = cvt_pk_bf16(v[0], v[1]); w[1] = cvt_pk_bf16(v[2], v[3]);
                                *(u32x2*)((bf16_t*)g.out + (size_t)row * 1024 + col) = w;
                            } else {
                                const int hh = (col - 1024) >> 8, d = (col - 1024) & 255, lb = row >> 8, mm = row & 255;
                                bf16_t* o = g.out2 + ((size_t)(lb * 4 + hh) * 256 + d) * 256 + mm;
#pragma unroll
                                for (int j = 0; j < 4; ++j) o[j * 256] = f2bf(v[j]);
                            }
                        }
                }
        }
        if (!has_next) break;
        if (!(dual && seg == 0)) {
#pragma unroll
            for (int a = 0; a < 2; ++a)
#pragma unroll
                for (int b = 0; b < 2; ++b)
#pragma unroll
                    for (int m = 0; m < 4; ++m)
#pragma unroll
                        for (int n = 0; n < 2; ++n) acc[a][b][m][n] = (f32x4){0.f, 0.f, 0.f, 0.f};
        }
        pm = npm; pn = npn; seg = nseg; cA = nA; cB = nB; ++ui;
    }
    PG_WAIT_V(0);
    if (wr == 0) PG_BAR;
    PG_BAR;
#undef PG_SA
#undef PG_SB
#undef PG_STAGE
#undef PG_LDA
#undef PG_LDB
#undef PG_MMA
#undef PG_NEXT
#undef PG_ABASE
#undef PG_BBASE
}

DEV void transpose_mat(const float* __restrict__ src, const int K, const int N, bf16_t* __restrict__ dst, const int perm, const float scale) {
    float* tile = (float*)g_lds;
    const int nkt = K / 64, ntile = nkt * (N / 64), tid = TIDX, bid = BIDX;
    for (int t = bid; t < ntile; t += gridDim.x) {
        const int rt = t / nkt, kt = t - rt * nkt, rho0 = rt * 64;
        const int cbase = perm ? (((rho0 & 255) >> 7) * 2816 + (rho0 >> 8) * 128 + (rho0 & 127)) : rho0;
        __syncthreads();
#pragma unroll
        for (int i = 0; i < 8; ++i) { const int kk = (tid >> 6) + 8 * i, cc = tid & 63; tile[kk * 65 + cc] = src[(size_t)(kt * 64 + kk) * N + cbase + cc]; }
        __syncthreads();
#pragma unroll
        for (int i = 0; i < 4; ++i) {
            const int rr = (tid >> 5) + 16 * i, k2 = (tid & 31) * 2;
            *(unsigned*)(dst + (size_t)(rho0 + rr) * K + kt * 64 + k2) = cvt_pk_bf16(tile[k2 * 65 + rr] * scale, tile[(k2 + 1) * 65 + rr] * scale);
        }
    }
}

DEV void setup_phase(const Params& p) {
    bf16_t* wt = (bf16_t*)(p.ws + WS_WT);
    for (int l = 0; l < 2; ++l) {
        bf16_t* w = wt + (size_t)l * WL;
        transpose_mat(p.in[5] + (size_t)l * 1024 * 5632, 1024, 5632, w + O_GU1, 1, 1.f);
        transpose_mat(p.in[6] + (size_t)l * 2816 * 1024, 2816, 1024, w + O_D1, 0, 1.f);
        transpose_mat(p.in[7] + (size_t)l * 1024 * 5120, 1024, 5120, w + O_IN, 0, 1.f);
        transpose_mat(p.in[12] + (size_t)l * 512 * 1024, 512, 1024, w + O_PW, 0, 1.f);
        transpose_mat(p.in[16] + (size_t)l * 512 * 1024, 512, 1024, w + O_RO, 0, 1.f);
        transpose_mat(p.in[18] + (size_t)l * 1024 * 1024, 1024, 1024, w + O_MIX, 0, 1.f);
        transpose_mat(p.in[20] + (size_t)l * 1024 * 1024, 1024, 1024, w + O_Q, 0, 0.0625f);
        transpose_mat(p.in[21] + (size_t)l * 1024 * 2048, 1024, 2048, w + O_KV, 0, 1.f);
        transpose_mat(p.in[22] + (size_t)l * 1024 * 1024, 1024, 1024, w + O_O, 0, 1.f);
        transpose_mat(p.in[23] + (size_t)l * 1024 * 5632, 1024, 5632, w + O_GU2, 1, 1.f);
        transpose_mat(p.in[24] + (size_t)l * 2816 * 1024, 2816, 1024, w + O_D2, 0, 1.f);
    }
    float2* rot = (float2*)(p.ws + WS_ROT);
    const int tid0 = TIDX, bid0 = BIDX;
    for (int idx = bid0 * NTHREADS + tid0; idx < 16384 * 32; idx += gridDim.x * NTHREADS) {
        const int pos = idx >> 5, i = idx & 31;
        const float ang = (float)pos * p.inv_freq[i];
        double rev = (double)ang * 0.15915494309189535;
        rev -= floor(rev);
        const float fr = (float)rev;
        rot[idx] = make_float2(__builtin_amdgcn_cosf(fr), __builtin_amdgcn_sinf(fr));
    }
    bf16_t* memn = (bf16_t*)(p.ws + WS_MEMN);
    const int lane = tid0 & 63, gw = bid0 * 8 + (tid0 >> 6), nw = gridDim.x * 8;
    for (int rr = gw; rr < 2 * 2304; rr += nw) {
        const int l = rr / 2304, row = rr - l * 2304;
        const float* src = row < 2048 ? p.in[2] + (size_t)row * 1024 : p.in[3] + (size_t)(row - 2048) * 1024;
        const float* mg = p.in[19] + l * 1024;
        f32x4 x[4]; float ss = 0.f;
#pragma unroll
        for (int i = 0; i < 4; ++i) { x[i] = *(const f32x4*)(src + i * 256 + lane * 4); ss += x[i][0] * x[i][0] + x[i][1] * x[i][1] + x[i][2] * x[i][2] + x[i][3] * x[i][3]; }
        ss = wave_sum(ss);
        const float r = 1.0f / sqrtf(ss * (1.f / 1024.f) + 1e-6f);
#pragma unroll
        for (int i = 0; i < 4; ++i) {
            const f32x4 gg = *(const f32x4*)(mg + i * 256 + lane * 4);
            u32x2 w; w[0] = cvt_pk_bf16(x[i][0] * r * gg[0], x[i][1] * r * gg[1]); w[1] = cvt_pk_bf16(x[i][2] * r * gg[2], x[i][3] * r * gg[3]);
            *(u32x2*)(memn + (size_t)rr * 1024 + i * 256 + lane * 4) = w;
        }
    }
}

DEV void rowwise_phase(const float* __restrict__ Xsrc, float* __restrict__ X, const float* __restrict__ F, const float scale,
                       const float* __restrict__ gpost, const float* __restrict__ gnext, bf16_t* __restrict__ H) {
    const int tid0 = TIDX, bid0 = BIDX;
    const int lane = tid0 & 63, gw = bid0 * 8 + (tid0 >> 6), nw = gridDim.x * 8;
    for (int row = gw; row < TG; row += nw) {
        f32x4 x[4];
#pragma unroll
        for (int i = 0; i < 4; ++i) x[i] = *(const f32x4*)(Xsrc + (size_t)row * 1024 + i * 256 + lane * 4);
        if (F) {
            f32x4 f[4]; float ss = 0.f;
#pragma unroll
            for (int i = 0; i < 4; ++i) { f[i] = *(const f32x4*)(F + (size_t)row * 1024 + i * 256 + lane * 4); ss += f[i][0] * f[i][0] + f[i][1] * f[i][1] + f[i][2] * f[i][2] + f[i][3] * f[i][3]; }
            ss = wave_sum(ss);
            const float r = scale / sqrtf(ss * (1.f / 1024.f) + 1e-6f);
#pragma unroll
            for (int i = 0; i < 4; ++i) { const f32x4 gp = *(const f32x4*)(gpost + i * 256 + lane * 4); x[i] += f[i] * r * gp; }
        }
#pragma unroll
        for (int i = 0; i < 4; ++i) *(f32x4*)(X + (size_t)row * 1024 + i * 256 + lane * 4) = x[i];
        if (gnext) {
            float ss = 0.f;
#pragma unroll
            for (int i = 0; i < 4; ++i) ss += x[i][0] * x[i][0] + x[i][1] * x[i][1] + x[i][2] * x[i][2] + x[i][3] * x[i][3];
            ss = wave_sum(ss);
            const float r = 1.0f / sqrtf(ss * (1.f / 1024.f) + 1e-6f);
#pragma unroll
            for (int i = 0; i < 4; ++i) {
                const f32x4 gg = *(const f32x4*)(gnext + i * 256 + lane * 4);
                u32x2 w; w[0] = cvt_pk_bf16(x[i][0] * r * gg[0], x[i][1] * r * gg[1]); w[1] = cvt_pk_bf16(x[i][2] * r * gg[2], x[i][3] * r * gg[3]);
                *(u32x2*)(H + (size_t)row * 1024 + i * 256 + lane * 4) = w;
            }
        }
    }
}

DEV void conv_phase(const bf16_t* __restrict__ PROJ, bf16_t* __restrict__ CV, const float* __restrict__ dw_w, const float* __restrict__ dw_b,
                    const float* __restrict__ ln_g, const float* __restrict__ ln_b, const int S) {
    bf16_t* us = (bf16_t*)g_lds;
    float* red = (float*)(g_lds + 62 * 512 * 2);
    float* stat = red + 8 * 32 * 2;
    const int tid = TIDX, bid = BIDX, c = tid, wid = tid >> 6, lane = tid & 63;
    float w[31];
#pragma unroll
    for (int k = 0; k < 31; ++k) w[k] = dw_w[k * 512 + c];
    const float bias = dw_b[c], lg = ln_g[c], lb = ln_b[c];
    for (int u = bid; u < TG / 32; u += gridDim.x) {
        const int t0 = u * 32, seq = t0 / S, pos0 = t0 - seq * S;
        __syncthreads();
        const int cg8 = (tid & 63) * 8;
#pragma unroll
        for (int it = 0; it < 8; ++it) {
            const int tt = it * 8 + (tid >> 6);
            if (tt < 62) {
                const int pos = pos0 - 15 + tt;
                u32x4 o = {0u, 0u, 0u, 0u};
                if (pos >= 0 && pos < S) {
                    const bf16_t* pr = PROJ + (size_t)(seq * S + pos) * PC;
                    const u32x4 v = *(const u32x4*)(pr + cg8), gt = *(const u32x4*)(pr + 512 + cg8);
#pragma unroll
                    for (int q = 0; q < 4; ++q) o[q] = cvt_pk_bf16(bflo(v[q]) * sigmoidf_(bflo(gt[q])), bfhi(v[q]) * sigmoidf_(bfhi(gt[q])));
                }
                *(u32x4*)(us + tt * 512 + cg8) = o;
            }
        }
        __syncthreads();
        float acc[32];
#pragma unroll
        for (int seg = 0; seg < 4; ++seg) {
#pragma unroll
            for (int s = 0; s < 8; ++s) acc[seg * 8 + s] = bias;
#pragma unroll
            for (int kk = 0; kk < 38; ++kk) {
                const float uv = bf2f(us[(seg * 8 + kk) * 512 + c]);
#pragma unroll
                for (int s = 0; s < 8; ++s) { const int k = kk - s; if (k >= 0 && k < 31) acc[seg * 8 + s] += w[k] * uv; }
            }
        }
#pragma unroll
        for (int s = 0; s < 32; ++s) {
            const float s1 = wave_sum(acc[s]), s2 = wave_sum(acc[s] * acc[s]);
            if (lane == 0) { red[(wid * 32 + s) * 2] = s1; red[(wid * 32 + s) * 2 + 1] = s2; }
        }
        __syncthreads();
        if (tid < 32) {
            float s1 = 0.f, s2 = 0.f;
#pragma unroll
            for (int q = 0; q < 8; ++q) { s1 += red[(q * 32 + tid) * 2]; s2 += red[(q * 32 + tid) * 2 + 1]; }
            const float mean = s1 * (1.f / 512.f), var = fmaxf(s2 * (1.f / 512.f) - mean * mean, 0.f);
            stat[tid * 2] = mean; stat[tid * 2 + 1] = 1.0f / sqrtf(var + 1e-6f);
        }
        __syncthreads();
#pragma unroll
        for (int s = 0; s < 32; ++s) {
            const float y = (acc[s] - stat[s * 2]) * stat[s * 2 + 1] * lg + lb;
            CV[(size_t)(t0 + s) * 512 + c] = f2bf(siluf_(y));
        }
    }
}

template <int I> DEV float bfel(const u32x4& v) { return (I & 1) ? bfhi(v[I >> 1]) : bflo(v[I >> 1]); }

DEV void r1_phase(const bf16_t* __restrict__ PROJ, const float2* __restrict__ rot, float* __restrict__ KVST,
                  const float* __restrict__ dec_f, const float* __restrict__ dec_b, const int S) {
    bf16_t* vT = (bf16_t*)g_lds; bf16_t* kTf = vT + 64 * 136; bf16_t* kTb = kTf + 64 * 136;
    const int tid = TIDX, bid = BIDX, wid = tid >> 6, lane = tid & 63, fr = lane & 15, fq = lane >> 4;
    const int j = tid >> 2, dq = (tid & 3) * 8;
    for (int unit = bid; unit < (TG / 128) * 8; unit += gridDim.x) {
        const int cidx = unit >> 3, h = unit & 7, t0 = cidx * 128, seq = t0 / S, pos0 = t0 - seq * S;
        const float lgf2 = -expf(dec_f[h]) * 1.4426950408889634f, lgb2 = -expf(dec_b[h]) * 1.4426950408889634f;
        __syncthreads();
        const bf16_t* pr = PROJ + (size_t)(t0 + j) * PC;
        const u32x4 k1 = *(const u32x4*)(pr + C_K + h * 64 + dq), k2 = *(const u32x4*)(pr + C_K + h * 64 + 32 + dq);
        const float2* rp = rot + (size_t)(pos0 + j) * 32 + dq;
        const float df = exp2f(lgf2 * (float)(127 - j)), db = exp2f(lgb2 * (float)j);
#pragma unroll
        for (int i = 0; i < 8; ++i) {
            const float a = (i & 1) ? bfhi(k1[i >> 1]) : bflo(k1[i >> 1]), b = (i & 1) ? bfhi(k2[i >> 1]) : bflo(k2[i >> 1]);
            const float2 cs = rp[i];
            const float r1 = (a * cs.x - b * cs.y) * 0.125f, r2 = (a * cs.y + b * cs.x) * 0.125f;
            kTf[(dq + i) * 136 + j] = f2bf(r1 * df); kTf[(32 + dq + i) * 136 + j] = f2bf(r2 * df);
            kTb[(dq + i) * 136 + j] = f2bf(r1 * db); kTb[(32 + dq + i) * 136 + j] = f2bf(r2 * db);
        }
        {
            const int e0 = (tid & 3) * 16;
            const u32x4 v1 = *(const u32x4*)(pr + C_V + h * 64 + e0), v2 = *(const u32x4*)(pr + C_V + h * 64 + e0 + 8);
#pragma unroll
            for (int i = 0; i < 4; ++i) {
                vT[(e0 + 2 * i) * 136 + j] = (bf16_t)(v1[i] & 0xffffu); vT[(e0 + 2 * i + 1) * 136 + j] = (bf16_t)(v1[i] >> 16);
                vT[(e0 + 8 + 2 * i) * 136 + j] = (bf16_t)(v2[i] & 0xffffu); vT[(e0 + 8 + 2 * i + 1) * 136 + j] = (bf16_t)(v2[i] >> 16);
            }
        }
        __syncthreads();
        const int dir = wid >> 2, et = wid & 3;
        const bf16_t* kT = dir ? kTb : kTf;
        bf16x8 a[4];
#pragma unroll
        for (int ks = 0; ks < 4; ++ks) a[ks] = *(const bf16x8*)(vT + (et * 16 + fr) * 136 + ks * 32 + fq * 8);
        float* o = KVST + ((size_t)(cidx * 8 + h) * 2 + dir) * 4096;
#pragma unroll
        for (int dt = 0; dt < 4; ++dt) {
            f32x4 acc = {0.f, 0.f, 0.f, 0.f};
#pragma unroll
            for (int ks = 0; ks < 4; ++ks) {
                const bf16x8 b = *(const bf16x8*)(kT + (dt * 16 + fr) * 136 + ks * 32 + fq * 8);
                acc = __builtin_amdgcn_mfma_f32_16x16x32_bf16(a[ks], b, acc, 0, 0, 0);
            }
#pragma unroll
            for (int jj = 0; jj < 4; ++jj) o[(et * 16 + fq * 4 + jj) * 64 + dt * 16 + fr] = acc[jj];
        }
    }
}

DEV void r2_phase(const float* __restrict__ KVST, bf16_t* __restrict__ PREV, const float* __restrict__ dec_f, const float* __restrict__ dec_b, const int S) {
    const int NC = S / 128, nseq = TG / S, total = nseq * 8 * 2 * 4096;
    const int tid0 = TIDX, bid0 = BIDX;
    for (int idx = bid0 * NTHREADS + tid0; idx < total; idx += gridDim.x * NTHREADS) {
        const int elem = idx & 4095, dir = (idx >> 12) & 1, h = (idx >> 13) & 7, seq = idx >> 16;
        const float lg = -expf((dir ? dec_b : dec_f)[h]);
        const float cd = expf(lg * 128.f);
        float st = 0.f;
#pragma unroll 8
        for (int n = 0; n < NC; ++n) {
            const int nn = dir ? NC - 1 - n : n;
            const size_t o = ((size_t)((seq * NC + nn) * 8 + h) * 2 + dir) * 4096 + elem;
            PREV[o] = f2bf(st);
            st = st * cd + KVST[o];
        }
    }
}

DEV void r3_phase(const bf16_t* __restrict__ PROJ, const float2* __restrict__ rot, const bf16_t* __restrict__ PREV, bf16_t* __restrict__ RT,
                  const float* __restrict__ dec_f, const float* __restrict__ dec_b, const float* __restrict__ gn_g, const int S) {
    bf16_t* Qs = (bf16_t*)g_lds; bf16_t* Ks = Qs + 128 * 72; bf16_t* vT = Ks + 128 * 72;
    const int tid = TIDX, bid = BIDX, wid = tid >> 6, lane = tid & 63, fr = lane & 15, fq = lane >> 4;
    const int j = tid >> 2, dq = (tid & 3) * 8;
    for (int unit = bid; unit < (TG / 128) * 8; unit += gridDim.x) {
        const int cidx = unit >> 3, h = unit & 7, t0 = cidx * 128, seq = t0 / S, pos0 = t0 - seq * S;
        const float lgf2 = -expf(dec_f[h]) * 1.4426950408889634f, lgb2 = -expf(dec_b[h]) * 1.4426950408889634f;
        __syncthreads();
        {
            const bf16_t* pr = PROJ + (size_t)(t0 + j) * PC;
            const u32x4 q1 = *(const u32x4*)(pr + C_Q + h * 64 + dq), q2 = *(const u32x4*)(pr + C_Q + h * 64 + 32 + dq);
            const u32x4 k1 = *(const u32x4*)(pr + C_K + h * 64 + dq), k2 = *(const u32x4*)(pr + C_K + h * 64 + 32 + dq);
            const float2* rp = rot + (size_t)(pos0 + j) * 32 + dq;
            u32x4 oq1, oq2, ok1, ok2;
#pragma unroll
            for (int i = 0; i < 4; ++i) {
                const float2 c0 = rp[2 * i], c1 = rp[2 * i + 1];
                const float qa0 = bflo(q1[i]), qa1 = bfhi(q1[i]), qb0 = bflo(q2[i]), qb1 = bfhi(q2[i]);
                const float ka0 = bflo(k1[i]), ka1 = bfhi(k1[i]), kb0 = bflo(k2[i]), kb1 = bfhi(k2[i]);
                oq1[i] = cvt_pk_bf16(qa0 * c0.x - qb0 * c0.y, qa1 * c1.x - qb1 * c1.y);
                oq2[i] = cvt_pk_bf16(qa0 * c0.y + qb0 * c0.x, qa1 * c1.y + qb1 * c1.x);
                ok1[i] = cvt_pk_bf16((ka0 * c0.x - kb0 * c0.y) * 0.125f, (ka1 * c1.x - kb1 * c1.y) * 0.125f);
                ok2[i] = cvt_pk_bf16((ka0 * c0.y + kb0 * c0.x) * 0.125f, (ka1 * c1.y + kb1 * c1.x) * 0.125f);
            }
            *(u32x4*)(Qs + j * 72 + dq) = oq1; *(u32x4*)(Qs + j * 72 + 32 + dq) = oq2;
            *(u32x4*)(Ks + j * 72 + dq) = ok1; *(u32x4*)(Ks + j * 72 + 32 + dq) = ok2;
            const int e0 = (tid & 3) * 16;
            const u32x4 v1 = *(const u32x4*)(pr + C_V + h * 64 + e0), v2 = *(const u32x4*)(pr + C_V + h * 64 + e0 + 8);
#pragma unroll
            for (int i = 0; i < 4; ++i) {
                vT[(e0 + 2 * i) * 136 + j] = (bf16_t)(v1[i] & 0xffffu); vT[(e0 + 2 * i + 1) * 136 + j] = (bf16_t)(v1[i] >> 16);
                vT[(e0 + 8 + 2 * i) * 136 + j] = (bf16_t)(v2[i] & 0xffffu); vT[(e0 + 8 + 2 * i + 1) * 136 + j] = (bf16_t)(v2[i] >> 16);
            }
        }
        __syncthreads();
        const int i0 = wid * 16, ii = i0 + fr;
        bf16x8 bq[2];
#pragma unroll
        for (int ks = 0; ks < 2; ++ks) bq[ks] = *(const bf16x8*)(Qs + (i0 + fr) * 72 + ks * 32 + fq * 8);
        f32x4 s[8];
#pragma unroll
        for (int jt = 0; jt < 8; ++jt) {
            s[jt] = (f32x4){0.f, 0.f, 0.f, 0.f};
#pragma unroll
            for (int ks = 0; ks < 2; ++ks) {
                const bf16x8 a = *(const bf16x8*)(Ks + (jt * 16 + fr) * 72 + ks * 32 + fq * 8);
                s[jt] = __builtin_amdgcn_mfma_f32_16x16x32_bf16(a, bq[ks], s[jt], 0, 0, 0);
            }
#pragma unroll
            for (int jj = 0; jj < 4; ++jj) {
                const int delta = ii - (jt * 16 + fq * 4 + jj);
                const float fac = delta >= 0 ? exp2f(lgf2 * (float)delta) : exp2f(lgb2 * (float)(-delta));
                s[jt][jj] *= fac;
            }
        }
        bf16x8 bp[4];
#pragma unroll
        for (int k2 = 0; k2 < 4; ++k2) {
            u32x4 w; w[0] = cvt_pk_bf16(s[2 * k2][0], s[2 * k2][1]); w[1] = cvt_pk_bf16(s[2 * k2][2], s[2 * k2][3]);
            w[2] = cvt_pk_bf16(s[2 * k2 + 1][0], s[2 * k2 + 1][1]); w[3] = cvt_pk_bf16(s[2 * k2 + 1][2], s[2 * k2 + 1][3]);
            bp[k2] = __builtin_bit_cast(bf16x8, w);
        }
        const bf16_t* pf = PREV + ((size_t)(cidx * 8 + h) * 2) * 4096;
        const bf16_t* pb = pf + 4096;
        const float qf = exp2f(lgf2 * (float)(ii + 1)), qb = exp2f(lgb2 * (float)(128 - ii));
        f32x4 o[4];
#pragma unroll
        for (int et = 0; et < 4; ++et) {
            o[et] = (f32x4){0.f, 0.f, 0.f, 0.f};
#pragma unroll
            for (int k2 = 0; k2 < 4; ++k2) {
                const u32x2 lo = *(const u32x2*)(vT + (et * 16 + fr) * 136 + (2 * k2) * 16 + fq * 4);
                const u32x2 hi = *(const u32x2*)(vT + (et * 16 + fr) * 136 + (2 * k2 + 1) * 16 + fq * 4);
                u32x4 w; w[0] = lo[0]; w[1] = lo[1]; w[2] = hi[0]; w[3] = hi[1];
                o[et] = __builtin_amdgcn_mfma_f32_16x16x32_bf16(__builtin_bit_cast(bf16x8, w), bp[k2], o[et], 0, 0, 0);
            }
            f32x4 cf = {0.f, 0.f, 0.f, 0.f}, cb = {0.f, 0.f, 0.f, 0.f};
#pragma unroll
            for (int ks = 0; ks < 2; ++ks) {
                const bf16x8 af = *(const bf16x8*)(pf + (et * 16 + fr) * 64 + ks * 32 + fq * 8);
                const bf16x8 ab = *(const bf16x8*)(pb + (et * 16 + fr) * 64 + ks * 32 + fq * 8);
                cf = __builtin_amdgcn_mfma_f32_16x16x32_bf16(af, bq[ks], cf, 0, 0, 0);
                cb = __builtin_amdgcn_mfma_f32_16x16x32_bf16(ab, bq[ks], cb, 0, 0, 0);
            }
            o[et] += cf * qf + cb * qb;
        }
        float sum = 0.f;
#pragma unroll
        for (int et = 0; et < 4; ++et) sum += (o[et][0] + o[et][1]) + (o[et][2] + o[et][3]);
        sum += __shfl_xor(sum, 16); sum += __shfl_xor(sum, 32);
        const float mu = sum * (1.f / 64.f);
        float vs = 0.f;
#pragma unroll
        for (int et = 0; et < 4; ++et) { const f32x4 d = o[et] - mu; vs += (d[0] * d[0] + d[1] * d[1]) + (d[2] * d[2] + d[3] * d[3]); }
        vs += __shfl_xor(vs, 16); vs += __shfl_xor(vs, 32);
        const float rstd = 1.0f / sqrtf(vs * (1.f / 64.f) + 1e-6f);
        const size_t tok = (size_t)(t0 + ii);
#pragma unroll
        for (int et = 0; et < 4; ++et) {
            const int e = et * 16 + fq * 4;
            const u32x2 gg = *(const u32x2*)(PROJ + tok * PC + C_G + h * 64 + e);
            const f32x4 gn = *(const f32x4*)(gn_g + h * 64 + e);
            const f32x4 y = (o[et] - mu) * rstd * gn;
            u32x2 w; w[0] = cvt_pk_bf16(siluf_(bflo(gg[0])) * y[0], siluf_(bfhi(gg[0])) * y[1]); w[1] = cvt_pk_bf16(siluf_(bflo(gg[1])) * y[2], siluf_(bfhi(gg[1])) * y[3]);
            *(u32x2*)(RT + tok * 512 + h * 64 + e) = w;
        }
    }
}

DEV void attn_phase(const bf16_t* __restrict__ Q, const bf16_t* __restrict__ Kmem, const bf16_t* __restrict__ VmemT, bf16_t* __restrict__ O, const int S, const int g) {
    const int tid = TIDX, bid = BIDX, wid = tid >> 6, lane = tid & 63, fr = lane & 15, fq = lane >> 4;
    for (int unit = bid; unit < (TG / 128) * 4; unit += gridDim.x) {
        const int qb = unit >> 2, h = unit & 3, t0 = qb * 128, seq = t0 / S, b = (g < 2) ? g * 4 + seq : 8;
        const size_t tok = (size_t)(t0 + wid * 16 + fr);
        bf16x8 bq[8];
#pragma unroll
        for (int ks = 0; ks < 8; ++ks) bq[ks] = *(const bf16x8*)(Q + tok * 1024 + h * 256 + ks * 32 + fq * 8);
        const bf16_t* kb = Kmem + (size_t)(b * 256) * 1024 + h * 256;
        f32x4 s[16];
#pragma unroll
        for (int mt = 0; mt < 16; ++mt) {
            s[mt] = (f32x4){0.f, 0.f, 0.f, 0.f};
#pragma unroll
            for (int ks = 0; ks < 8; ++ks) {
                const bf16x8 a = *(const bf16x8*)(kb + (size_t)(mt * 16 + fr) * 1024 + ks * 32 + fq * 8);
                s[mt] = __builtin_amdgcn_mfma_f32_16x16x32_bf16(a, bq[ks], s[mt], 0, 0, 0);
            }
        }
        float mx = -3.0e38f;
#pragma unroll
        for (int mt = 0; mt < 16; ++mt) mx = fmaxf(mx, fmaxf(fmaxf(s[mt][0], s[mt][1]), fmaxf(s[mt][2], s[mt][3])));
        mx = fmaxf(mx, __shfl_xor(mx, 16)); mx = fmaxf(mx, __shfl_xor(mx, 32));
        float l = 0.f;
#pragma unroll
        for (int mt = 0; mt < 16; ++mt) {
#pragma unroll
            for (int jj = 0; jj < 4; ++jj) { const float pv = __expf(s[mt][jj] - mx); s[mt][jj] = pv; l += pv; }
        }
        l += __shfl_xor(l, 16); l += __shfl_xor(l, 32);
        const float il = 1.0f / l;
        bf16x8 bp[8];
#pragma unroll
        for (int k2 = 0; k2 < 8; ++k2) {
            u32x4 w; w[0] = cvt_pk_bf16(s[2 * k2][0], s[2 * k2][1]); w[1] = cvt_pk_bf16(s[2 * k2][2], s[2 * k2][3]);
            w[2] = cvt_pk_bf16(s[2 * k2 + 1][0], s[2 * k2 + 1][1]); w[3] = cvt_pk_bf16(s[2 * k2 + 1][2], s[2 * k2 + 1][3]);
            bp[k2] = __builtin_bit_cast(bf16x8, w);
        }
        const bf16_t* vb = VmemT + ((size_t)(b * 4 + h) * 256) * 256;
#pragma unroll
        for (int dt = 0; dt < 16; ++dt) {
            f32x4 o = {0.f, 0.f, 0.f, 0.f};
#pragma unroll
            for (int k2 = 0; k2 < 8; ++k2) {
                const u32x2 lo = *(const u32x2*)(vb + (size_t)(dt * 16 + fr) * 256 + (2 * k2) * 16 + fq * 4);
                const u32x2 hi = *(const u32x2*)(vb + (size_t)(dt * 16 + fr) * 256 + (2 * k2 + 1) * 16 + fq * 4);
                u32x4 w; w[0] = lo[0]; w[1] = lo[1]; w[2] = hi[0]; w[3] = hi[1];
                o = __builtin_amdgcn_mfma_f32_16x16x32_bf16(__builtin_bit_cast(bf16x8, w), bp[k2], o, 0, 0, 0);
            }
            u32x2 w; w[0] = cvt_pk_bf16(o[0] * il, o[1] * il); w[1] = cvt_pk_bf16(o[2] * il, o[3] * il);
            *(u32x2*)(O + tok * 1024 + h * 256 + dt * 16 + fq * 4) = w;
        }
    }
}

constexpr int PH_PER_GROUP = 35, N_PHASES = 2 + NGRP * PH_PER_GROUP;

DEV void run_phase(const Params& p, const int ph) {
    unsigned char* ws = p.ws;
#ifndef DIS_SETUP
    if (ph == 0) { setup_phase(p); return; }
#endif
    bf16_t* H = (bf16_t*)(ws + WS_H); bf16_t* HID = (bf16_t*)(ws + WS_HID); bf16_t* PROJ = (bf16_t*)(ws + WS_PROJ);
    float* F = (float*)(ws + WS_F); bf16_t* MIXB = (bf16_t*)(ws + WS_MIXB); bf16_t* QB = (bf16_t*)(ws + WS_QB); bf16_t* OB = (bf16_t*)(ws + WS_OB);
    bf16_t* CV = (bf16_t*)(ws + WS_CV); bf16_t* RT = (bf16_t*)(ws + WS_RT);
    float* KVST = (float*)(ws + WS_KVST); bf16_t* PREV = (bf16_t*)(ws + WS_PREV);
    const float2* rot = (const float2*)(ws + WS_ROT);
    GemmDesc gd{};
    int kind = 0;
    int g = 0, l = 0, s = 0;
    if (ph == 1) {
        gd.A = (const bf16_t*)(ws + WS_MEMN); gd.Bt = (const bf16_t*)(ws + WS_WT) + O_KV; gd.M = 2 * 2304; gd.N = 2048; gd.K = 1024; gd.epi = EPI_KV;
        gd.out = ws + WS_KMEM; gd.out2 = (bf16_t*)(ws + WS_VMEMT); gd.bt_layer_stride = WL;
    } else {
        const int idx = ph - 2; g = idx / PH_PER_GROUP; const int r = idx - g * PH_PER_GROUP;
        if (r < 18) { l = 0; s = r; } else { l = 1; s = r - 17; }
    }
    const int S = (g < 2) ? 4096 : 16384;
    const bf16_t* W = (const bf16_t*)(ws + WS_WT) + (size_t)l * WL;
    const float* ng = p.in[4] + (size_t)l * 8 * 1024;
    const float* xin = (g < 2) ? p.in[0] + (size_t)g * TG * 1024 : p.in[1];
    float* X = p.out + (size_t)g * TG * 1024;
    const float* rw_src = X; const float* rw_F = nullptr; float rw_scale = 1.f; const float* rw_gpost = nullptr; const float* rw_gnext = nullptr;
    if (ph >= 2) {
        switch (s) {
        case 0: kind = 1; rw_src = xin; rw_gnext = ng + 0 * 1024; break;
        case 1: gd.A = H; gd.Bt = W + O_GU1; gd.M = TG; gd.N = 5632; gd.K = 1024; gd.epi = EPI_SWIGLU; gd.out = HID; break;
        case 2: gd.A = HID; gd.Bt = W + O_D1; gd.M = TG; gd.N = 1024; gd.K = 2816; gd.epi = EPI_F32; gd.out = F; break;
        case 3: kind = 1; rw_F = F; rw_scale = 0.5f; rw_gpost = ng + 1 * 1024; rw_gnext = ng + 2 * 1024; break;
        case 4: gd.A = H; gd.Bt = W + O_IN; gd.M = TG; gd.N = PC; gd.K = 1024; gd.epi = EPI_PROJ; gd.out = PROJ; gd.gate_b = p.in[17] + (size_t)l * 2048; break;
        case 5: kind = 2; break;
        case 6: kind = 3; break;
        case 7: kind = 4; break;
        case 8: gd.A = CV; gd.Bt = W + O_PW; gd.M = TG; gd.N = 1024; gd.K = 512; gd.epi = EPI_MIX; gd.out = MIXB; gd.A2 = RT; gd.Bt2 = W + O_RO; gd.K2 = 512; gd.proj = PROJ; break;
        case 9: gd.A = MIXB; gd.Bt = W + O_MIX; gd.M = TG; gd.N = 1024; gd.K = 1024; gd.epi = EPI_F32; gd.out = F; break;
        case 10: kind = 1; rw_F = F; rw_scale = 1.f; rw_gpost = ng + 3 * 1024; rw_gnext = ng + 4 * 1024; break;
        case 11: gd.A = H; gd.Bt = W + O_Q; gd.M = TG; gd.N = 1024; gd.K = 1024; gd.epi = EPI_BF16; gd.out = QB; break;
        case 12: kind = 5; break;
        case 13: gd.A = OB; gd.Bt = W + O_O; gd.M = TG; gd.N = 1024; gd.K = 1024; gd.epi = EPI_F32; gd.out = F; break;
        case 14: kind = 1; rw_F = F; rw_scale = 1.f; rw_gpost = ng + 5 * 1024; rw_gnext = ng + 6 * 1024; break;
        case 15: gd.A = H; gd.Bt = W + O_GU2; gd.M = TG; gd.N = 5632; gd.K = 1024; gd.epi = EPI_SWIGLU; gd.out = HID; break;
        case 16: gd.A = HID; gd.Bt = W + O_D2; gd.M = TG; gd.N = 1024; gd.K = 2816; gd.epi = EPI_F32; gd.out = F; break;
        default: kind = 1; rw_F = F; rw_scale = 0.5f; rw_gpost = ng + 7 * 1024; rw_gnext = (l == 0) ? p.in[4] + (size_t)8 * 1024 : nullptr; break;
        }
    }
    if (kind == 0) {
#ifndef DIS_GEMM
        switch (gd.epi) {
        case EPI_F32: gemm_phase<EPI_F32>(gd); break;
        case EPI_BF16: gemm_phase<EPI_BF16>(gd); break;
        case EPI_SWIGLU: gemm_phase<EPI_SWIGLU>(gd); break;
        case EPI_PROJ: gemm_phase<EPI_PROJ>(gd); break;
        case EPI_MIX: gemm_phase<EPI_MIX>(gd); break;
        default: gemm_phase<EPI_KV>(gd); break;
        }
#endif
    }
    else if (kind == 1) rowwise_phase(rw_src, X, rw_F, rw_scale, rw_gpost, rw_gnext, H);
#ifndef DIS_REST
    else if (kind == 2) {
        conv_phase(PROJ, CV, p.in[8] + (size_t)l * 31 * 512, p.in[9] + l * 512, p.in[10] + l * 512, p.in[11] + l * 512, S);
        r1_phase(PROJ, rot, KVST, p.in[13] + l * 8, p.in[14] + l * 8, S);
    } else if (kind == 3) r2_phase(KVST, PREV, p.in[13] + l * 8, p.in[14] + l * 8, S);
    else if (kind == 4) r3_phase(PROJ, rot, PREV, RT, p.in[13] + l * 8, p.in[14] + l * 8, p.in[15] + l * 512, S);
    else attn_phase(QB, (const bf16_t*)(ws + WS_KMEM) + (size_t)l * 2304 * 1024, (const bf16_t*)(ws + WS_VMEMT) + (size_t)l * 2304 * 1024, OB, S, g);
#endif
}

__global__ void __launch_bounds__(NTHREADS) mega(const Params p) {
    for (int ph = p.ph_begin; ph < p.ph_end; ++ph) {
        run_phase(p, ph);
        if (ph + 1 < p.ph_end) cg::this_grid().sync();
    }
}

extern "C" void kernel_launch(void* const* d_in, const int* in_sizes, int n_in, void* d_out, int out_size, void* d_ws, size_t ws_size, hipStream_t stream) {
    static int grid = 0;
    if (grid == 0) {
        if (n_in != 25 || ws_size < WS_END) { fprintf(stderr, "kernel_launch: need 25 inputs and >= %zu bytes of workspace (got %d, %zu)\n", (size_t)WS_END, n_in, ws_size); grid = -1; return; }
        int dev = 0, cus = 0, per_cu = 0;
        hipGetDevice(&dev);
        hipDeviceGetAttribute(&cus, hipDeviceAttributeMultiprocessorCount, dev);
        if (hipFuncSetAttribute((const void*)mega, hipFuncAttributeMaxDynamicSharedMemorySize, LDS_BYTES) != hipSuccess) { fprintf(stderr, "kernel_launch: hipFuncSetAttribute failed\n"); grid = -1; return; }
        hipOccupancyMaxActiveBlocksPerMultiprocessor(&per_cu, (const void*)mega, NTHREADS, LDS_BYTES);
        if (per_cu < 1) per_cu = 1;
        (void)hipGetLastError();
        grid = cus * 1;
    }
    if (grid < 0) return;
    Params p{};
    for (int i = 0; i < 25; ++i) p.in[i] = (const float*)d_in[i];
    p.out = (float*)d_out; p.ws = (unsigned char*)d_ws;
    for (int i = 0; i < 32; ++i) p.inv_freq[i] = (float)pow(10000.0, -(double)i / 32.0);
#if SINGLE_LAUNCH
    p.ph_begin = 0; p.ph_end = N_PHASES;
    void* args[] = {&p};
    hipError_t e = hipLaunchCooperativeKernel((const void*)mega, dim3(grid), dim3(NTHREADS), args, LDS_BYTES, stream);
    if (e != hipSuccess) fprintf(stderr, "cooperative launch failed: %s (grid %d)\n", hipGetErrorString(e), grid);
#else
    for (int ph = 0; ph < N_PHASES; ++ph) {
        p.ph_begin = ph; p.ph_end = ph + 1;
        hipLaunchKernelGGL(mega, dim3(grid), dim3(NTHREADS), LDS_BYTES, stream, p);
    }
#endif
}
```

```cpp
#include <hip/hip_runtime.h>
#include <hip/hip_bf16.h>
#include <hip/hip_cooperative_groups.h>
#include <cstdio>
#include <cmath>
namespace cg = cooperative_groups;

#ifndef PROBE
#define PROBE 0
#endif
#ifndef SINGLE_LAUNCH
#define SINGLE_LAUNCH 1
#endif

#define DEV __device__ __forceinline__
typedef unsigned short bf16_t;
typedef short bf16x8 __attribute__((ext_vector_type(8)));
typedef short bf16x4 __attribute__((ext_vector_type(4)));
typedef float f32x4 __attribute__((ext_vector_type(4)));
typedef unsigned u32x4 __attribute__((ext_vector_type(4)));
typedef unsigned u32x2 __attribute__((ext_vector_type(2)));

constexpr int TG = 16384;
constexpr int NGRP = 3;
constexpr int PC = 5120;
constexpr int C_Q = 1024, C_K = 1536, C_V = 2048, C_G = 2560, C_GC = 3072, C_GR = 4096;
constexpr int NTHREADS = 512;
constexpr int LDS_BYTES = 131072 + 16;

constexpr size_t O_GU1 = 0, O_D1 = 5767168, O_IN = 8650752, O_PW = 13893632, O_RO = 14417920, O_MIX = 14942208,
                 O_Q = 15990784, O_KV = 17039360, O_O = 19136512, O_GU2 = 20185088, O_D2 = 25952256, WL = 28835840;
constexpr size_t WS_WT = 0;
constexpr size_t WS_ROT = WS_WT + 2 * WL * 2;
constexpr size_t WS_MEMN = WS_ROT + (size_t)16384 * 32 * 8;
constexpr size_t WS_KMEM = WS_MEMN + (size_t)2 * 2304 * 1024 * 2;
constexpr size_t WS_VMEMT = WS_KMEM + (size_t)2 * 2304 * 1024 * 2;
constexpr size_t WS_H = WS_VMEMT + (size_t)2 * 2304 * 1024 * 2;
constexpr size_t WS_HID = WS_H + (size_t)TG * 1024 * 2;
constexpr size_t WS_KVST = WS_HID;
constexpr size_t WS_PREV = WS_HID + 33554432;
constexpr size_t WS_MIXB = WS_HID + 50331648;
constexpr size_t WS_PROJ = WS_HID + (size_t)TG * 2816 * 2;
constexpr size_t WS_F = WS_PROJ;
constexpr size_t WS_QB = WS_PROJ + 67108864;
constexpr size_t WS_OB = WS_PROJ + 100663296;
constexpr size_t WS_CV = WS_PROJ + (size_t)TG * PC * 2;
constexpr size_t WS_RT = WS_CV + (size_t)TG * 512 * 2;
constexpr size_t WS_BAR = WS_RT + (size_t)TG * 512 * 2;
constexpr size_t WS_END = WS_BAR + 16384;

struct Params {
    const float* in[25];
    float* out;
    unsigned char* ws;
    float inv_freq[32];
    int ph_begin, ph_end;
};

extern __shared__ __attribute__((aligned(16))) unsigned char g_lds[];

DEV unsigned cvt_pk_bf16(float lo, float hi) { unsigned r; asm("v_cvt_pk_bf16_f32 %0, %1, %2" : "=v"(r) : "v"(lo), "v"(hi)); return r; }
DEV bf16_t f2bf(float v) { return (bf16_t)(cvt_pk_bf16(v, 0.f) & 0xffffu); }
DEV float bf2f(bf16_t v) { return __uint_as_float((unsigned)v << 16); }
DEV float bflo(unsigned v) { return __uint_as_float(v << 16); }
DEV float bfhi(unsigned v) { return __uint_as_float(v & 0xffff0000u); }
DEV float sigmoidf_(float x) { return __builtin_amdgcn_rcpf(1.f + __expf(-x)); }
DEV float siluf_(float x) { return x * __builtin_amdgcn_rcpf(1.f + __expf(-x)); }
DEV float wave_sum(float v) {
#pragma unroll
    for (int o = 32; o > 0; o >>= 1) v += __shfl_xor(v, o);
    return v;
}

DEV int launder_v(int v) { asm volatile("" : "+v"(v)); return v; }
DEV int launder_s(int v) { asm volatile("" : "+s"(v)); return v; }
#define TIDX launder_v((int)threadIdx.x)
#define BIDX launder_s((int)blockIdx.x)
constexpr int BM = 256, BK = 64, HALF = 128, HT = HALF * BK, NXCD = 8, WGM = 8;
DEV int lds_byte(int r, int c) {
    int st = (r >> 4) * 2 + (c >> 5), rr = r & 15, cc = c & 31, ob = rr * 64 + cc * 2;
    return st * 1024 + (ob ^ (((ob >> 9) & 1) << 5));
}
DEV void stage_rc(int b, int& R, int& C) {
    int st = b / 1024, sb = b % 1024, swz = sb ^ (((sb >> 9) & 1) << 5);
    R = (st >> 1) * 16 + swz / 64; C = (st & 1) * 32 + (swz % 64) / 2;
}

#define LAS __attribute__((address_space(3)))
enum { EPI_F32 = 0, EPI_BF16 = 1, EPI_SWIGLU = 2, EPI_PROJ = 3, EPI_MIX = 4, EPI_KV = 5 };

struct GemmDesc {
    const bf16_t* A; const bf16_t* Bt; int M, N, K, epi;
    void* out;
    const bf16_t* A2; const bf16_t* Bt2; int K2;
    const bf16_t* proj;
    const float* gate_b;
    bf16_t* out2;
    size_t bt_layer_stride;
};

template <int EPI> DEV void gemm_phase(const GemmDesc& g) {
    LAS unsigned char* lds = (LAS unsigned char*)g_lds;
    const int tid = TIDX, wid = __builtin_amdgcn_readfirstlane(tid >> 6), lane = tid & 63, wr = wid >> 2, wc = wid & 3, fr = lane & 15, fq = lane >> 4;
    const int K = g.K, nt = K / BK;
    const int nM = g.M / BM, nN = g.N / BM, nwg = nM * nN, G = gridDim.x, cblk = BIDX;
    const bool dual = (EPI == EPI_MIX);
    unsigned voff[2];
#pragma unroll
    for (int i = 0; i < 2; ++i) { int R, C; stage_rc(tid * 16 + i * 8192, R, C); voff[i] = (unsigned)(R * K + C) * 2u; }
    const size_t kstep = (size_t)(BK * 2), hstep = (size_t)HALF * K * 2, tstep = 2 * hstep;
    const unsigned ldsw = (unsigned)wid * 1024u;
    const int aoff = lds_byte(wr * 64 + fr, fq * 8), boff = lds_byte(wc * 32 + fr, fq * 8);
#define PG_SA(b, h) (((b) * 2 + (h)) * (HT * 2))
#define PG_SB(b, h) ((4 + (b) * 2 + (h)) * (HT * 2))
#define PG_STAGE(bufoff, gbase) do { _Pragma("unroll") for (int _i = 0; _i < 2; ++_i) \
        __builtin_amdgcn_global_load_lds((const unsigned*)((const char*)(gbase) + voff[_i]), (LAS unsigned*)(lds + (bufoff) + ldsw + _i * 8192), 16, 0, 0); } while (0)
#define PG_LDA(dst, b, h) do { _Pragma("unroll") for (int m = 0; m < 4; ++m) _Pragma("unroll") for (int k = 0; k < 2; ++k) dst[m][k] = *(const LAS bf16x8*)(lds + PG_SA(b, h) + aoff + m * 2048 + k * 1024); } while (0)
#define PG_LDB(dst, b, h) do { _Pragma("unroll") for (int n = 0; n < 2; ++n) _Pragma("unroll") for (int k = 0; k < 2; ++k) dst[n][k] = *(const LAS bf16x8*)(lds + PG_SB(b, h) + boff + n * 2048 + k * 1024); } while (0)
#define PG_MMA(ai, bj, Af, Bf) do { __builtin_amdgcn_s_setprio(1); _Pragma("unroll") for (int m = 0; m < 4; ++m) _Pragma("unroll") for (int n = 0; n < 2; ++n) _Pragma("unroll") for (int k = 0; k < 2; ++k) \
        acc[ai][bj][m][n] = __builtin_amdgcn_mfma_f32_16x16x32_bf16(Bf[n][k], Af[m][k], acc[ai][bj][m][n], 0, 0, 0); __builtin_amdgcn_s_setprio(0); } while (0)
#define PG_WAIT_V(n) asm volatile("s_waitcnt vmcnt(" #n ")" ::: "memory")
#define PG_WAIT_L(n) asm volatile("s_waitcnt lgkmcnt(" #n ")" ::: "memory")
#define PG_BAR __builtin_amdgcn_s_barrier()
#define PG_SCHED __builtin_amdgcn_sched_barrier(0)
#define PG_NEXT(i, pm_, pn_, seg_, ok_) do { const int _ti = dual ? ((i) >> 1) : (i); seg_ = dual ? ((i) & 1) : 0; const int _L = _ti * G + cblk; ok_ = _L < nwg; \
        if (ok_) { int wgid = _L; { const int q = nwg / NXCD, r = nwg % NXCD, xcd = wgid % NXCD, off = wgid / NXCD; wgid = (xcd < r ? xcd * (q + 1) : r * (q + 1) + (xcd - r) * q) + off; } \
          const int nig = WGM * nN, gid = wgid / nig, fm = gid * WGM, gsz = (nM - fm) < WGM ? (nM - fm) : WGM; pm_ = fm + ((wgid % nig) % gsz); pn_ = (wgid % nig) / gsz; } } while (0)
#define PG_ABASE(pm_, seg_) ((const char*)((seg_) ? g.A2 : g.A) + (size_t)(pm_) * tstep)
#define PG_BBASE(pm_, pn_, seg_) ((const char*)((seg_) ? g.Bt2 : g.Bt) + ((EPI == EPI_KV && (pm_) >= 9) ? g.bt_layer_stride * 2 : (size_t)0) + (size_t)(pn_) * tstep)
    int pm = 0, pn = 0, seg = 0, npm = 0, npn = 0, nseg = 0, ui = 0; bool ok;
    PG_NEXT(0, pm, pn, seg, ok);
    if (!ok) return;
    f32x4 acc[2][2][4][2];
#pragma unroll
    for (int a = 0; a < 2; ++a)
#pragma unroll
        for (int b = 0; b < 2; ++b)
#pragma unroll
            for (int m = 0; m < 4; ++m)
#pragma unroll
                for (int n = 0; n < 2; ++n) acc[a][b][m][n] = (f32x4){0.f, 0.f, 0.f, 0.f};
    bf16x8 At[4][2], B0[2][2], B1[2][2];
    const char* cA = PG_ABASE(pm, seg); const char* cB = PG_BBASE(pm, pn, seg);
    asm volatile("s_waitcnt vmcnt(0) lgkmcnt(0)" ::: "memory"); PG_BAR; PG_SCHED;
    PG_STAGE(PG_SB(0, 0), cB); PG_STAGE(PG_SA(0, 0), cA); PG_STAGE(PG_SB(0, 1), cB + hstep); PG_STAGE(PG_SA(0, 1), cA + hstep);
    if (wr == 1) PG_BAR;
    PG_WAIT_V(4); PG_BAR;
    PG_STAGE(PG_SB(1, 0), cB + kstep); PG_STAGE(PG_SA(1, 0), cA + kstep); PG_STAGE(PG_SB(1, 1), cB + hstep + kstep);
    PG_WAIT_V(6); PG_BAR;
    for (;;) {
        bool has_next; PG_NEXT(ui + 1, npm, npn, nseg, has_next);
        const char* nA = has_next ? PG_ABASE(npm, nseg) : cA; const char* nB = has_next ? PG_BBASE(npm, npn, nseg) : cB;
        for (int t = 0; t < nt; t += 2) {
            const bool last = (t == nt - 2);
            const char* a1 = cA + (size_t)(t + 1) * kstep;
            const char* a2 = last ? nA : cA + (size_t)(t + 2) * kstep; const char* b2 = last ? nB : cB + (size_t)(t + 2) * kstep;
            const char* a3 = a2 + kstep; const char* b3 = b2 + kstep;
            PG_LDB(B0, 0, 0); PG_SCHED; PG_LDA(At, 0, 0); PG_STAGE(PG_SA(1, 1), a1 + hstep);
            PG_WAIT_L(8); PG_BAR; PG_WAIT_L(0); PG_MMA(0, 0, At, B0); PG_BAR; PG_SCHED;
            PG_LDB(B1, 0, 1); PG_STAGE(PG_SB(0, 0), b2);
            PG_BAR; PG_WAIT_L(0); PG_MMA(0, 1, At, B1); PG_BAR;
            PG_LDA(At, 0, 1); PG_STAGE(PG_SA(0, 0), a2);
            PG_BAR; PG_WAIT_L(0); PG_MMA(1, 0, At, B0); PG_BAR; PG_SCHED;
            PG_STAGE(PG_SB(0, 1), b2 + hstep);
            PG_WAIT_V(6); PG_BAR; PG_MMA(1, 1, At, B1); PG_BAR;
            PG_LDB(B0, 1, 0); PG_SCHED; PG_LDA(At, 1, 0); PG_STAGE(PG_SA(0, 1), a2 + hstep);
            PG_WAIT_L(8); PG_BAR; PG_WAIT_L(0); PG_MMA(0, 0, At, B0); PG_BAR; PG_SCHED;
            PG_LDB(B1, 1, 1); PG_STAGE(PG_SB(1, 0), b3);
            PG_BAR; PG_WAIT_L(0); PG_MMA(0, 1, At, B1); PG_BAR;
            PG_LDA(At, 1, 1); PG_STAGE(PG_SA(1, 0), a3);
            PG_BAR; PG_WAIT_L(0); PG_MMA(1, 0, At, B0); PG_BAR; PG_SCHED;
            PG_STAGE(PG_SB(1, 1), b3 + hstep);
            PG_WAIT_V(6); PG_BAR; PG_MMA(1, 1, At, B1); PG_BAR;
        }
        const int brow = pm * BM, bcol = pn * BM;
        const int r0 = brow + wr * 64 + fr, c0 = bcol + wc * 32 + fq * 4;
        if (EPI == EPI_MIX) {
          if (seg == 0) {
#pragma unroll
            for (int ai = 0; ai < 2; ++ai)
#pragma unroll
                for (int m = 0; m < 4; ++m) {
                    const bf16_t* pr = g.proj + (size_t)(r0 + ai * 128 + m * 16) * PC + c0;
#pragma unroll
                    for (int bj = 0; bj < 2; ++bj)
#pragma unroll
                        for (int n = 0; n < 2; ++n) {
                            const u32x2 gc = *(const u32x2*)(pr + C_GC + bj * 128 + n * 16), gr = *(const u32x2*)(pr + C_GR + bj * 128 + n * 16);
                            f32x4 v = acc[ai][bj][m][n];
                            v[0] *= bflo(gc[0]) * __builtin_amdgcn_rcpf(bflo(gr[0])); v[1] *= bfhi(gc[0]) * __builtin_amdgcn_rcpf(bfhi(gr[0]));
                            v[2] *= bflo(gc[1]) * __builtin_amdgcn_rcpf(bflo(gr[1])); v[3] *= bfhi(gc[1]) * __builtin_amdgcn_rcpf(bfhi(gr[1]));
                            acc[ai][bj][m][n] = v;
                        }
                }
          } else {
#pragma unroll
            for (int ai = 0; ai < 2; ++ai)
#pragma unroll
                for (int m = 0; m < 4; ++m) {
                    const size_t row = (size_t)(r0 + ai * 128 + m * 16);
                    const bf16_t* pr = g.proj + row * PC + c0;
                    bf16_t* o = (bf16_t*)g.out + row * 1024 + c0;
#pragma unroll
                    for (int bj = 0; bj < 2; ++bj)
#pragma unroll
                        for (int n = 0; n < 2; ++n) {
                            const u32x2 gr = *(const u32x2*)(pr + C_GR + bj * 128 + n * 16);
                            const f32x4 v = acc[ai][bj][m][n];
                            u32x2 w; w[0] = cvt_pk_bf16(v[0] * bflo(gr[0]), v[1] * bfhi(gr[0])); w[1] = cvt_pk_bf16(v[2] * bflo(gr[1]), v[3] * bfhi(gr[1]));
                            *(u32x2*)(o + bj * 128 + n * 16) = w;
                        }
                }
          }
        } else if (EPI == EPI_F32) {
#pragma unroll
            for (int ai = 0; ai < 2; ++ai)
#pragma unroll
                for (int m = 0; m < 4; ++m) {
                    float* o = (float*)g.out + (size_t)(r0 + ai * 128 + m * 16) * g.N + c0;
#pragma unroll
                    for (int bj = 0; bj < 2; ++bj)
#pragma unroll
                        for (int n = 0; n < 2; ++n) *(f32x4*)(o + bj * 128 + n * 16) = acc[ai][bj][m][n];
                }
        } else if (EPI == EPI_BF16 || EPI == EPI_PROJ) {
            const bool sg = (EPI == EPI_PROJ) && (bcol >= C_GC);
#pragma unroll
            for (int ai = 0; ai < 2; ++ai)
#pragma unroll
                for (int m = 0; m < 4; ++m) {
                    bf16_t* o = (bf16_t*)g.out + (size_t)(r0 + ai * 128 + m * 16) * g.N + c0;
#pragma unroll
                    for (int bj = 0; bj < 2; ++bj)
#pragma unroll
                        for (int n = 0; n < 2; ++n) {
                            f32x4 v = acc[ai][bj][m][n];
                            if (sg) {
                                const f32x4 b = *(const f32x4*)(g.gate_b + (c0 - C_GC) + bj * 128 + n * 16);
#pragma unroll
                                for (int j = 0; j < 4; ++j) v[j] = sigmoidf_(v[j] + b[j]);
                            }
                            u32x2 w; w[0] = cvt_pk_bf16(v[0], v[1]); w[1] = cvt_pk_bf16(v[2], v[3]);
                            *(u32x2*)(o + bj * 128 + n * 16) = w;
                        }
                }
        } else if (EPI == EPI_SWIGLU) {
            const int hc0 = (bcol >> 1) + wc * 32 + fq * 4;
#pragma unroll
            for (int ai = 0; ai < 2; ++ai)
#pragma unroll
                for (int m = 0; m < 4; ++m) {
                    bf16_t* o = (bf16_t*)g.out + (size_t)(r0 + ai * 128 + m * 16) * (g.N >> 1) + hc0;
#pragma unroll
                    for (int n = 0; n < 2; ++n) {
                        const f32x4 ga = acc[ai][0][m][n], up = acc[ai][1][m][n];
                        u32x2 w; w[0] = cvt_pk_bf16(siluf_(ga[0]) * up[0], siluf_(ga[1]) * up[1]); w[1] = cvt_pk_bf16(siluf_(ga[2]) * up[2], siluf_(ga[3]) * up[3]);
                        *(u32x2*)(o + n * 16) = w;
                    }
                }
        } else {
#pragma unroll
            for (int ai = 0; ai < 2; ++ai)
#pragma unroll
                for (int m = 0; m < 4; ++m) {
                    const int row = r0 + ai * 128 + m * 16;
#pragma unroll
                    for (int bj = 0; bj < 2; ++bj)
#pragma unroll
                        for (int n = 0; n < 2; ++n) {
                            const f32x4 v = acc[ai][bj][m][n];
                            const int col = c0 + bj * 128 + n * 16;
                            if (bcol < 1024) {
                                u32x2 w; w[0] = cvt_pk_bf16(v[0], v[1]); w[1] = cvt_pk_bf16(v[2], v[3]);
                                *(u32x2*)((bf16_t*)g.out + (size_t)row * 1024 + col) = w;
                            } else {
                                const int hh = (col - 1024) >> 8, d = (col - 1024) & 255, lb = row >> 8, mm = row & 255;
                                bf16_t* o = g.out2 + ((size_t)(lb * 4 + hh) * 256 + d) * 256 + mm;
#pragma unroll
                                for (int j = 0; j < 4; ++j) o[j * 256] = f2bf(v[j]);
                            }
                        }
                }
        }
        if (!has_next) break;
        if (!(dual && seg == 0)) {
#pragma unroll
            for (int a = 0; a < 2; ++a)
#pragma unroll
                for (int b = 0; b < 2; ++b)
#pragma unroll
                    for (int m = 0; m < 4; ++m)
#pragma unroll
                        for (int n = 0; n < 2; ++n) acc[a][b][m][n] = (f32x4){0.f, 0.f, 0.f, 0.f};
        }
        pm = npm; pn = npn; seg = nseg; cA = nA; cB = nB; ++ui;
    }
    PG_WAIT_V(0);
    if (wr == 0) PG_BAR;
    PG_BAR;
#undef PG_SA
#undef PG_SB
#undef PG_STAGE
#undef PG_LDA
#undef PG_LDB
#undef PG_MMA
#undef PG_NEXT
#undef PG_ABASE
#undef PG_BBASE
}

DEV void transpose_mat(const float* __restrict__ src, const int K, const int N, bf16_t* __restrict__ dst, const int perm, const float scale) {
    float* tile = (float*)g_lds;
    const int nkt = K / 64, ntile = nkt * (N / 64), tid = TIDX, bid = BIDX;
    for (int t = bid; t < ntile; t += gridDim.x) {
        const int rt = t / nkt, kt = t - rt * nkt, rho0 = rt * 64;
        const int cbase = perm ? (((rho0 & 255) >> 7) * 2816 + (rho0 >> 8) * 128 + (rho0 & 127)) : rho0;
        __syncthreads();
#pragma unroll
        for (int i = 0; i < 8; ++i) { const int kk = (tid >> 6) + 8 * i, cc = tid & 63; tile[kk * 65 + cc] = src[(size_t)(kt * 64 + kk) * N + cbase + cc]; }
        __syncthreads();
#pragma unroll
        for (int i = 0; i < 4; ++i) {
            const int rr = (tid >> 5) + 16 * i, k2 = (tid & 31) * 2;
            *(unsigned*)(dst + (size_t)(rho0 + rr) * K + kt * 64 + k2) = cvt_pk_bf16(tile[k2 * 65 + rr] * scale, tile[(k2 + 1) * 65 + rr] * scale);
        }
    }
}

DEV void setup_phase(const Params& p) {
    bf16_t* wt = (bf16_t*)(p.ws + WS_WT);
    for (int l = 0; l < 2; ++l) {
        bf16_t* w = wt + (size_t)l * WL;
        transpose_mat(p.in[5] + (size_t)l * 1024 * 5632, 1024, 5632, w + O_GU1, 1, 1.f);
        transpose_mat(p.in[6] + (size_t)l * 2816 * 1024, 2816, 1024, w + O_D1, 0, 1.f);
        transpose_mat(p.in[7] + (size_t)l * 1024 * 5120, 1024, 5120, w + O_IN, 0, 1.f);
        transpose_mat(p.in[12] + (size_t)l * 512 * 1024, 512, 1024, w + O_PW, 0, 1.f);
        transpose_mat(p.in[16] + (size_t)l * 512 * 1024, 512, 1024, w + O_RO, 0, 1.f);
        transpose_mat(p.in[18] + (size_t)l * 1024 * 1024, 1024, 1024, w + O_MIX, 0, 1.f);
        transpose_mat(p.in[20] + (size_t)l * 1024 * 1024, 1024, 1024, w + O_Q, 0, 0.0625f);
        transpose_mat(p.in[21] + (size_t)l * 1024 * 2048, 1024, 2048, w + O_KV, 0, 1.f);
        transpose_mat(p.in[22] + (size_t)l * 1024 * 1024, 1024, 1024, w + O_O, 0, 1.f);
        transpose_mat(p.in[23] + (size_t)l * 1024 * 5632, 1024, 5632, w + O_GU2, 1, 1.f);
        transpose_mat(p.in[24] + (size_t)l * 2816 * 1024, 2816, 1024, w + O_D2, 0, 1.f);
    }
    float2* rot = (float2*)(p.ws + WS_ROT);
    const int tid0 = TIDX, bid0 = BIDX;
    for (int idx = bid0 * NTHREADS + tid0; idx < 16384 * 32; idx += gridDim.x * NTHREADS) {
        const int pos = idx >> 5, i = idx & 31;
        const float ang = (float)pos * p.inv_freq[i];
        double rev = (double)ang * 0.15915494309189535;
        rev -= floor(rev);
        const float fr = (float)rev;
        rot[idx] = make_float2(__builtin_amdgcn_cosf(fr), __builtin_amdgcn_sinf(fr));
    }
    bf16_t* memn = (bf16_t*)(p.ws + WS_MEMN);
    const int lane = tid0 & 63, gw = bid0 * 8 + (tid0 >> 6), nw = gridDim.x * 8;
    for (int rr = gw; rr < 2 * 2304; rr += nw) {
        const int l = rr / 2304, row = rr - l * 2304;
        const float* src = row < 2048 ? p.in[2] + (size_t)row * 1024 : p.in[3] + (size_t)(row - 2048) * 1024;
        const float* mg = p.in[19] + l * 1024;
        f32x4 x[4]; float ss = 0.f;
#pragma unroll
        for (int i = 0; i < 4; ++i) { x[i] = *(const f32x4*)(src + i * 256 + lane * 4); ss += x[i][0] * x[i][0] + x[i][1] * x[i][1] + x[i][2] * x[i][2] + x[i][3] * x[i][3]; }
        ss = wave_sum(ss);
        const float r = 1.0f / sqrtf(ss * (1.f / 1024.f) + 1e-6f);
#pragma unroll
        for (int i = 0; i < 4; ++i) {
            const f32x4 gg = *(const f32x4*)(mg + i * 256 + lane * 4);
            u32x2 w; w[0] = cvt_pk_bf16(x[i][0] * r * gg[0], x[i][1] * r * gg[1]); w[1] = cvt_pk_bf16(x[i][2] * r * gg[2], x[i][3] * r * gg[3]);
            *(u32x2*)(memn + (size_t)rr * 1024 + i * 256 + lane * 4) = w;
        }
    }
}

DEV void rowwise_phase(const float* __restrict__ Xsrc, float* __restrict__ X, const float* __restrict__ F, const float scale,
                       const float* __restrict__ gpost, const float* __restrict__ gnext, bf16_t* __restrict__ H) {
    const int tid0 = TIDX, bid0 = BIDX;
    const int lane = tid0 & 63, gw = bid0 * 8 + (tid0 >> 6), nw = gridDim.x * 8;
    for (int row = gw; row < TG; row += nw) {
        f32x4 x[4];
#pragma unroll
        for (int i = 0; i < 4; ++i) x[i] = *(const f32x4*)(Xsrc + (size_t)row * 1024 + i * 256 + lane * 4);
        if (F) {
            f32x4 f[4]; float ss = 0.f;
#pragma unroll
            for (int i = 0; i < 4; ++i) { f[i] = *(const f32x4*)(F + (size_t)row * 1024 + i * 256 + lane * 4); ss += f[i][0] * f[i][0] + f[i][1] * f[i][1] + f[i][2] * f[i][2] + f[i][3] * f[i][3]; }
            ss = wave_sum(ss);
            const float r = scale / sqrtf(ss * (1.f / 1024.f) + 1e-6f);
#pragma unroll
            for (int i = 0; i < 4; ++i) { const f32x4 gp = *(const f32x4*)(gpost + i * 256 + lane * 4); x[i] += f[i] * r * gp; }
        }
#pragma unroll
        for (int i = 0; i < 4; ++i) *(f32x4*)(X + (size_t)row * 1024 + i * 256 + lane * 4) = x[i];
        if (gnext) {
            float ss = 0.f;
#pragma unroll
            for (int i = 0; i < 4; ++i) ss += x[i][0] * x[i][0] + x[i][1] * x[i][1] + x[i][2] * x[i][2] + x[i][3] * x[i][3];
            ss = wave_sum(ss);
            const float r = 1.0f / sqrtf(ss * (1.f / 1024.f) + 1e-6f);
#pragma unroll
            for (int i = 0; i < 4; ++i) {
                const f32x4 gg = *(const f32x4*)(gnext + i * 256 + lane * 4);
                u32x2 w; w[0] = cvt_pk_bf16(x[i][0] * r * gg[0], x[i][1] * r * gg[1]); w[1] = cvt_pk_bf16(x[i][2] * r * gg[2], x[i][3] * r * gg[3]);
                *(u32x2*)(H + (size_t)row * 1024 + i * 256 + lane * 4) = w;
            }
        }
    }
}

DEV void conv_phase(const bf16_t* __restrict__ PROJ, bf16_t* __restrict__ CV, const float* __restrict__ dw_w, const float* __restrict__ dw_b,
                    const float* __restrict__ ln_g, const float* __restrict__ ln_b, const int S) {
    bf16_t* us = (bf16_t*)g_lds;
    float* red = (float*)(g_lds + 62 * 512 * 2);
    float* stat = red + 8 * 32 * 2;
    const int tid = TIDX, bid = BIDX, c = tid, wid = tid >> 6, lane = tid & 63;
    float w[31];
#pragma unroll
    for (int k = 0; k < 31; ++k) w[k] = dw_w[k * 512 + c];
    const float bias = dw_b[c], lg = ln_g[c], lb = ln_b[c];
    for (int u = bid; u < TG / 32; u += gridDim.x) {
        const int t0 = u * 32, seq = t0 / S, pos0 = t0 - seq * S;
        __syncthreads();
        const int cg8 = (tid & 63) * 8;
#pragma unroll
        for (int it = 0; it < 8; ++it) {
            const int tt = it * 8 + (tid >> 6);
            if (tt < 62) {
                const int pos = pos0 - 15 + tt;
                u32x4 o = {0u, 0u, 0u, 0u};
                if (pos >= 0 && pos < S) {
                    const bf16_t* pr = PROJ + (size_t)(seq * S + pos) * PC;
                    const u32x4 v = *(const u32x4*)(pr + cg8), gt = *(const u32x4*)(pr + 512 + cg8);
#pragma unroll
                    for (int q = 0; q < 4; ++q) o[q] = cvt_pk_bf16(bflo(v[q]) * sigmoidf_(bflo(gt[q])), bfhi(v[q]) * sigmoidf_(bfhi(gt[q])));
                }
                *(u32x4*)(us + tt * 512 + cg8) = o;
            }
        }
        __syncthreads();
        float acc[32];
#pragma unroll
        for (int seg = 0; seg < 4; ++seg) {
#pragma unroll
            for (int s = 0; s < 8; ++s) acc[seg * 8 + s] = bias;
#pragma unroll
            for (int kk = 0; kk < 38; ++kk) {
                const float uv = bf2f(us[(seg * 8 + kk) * 512 + c]);
#pragma unroll
                for (int s = 0; s < 8; ++s) { const int k = kk - s; if (k >= 0 && k < 31) acc[seg * 8 + s] += w[k] * uv; }
            }
        }
#pragma unroll
        for (int s = 0; s < 32; ++s) {
            const float s1 = wave_sum(acc[s]), s2 = wave_sum(acc[s] * acc[s]);
            if (lane == 0) { red[(wid * 32 + s) * 2] = s1; red[(wid * 32 + s) * 2 + 1] = s2; }
        }
        __syncthreads();
        if (tid < 32) {
            float s1 = 0.f, s2 = 0.f;
#pragma unroll
            for (int q = 0; q < 8; ++q) { s1 += red[(q * 32 + tid) * 2]; s2 += red[(q * 32 + tid) * 2 + 1]; }
            const float mean = s1 * (1.f / 512.f), var = fmaxf(s2 * (1.f / 512.f) - mean * mean, 0.f);
            stat[tid * 2] = mean; stat[tid * 2 + 1] = 1.0f / sqrtf(var + 1e-6f);
        }
        __syncthreads();
#pragma unroll
        for (int s = 0; s < 32; ++s) {
            const float y = (acc[s] - stat[s * 2]) * stat[s * 2 + 1] * lg + lb;
            CV[(size_t)(t0 + s) * 512 + c] = f2bf(siluf_(y));
        }
    }
}

template <int I> DEV float bfel(const u32x4& v) { return (I & 1) ? bfhi(v[I >> 1]) : bflo(v[I >> 1]); }

DEV void r1_phase(const bf16_t* __restrict__ PROJ, const float2* __restrict__ rot, float* __restrict__ KVST,
                  const float* __restrict__ dec_f, const float* __restrict__ dec_b, const int S) {
    bf16_t* vT = (bf16_t*)g_lds; bf16_t* kTf = vT + 64 * 136; bf16_t* kTb = kTf + 64 * 136;
    const int tid = TIDX, bid = BIDX, wid = tid >> 6, lane = tid & 63, fr = lane & 15, fq = lane >> 4;
    const int j = tid >> 2, dq = (tid & 3) * 8;
    for (int unit = bid; unit < (TG / 128) * 8; unit += gridDim.x) {
        const int cidx = unit >> 3, h = unit & 7, t0 = cidx * 128, seq = t0 / S, pos0 = t0 - seq * S;
        const float lgf2 = -expf(dec_f[h]) * 1.4426950408889634f, lgb2 = -expf(dec_b[h]) * 1.4426950408889634f;
        __syncthreads();
        const bf16_t* pr = PROJ + (size_t)(t0 + j) * PC;
        const u32x4 k1 = *(const u32x4*)(pr + C_K + h * 64 + dq), k2 = *(const u32x4*)(pr + C_K + h * 64 + 32 + dq);
        const float2* rp = rot + (size_t)(pos0 + j) * 32 + dq;
        const float df = exp2f(lgf2 * (float)(127 - j)), db = exp2f(lgb2 * (float)j);
#pragma unroll
        for (int i = 0; i < 8; ++i) {
            const float a = (i & 1) ? bfhi(k1[i >> 1]) : bflo(k1[i >> 1]), b = (i & 1) ? bfhi(k2[i >> 1]) : bflo(k2[i >> 1]);
            const float2 cs = rp[i];
            const float r1 = (a * cs.x - b * cs.y) * 0.125f, r2 = (a * cs.y + b * cs.x) * 0.125f;
            kTf[(dq + i) * 136 + j] = f2bf(r1 * df); kTf[(32 + dq + i) * 136 + j] = f2bf(r2 * df);
            kTb[(dq + i) * 136 + j] = f2bf(r1 * db); kTb[(32 + dq + i) * 136 + j] = f2bf(r2 * db);
        }
        {
            const int e0 = (tid & 3) * 16;
            const u32x4 v1 = *(const u32x4*)(pr + C_V + h * 64 + e0), v2 = *(const u32x4*)(pr + C_V + h * 64 + e0 + 8);
#pragma unroll
            for (int i = 0; i < 4; ++i) {
                vT[(e0 + 2 * i) * 136 + j] = (bf16_t)(v1[i] & 0xffffu); vT[(e0 + 2 * i + 1) * 136 + j] = (bf16_t)(v1[i] >> 16);
                vT[(e0 + 8 + 2 * i) * 136 + j] = (bf16_t)(v2[i] & 0xffffu); vT[(e0 + 8 + 2 * i + 1) * 136 + j] = (bf16_t)(v2[i] >> 16);
            }
        }
        __syncthreads();
        const int dir = wid >> 2, et = wid & 3;
        const bf16_t* kT = dir ? kTb : kTf;
        bf16x8 a[4];
#pragma unroll
        for (int ks = 0; ks < 4; ++ks) a[ks] = *(const bf16x8*)(vT + (et * 16 + fr) * 136 + ks * 32 + fq * 8);
        float* o = KVST + ((size_t)(cidx * 8 + h) * 2 + dir) * 4096;
#pragma unroll
        for (int dt = 0; dt < 4; ++dt) {
            f32x4 acc = {0.f, 0.f, 0.f, 0.f};
#pragma unroll
            for (int ks = 0; ks < 4; ++ks) {
                const bf16x8 b = *(const bf16x8*)(kT + (dt * 16 + fr) * 136 + ks * 32 + fq * 8);
                acc = __builtin_amdgcn_mfma_f32_16x16x32_bf16(a[ks], b, acc, 0, 0, 0);
            }
#pragma unroll
            for (int jj = 0; jj < 4; ++jj) o[(et * 16 + fq * 4 + jj) * 64 + dt * 16 + fr] = acc[jj];
        }
    }
}

DEV void r2_phase(const float* __restrict__ KVST, bf16_t* __restrict__ PREV, const float* __restrict__ dec_f, const float* __restrict__ dec_b, const int S) {
    const int NC = S / 128, nseq = TG / S, total = nseq * 8 * 2 * 4096;
    const int tid0 = TIDX, bid0 = BIDX;
    for (int idx = bid0 * NTHREADS + tid0; idx < total; idx += gridDim.x * NTHREADS) {
        const int elem = idx & 4095, dir = (idx >> 12) & 1, h = (idx >> 13) & 7, seq = idx >> 16;
        const float lg = -expf((dir ? dec_b : dec_f)[h]);
        const float cd = expf(lg * 128.f);
        float st = 0.f;
#pragma unroll 8
        for (int n = 0; n < NC; ++n) {
            const int nn = dir ? NC - 1 - n : n;
            const size_t o = ((size_t)((seq * NC + nn) * 8 + h) * 2 + dir) * 4096 + elem;
            PREV[o] = f2bf(st);
            st = st * cd + KVST[o];
        }
    }
}

DEV void r3_phase(const bf16_t* __restrict__ PROJ, const float2* __restrict__ rot, const bf16_t* __restrict__ PREV, bf16_t* __restrict__ RT,
                  const float* __restrict__ dec_f, const float* __restrict__ dec_b, const float* __restrict__ gn_g, const int S) {
    bf16_t* Qs = (bf16_t*)g_lds; bf16_t* Ks = Qs + 128 * 72; bf16_t* vT = Ks + 128 * 72;
    const int tid = TIDX, bid = BIDX, wid = tid >> 6, lane = tid & 63, fr = lane & 15, fq = lane >> 4;
    const int j = tid >> 2, dq = (tid & 3) * 8;
    for (int unit = bid; unit < (TG / 128) * 8; unit += gridDim.x) {
        const int cidx = unit >> 3, h = unit & 7, t0 = cidx * 128, seq = t0 / S, pos0 = t0 - seq * S;
        const float lgf2 = -expf(dec_f[h]) * 1.4426950408889634f, lgb2 = -expf(dec_b[h]) * 1.4426950408889634f;
        __syncthreads();
        {
            const bf16_t* pr = PROJ + (size_t)(t0 + j) * PC;
            const u32x4 q1 = *(const u32x4*)(pr + C_Q + h * 64 + dq), q2 = *(const u32x4*)(pr + C_Q + h * 64 + 32 + dq);
            const u32x4 k1 = *(const u32x4*)(pr + C_K + h * 64 + dq), k2 = *(const u32x4*)(pr + C_K + h * 64 + 32 + dq);
            const float2* rp = rot + (size_t)(pos0 + j) * 32 + dq;
            u32x4 oq1, oq2, ok1, ok2;
#pragma unroll
            for (int i = 0; i < 4; ++i) {
                const float2 c0 = rp[2 * i], c1 = rp[2 * i + 1];
                const float qa0 = bflo(q1[i]), qa1 = bfhi(q1[i]), qb0 = bflo(q2[i]), qb1 = bfhi(q2[i]);
                const float ka0 = bflo(k1[i]), ka1 = bfhi(k1[i]), kb0 = bflo(k2[i]), kb1 = bfhi(k2[i]);
                oq1[i] = cvt_pk_bf16(qa0 * c0.x - qb0 * c0.y, qa1 * c1.x - qb1 * c1.y);
                oq2[i] = cvt_pk_bf16(qa0 * c0.y + qb0 * c0.x, qa1 * c1.y + qb1 * c1.x);
                ok1[i] = cvt_pk_bf16((ka0 * c0.x - kb0 * c0.y) * 0.125f, (ka1 * c1.x - kb1 * c1.y) * 0.125f);
                ok2[i] = cvt_pk_bf16((ka0 * c0.y + kb0 * c0.x) * 0.125f, (ka1 * c1.y + kb1 * c1.x) * 0.125f);
            }
            *(u32x4*)(Qs + j * 72 + dq) = oq1; *(u32x4*)(Qs + j * 72 + 32 + dq) = oq2;
            *(u32x4*)(Ks + j * 72 + dq) = ok1; *(u32x4*)(Ks + j * 72 + 32 + dq) = ok2;
            const int e0 = (tid & 3) * 16;
            const u32x4 v1 = *(const u32x4*)(pr + C_V + h * 64 + e0), v2 = *(const u32x4*)(pr + C_V + h * 64 + e0 + 8);
#pragma unroll
            for (int i = 0; i < 4; ++i) {
                vT[(e0 + 2 * i) * 136 + j] = (bf16_t)(v1[i] & 0xffffu); vT[(e0 + 2 * i + 1) * 136 + j] = (bf16_t)(v1[i] >> 16);
                vT[(e0 + 8 + 2 * i) * 136 + j] = (bf16_t)(v2[i] & 0xffffu); vT[(e0 + 8 + 2 * i + 1) * 136 + j] = (bf16_t)(v2[i] >> 16);
            }
        }
        __syncthreads();
        const int i0 = wid * 16, ii = i0 + fr;
        bf16x8 bq[2];
#pragma unroll
        for (int ks = 0; ks < 2; ++ks) bq[ks] = *(const bf16x8*)(Qs + (i0 + fr) * 72 + ks * 32 + fq * 8);
        f32x4 s[8];
#pragma unroll
        for (int jt = 0; jt < 8; ++jt) {
            s[jt] = (f32x4){0.f, 0.f, 0.f, 0.f};
#pragma unroll
            for (int ks = 0; ks < 2; ++ks) {
                const bf16x8 a = *(const bf16x8*)(Ks + (jt * 16 + fr) * 72 + ks * 32 + fq * 8);
                s[jt] = __builtin_amdgcn_mfma_f32_16x16x32_bf16(a, bq[ks], s[jt], 0, 0, 0);
            }
#pragma unroll
            for (int jj = 0; jj < 4; ++jj) {
                const int delta = ii - (jt * 16 + fq * 4 + jj);
                const float fac = delta >= 0 ? exp2f(lgf2 * (float)delta) : exp2f(lgb2 * (float)(-delta));
                s[jt][jj] *= fac;
            }
        }
        bf16x8 bp[4];
#pragma unroll
        for (int k2 = 0; k2 < 4; ++k2) {
            u32x4 w; w[0] = cvt_pk_bf16(s[2 * k2][0], s[2 * k2][1]); w[1] = cvt_pk_bf16(s[2 * k2][2], s[2 * k2][3]);
            w[2] = cvt_pk_bf16(s[2 * k2 + 1][0], s[2 * k2 + 1][1]); w[3] = cvt_pk_bf16(s[2 * k2 + 1][2], s[2 * k2 + 1][3]);
            bp[k2] = __builtin_bit_cast(bf16x8, w);
        }
        const bf16_t* pf = PREV + ((size_t)(cidx * 8 + h) * 2) * 4096;
        const bf16_t* pb = pf + 4096;
        const float qf = exp2f(lgf2 * (float)(ii + 1)), qb = exp2f(lgb2 * (float)(128 - ii));
        f32x4 o[4];
#pragma unroll
        for (int et = 0; et < 4; ++et) {
            o[et] = (f32x4){0.f, 0.f, 0.f, 0.f};
#pragma unroll
            for (int k2 = 0; k2 < 4; ++k2) {
                const u32x2 lo = *(const u32x2*)(vT + (et * 16 + fr) * 136 + (2 * k2) * 16 + fq * 4);
                const u32x2 hi = *(const u32x2*)(vT + (et * 16 + fr) * 136 + (2 * k2 + 1) * 16 + fq * 4);
                u32x4 w; w[0] = lo[0]; w[1] = lo[1]; w[2] = hi[0]; w[3] = hi[1];
                o[et] = __builtin_amdgcn_mfma_f32_16x16x32_bf16(__builtin_bit_cast(bf16x8, w), bp[k2], o[et], 0, 0, 0);
            }
            f32x4 cf = {0.f, 0.f, 0.f, 0.f}, cb = {0.f, 0.f, 0.f, 0.f};
#pragma unroll
            for (int ks = 0; ks < 2; ++ks) {
                const bf16x8 af = *(const bf16x8*)(pf + (et * 16 + fr) * 64 + ks * 32 + fq * 8);
                const bf16x8 ab = *(const bf16x8*)(pb + (et * 16 + fr) * 64 + ks * 32 + fq * 8);
                cf = __builtin_amdgcn_mfma_f32_16x16x32_bf16(af, bq[ks], cf, 0, 0, 0);
                cb = __builtin_amdgcn_mfma_f32_16x16x32_bf16(ab, bq[ks], cb, 0, 0, 0);
            }
            o[et] += cf * qf + cb * qb;
        }
        float sum = 0.f;
#pragma unroll
        for (int et = 0; et < 4; ++et) sum += (o[et][0] + o[et][1]) + (o[et][2] + o[et][3]);
        sum += __shfl_xor(sum, 16); sum += __shfl_xor(sum, 32);
        const float mu = sum * (1.f / 64.f);
        float vs = 0.f;
#pragma unroll
        for (int et = 0; et < 4; ++et) { const f32x4 d = o[et] - mu; vs += (d[0] * d[0] + d[1] * d[1]) + (d[2] * d[2] + d[3] * d[3]); }
        vs += __shfl_xor(vs, 16); vs += __shfl_xor(vs, 32);
        const float rstd = 1.0f / sqrtf(vs * (1.f / 64.f) + 1e-6f);
        const size_t tok = (size_t)(t0 + ii);
#pragma unroll
        for (int et = 0; et < 4; ++et) {
            const int e = et * 16 + fq * 4;
            const u32x2 gg = *(const u32x2*)(PROJ + tok * PC + C_G + h * 64 + e);
            const f32x4 gn = *(const f32x4*)(gn_g + h * 64 + e);
            const f32x4 y = (o[et] - mu) * rstd * gn;
            u32x2 w; w[0] = cvt_pk_bf16(siluf_(bflo(gg[0])) * y[0], siluf_(bfhi(gg[0])) * y[1]); w[1] = cvt_pk_bf16(siluf_(bflo(gg[1])) * y[2], siluf_(bfhi(gg[1])) * y[3]);
            *(u32x2*)(RT + tok * 512 + h * 64 + e) = w;
        }
    }
}

DEV void attn_phase(const bf16_t* __restrict__ Q, const bf16_t* __restrict__ Kmem, const bf16_t* __restrict__ VmemT, bf16_t* __restrict__ O, const int S, const int g) {
    const int tid = TIDX, bid = BIDX, wid = tid >> 6, lane = tid & 63, fr = lane & 15, fq = lane >> 4;
    for (int unit = bid; unit < (TG / 128) * 4; unit += gridDim.x) {
        const int qb = unit >> 2, h = unit & 3, t0 = qb * 128, seq = t0 / S, b = (g < 2) ? g * 4 + seq : 8;
        const size_t tok = (size_t)(t0 + wid * 16 + fr);
        bf16x8 bq[8];
#pragma unroll
        for (int ks = 0; ks < 8; ++ks) bq[ks] = *(const bf16x8*)(Q + tok * 1024 + h * 256 + ks * 32 + fq * 8);
        const bf16_t* kb = Kmem + (size_t)(b * 256) * 1024 + h * 256;
        f32x4 s[16];
#pragma unroll
        for (int mt = 0; mt < 16; ++mt) {
            s[mt] = (f32x4){0.f, 0.f, 0.f, 0.f};
#pragma unroll
            for (int ks = 0; ks < 8; ++ks) {
                const bf16x8 a = *(const bf16x8*)(kb + (size_t)(mt * 16 + fr) * 1024 + ks * 32 + fq * 8);
                s[mt] = __builtin_amdgcn_mfma_f32_16x16x32_bf16(a, bq[ks], s[mt], 0, 0, 0);
            }
        }
        float mx = -3.0e38f;
#pragma unroll
        for (int mt = 0; mt < 16; ++mt) mx = fmaxf(mx, fmaxf(fmaxf(s[mt][0], s[mt][1]), fmaxf(s[mt][2], s[mt][3])));
        mx = fmaxf(mx, __shfl_xor(mx, 16)); mx = fmaxf(mx, __shfl_xor(mx, 32));
        float l = 0.f;
#pragma unroll
        for (int mt = 0; mt < 16; ++mt) {
#pragma unroll
            for (int jj = 0; jj < 4; ++jj) { const float pv = __expf(s[mt][jj] - mx); s[mt][jj] = pv; l += pv; }
        }
        l += __shfl_xor(l, 16); l += __shfl_xor(l, 32);
        const float il = 1.0f / l;
        bf16x8 bp[8];
#pragma unroll
        for (int k2 = 0; k2 < 8; ++k2) {
            u32x4 w; w[0] = cvt_pk_bf16(s[2 * k2][0], s[2 * k2][1]); w[1] = cvt_pk_bf16(s[2 * k2][2], s[2 * k2][3]);
            w[2] = cvt_pk_bf16(s[2 * k2 + 1][0], s[2 * k2 + 1][1]); w[3] = cvt_pk_bf16(s[2 * k2 + 1][2], s[2 * k2 + 1][3]);
            bp[k2] = __builtin_bit_cast(bf16x8, w);
        }
        const bf16_t* vb = VmemT + ((size_t)(b * 4 + h) * 256) * 256;
#pragma unroll
        for (int dt = 0; dt < 16; ++dt) {
            f32x4 o = {0.f, 0.f, 0.f, 0.f};
#pragma unroll
            for (int k2 = 0; k2 < 8; ++k2) {
                const u32x2 lo = *(const u32x2*)(vb + (size_t)(dt * 16 + fr) * 256 + (2 * k2) * 16 + fq * 4);
                const u32x2 hi = *(const u32x2*)(vb + (size_t)(dt * 16 + fr) * 256 + (2 * k2 + 1) * 16 + fq * 4);
                u32x4 w; w[0] = lo[0]; w[1] = lo[1]; w[2] = hi[0]; w[3] = hi[1];
                o = __builtin_amdgcn_mfma_f32_16x16x32_bf16(__builtin_bit_cast(bf16x8, w), bp[k2], o, 0, 0, 0);
            }
            u32x2 w; w[0] = cvt_pk_bf16(o[0] * il, o[1] * il); w[1] = cvt_pk_bf16(o[2] * il, o[3] * il);
            *(u32x2*)(O + tok * 1024 + h * 256 + dt * 16 + fq * 4) = w;
        }
    }
}

#define XB_TMO      128
#define XB_XCNT(j)  (256  + 64 * (j))
#define XB_XSUB(j)  (1280 + 64 * (j))
#define XB_XGEN(j)  (2304 + 64 * (j))
#define XB_TOP      3328
#define XB_TOPGEN   3392
#define XCD_BAR_WORDS 3456
#define XB_SPIN_CAP (1u << 22)
DEV unsigned xb_ld(unsigned* p)              { return __hip_atomic_load(p, __ATOMIC_RELAXED, __HIP_MEMORY_SCOPE_AGENT); }
DEV unsigned xb_add(unsigned* p, unsigned v) { return __hip_atomic_fetch_add(p, v, __ATOMIC_RELAXED, __HIP_MEMORY_SCOPE_AGENT); }
DEV unsigned xb_xcc_id() { return (unsigned)__builtin_amdgcn_s_getreg((3 << 11) | 20) & 0xFu; }
#define XB_SPIN(cond, bar) do { unsigned _sp = 0; while (cond) { __builtin_amdgcn_s_sleep(1); \
    if ((++_sp & 255u) == 0u) { if (xb_ld(&(bar)[XB_TMO])) break; if (_sp > XB_SPIN_CAP) { atomicAdd(&(bar)[XB_TMO], 1u); break; } } } } while (0)
struct XcdBarrier { unsigned* bar; unsigned x; volatile LAS unsigned* st; };
DEV XcdBarrier xcd_barrier_post(unsigned* bar, volatile LAS unsigned* st) {
    XcdBarrier b; b.bar = bar; b.x = xb_xcc_id(); b.st = st;
    if (threadIdx.x == 0) (void)xb_add(&bar[XB_XCNT(b.x)], 1u);
    return b;
}
DEV void xcd_barrier_complete(unsigned* bar, unsigned x, unsigned& nloc, unsigned& nx) {
    const unsigned G = gridDim.x * gridDim.y * gridDim.z;
    unsigned sum, cnt, mine, sp = 0u;
    for (;;) {
        sum = 0u; cnt = 0u; mine = 0u;
#pragma unroll
        for (unsigned j = 0; j < 16; ++j) { const unsigned c = xb_ld(&bar[XB_XCNT(j)]); sum += c; cnt += (c > 0u) ? 1u : 0u; mine = (j == x) ? c : mine; }
        if (sum == G) break;
        __builtin_amdgcn_s_sleep(1);
        if ((++sp & 255u) == 0u) { if (xb_ld(&bar[XB_TMO])) break; if (sp > XB_SPIN_CAP) { atomicAdd(&bar[XB_TMO], 1u); break; } }
    }
    nloc = mine > 0u ? mine : 1u; nx = cnt > 0u ? cnt : 1u;
}
DEV void xcd_barrier(const XcdBarrier& b) {
    asm volatile("s_waitcnt vmcnt(0)" ::: "memory");
    __syncthreads();
    if (threadIdx.x == 0) {
        unsigned* bar = b.bar;
        __builtin_amdgcn_s_waitcnt(0);
        unsigned nloc = b.st[0], nx = b.st[1];
        if (nloc == 0u) { xcd_barrier_complete(bar, b.x, nloc, nx); b.st[0] = nloc; b.st[1] = nx; }
        const unsigned old = xb_add(&bar[XB_XSUB(b.x)], 1u);
        const unsigned gen = old / nloc;
        if (old + 1u == (gen + 1u) * nloc) {
            __builtin_amdgcn_fence(__ATOMIC_RELEASE, "agent");
            asm volatile("s_waitcnt vmcnt(0)" ::: "memory");
            const unsigned og = xb_add(&bar[XB_TOP], 1u);
            const unsigned tg = og / nx;
            if (og + 1u == (tg + 1u) * nx) xb_add(&bar[XB_TOPGEN], 1u);
            else XB_SPIN(xb_ld(&bar[XB_TOPGEN]) == tg, bar);
            __builtin_amdgcn_fence(__ATOMIC_ACQUIRE, "agent");
            xb_add(&bar[XB_XGEN(b.x)], 1u);
            asm volatile("s_waitcnt vmcnt(0)" ::: "memory");
        } else {
            XB_SPIN(xb_ld(&bar[XB_XGEN(b.x)]) == gen, bar);
            __builtin_amdgcn_fence(__ATOMIC_ACQUIRE, "agent");
            asm volatile("s_waitcnt vmcnt(0)" ::: "memory");
        }
    }
    __syncthreads();
}

constexpr int PH_PER_GROUP = 35, N_PHASES = 2 + NGRP * PH_PER_GROUP;

DEV void run_phase(const Params& p, const int ph) {
    unsigned char* ws = p.ws;
#ifndef DIS_SETUP
    if (ph == 0) { setup_phase(p); return; }
#endif
    bf16_t* H = (bf16_t*)(ws + WS_H); bf16_t* HID = (bf16_t*)(ws + WS_HID); bf16_t* PROJ = (bf16_t*)(ws + WS_PROJ);
    float* F = (float*)(ws + WS_F); bf16_t* MIXB = (bf16_t*)(ws + WS_MIXB); bf16_t* QB = (bf16_t*)(ws + WS_QB); bf16_t* OB = (bf16_t*)(ws + WS_OB);
    bf16_t* CV = (bf16_t*)(ws + WS_CV); bf16_t* RT = (bf16_t*)(ws + WS_RT);
    float* KVST = (float*)(ws + WS_KVST); bf16_t* PREV = (bf16_t*)(ws + WS_PREV);
    const float2* rot = (const float2*)(ws + WS_ROT);
    GemmDesc gd{};
    int kind = 0;
    int g = 0, l = 0, s = 0;
    if (ph == 1) {
        gd.A = (const bf16_t*)(ws + WS_MEMN); gd.Bt = (const bf16_t*)(ws + WS_WT) + O_KV; gd.M = 2 * 2304; gd.N = 2048; gd.K = 1024; gd.epi = EPI_KV;
        gd.out = ws + WS_KMEM; gd.out2 = (bf16_t*)(ws + WS_VMEMT); gd.bt_layer_stride = WL;
    } else {
        const int idx = ph - 2; g = idx / PH_PER_GROUP; const int r = idx - g * PH_PER_GROUP;
        if (r < 18) { l = 0; s = r; } else { l = 1; s = r - 17; }
    }
    const int S = (g < 2) ? 4096 : 16384;
    const bf16_t* W = (const bf16_t*)(ws + WS_WT) + (size_t)l * WL;
    const float* ng = p.in[4] + (size_t)l * 8 * 1024;
    const float* xin = (g < 2) ? p.in[0] + (size_t)g * TG * 1024 : p.in[1];
    float* X = p.out + (size_t)g * TG * 1024;
    const float* rw_src = X; const float* rw_F = nullptr; float rw_scale = 1.f; const float* rw_gpost = nullptr; const float* rw_gnext = nullptr;
    if (ph >= 2) {
        switch (s) {
        case 0: kind = 1; rw_src = xin; rw_gnext = ng + 0 * 1024; break;
        case 1: gd.A = H; gd.Bt = W + O_GU1; gd.M = TG; gd.N = 5632; gd.K = 1024; gd.epi = EPI_SWIGLU; gd.out = HID; break;
        case 2: gd.A = HID; gd.Bt = W + O_D1; gd.M = TG; gd.N = 1024; gd.K = 2816; gd.epi = EPI_F32; gd.out = F; break;
        case 3: kind = 1; rw_F = F; rw_scale = 0.5f; rw_gpost = ng + 1 * 1024; rw_gnext = ng + 2 * 1024; break;
        case 4: gd.A = H; gd.Bt = W + O_IN; gd.M = TG; gd.N = PC; gd.K = 1024; gd.epi = EPI_PROJ; gd.out = PROJ; gd.gate_b = p.in[17] + (size_t)l * 2048; break;
        case 5: kind = 2; break;
        case 6: kind = 3; break;
        case 7: kind = 4; break;
        case 8: gd.A = CV; gd.Bt = W + O_PW; gd.M = TG; gd.N = 1024; gd.K = 512; gd.epi = EPI_MIX; gd.out = MIXB; gd.A2 = RT; gd.Bt2 = W + O_RO; gd.K2 = 512; gd.proj = PROJ; break;
        case 9: gd.A = MIXB; gd.Bt = W + O_MIX; gd.M = TG; gd.N = 1024; gd.K = 1024; gd.epi = EPI_F32; gd.out = F; break;
        case 10: kind = 1; rw_F = F; rw_scale = 1.f; rw_gpost = ng + 3 * 1024; rw_gnext = ng + 4 * 1024; break;
        case 11: gd.A = H; gd.Bt = W + O_Q; gd.M = TG; gd.N = 1024; gd.K = 1024; gd.epi = EPI_BF16; gd.out = QB; break;
        case 12: kind = 5; break;
        case 13: gd.A = OB; gd.Bt = W + O_O; gd.M = TG; gd.N = 1024; gd.K = 1024; gd.epi = EPI_F32; gd.out = F; break;
        case 14: kind = 1; rw_F = F; rw_scale = 1.f; rw_gpost = ng + 5 * 1024; rw_gnext = ng + 6 * 1024; break;
        case 15: gd.A = H; gd.Bt = W + O_GU2; gd.M = TG; gd.N = 5632; gd.K = 1024; gd.epi = EPI_SWIGLU; gd.out = HID; break;
        case 16: gd.A = HID; gd.Bt = W + O_D2; gd.M = TG; gd.N = 1024; gd.K = 2816; gd.epi = EPI_F32; gd.out = F; break;
        default: kind = 1; rw_F = F; rw_scale = 0.5f; rw_gpost = ng + 7 * 1024; rw_gnext = (l == 0) ? p.in[4] + (size_t)8 * 1024 : nullptr; break;
        }
    }
    if (kind == 0) {
#ifndef DIS_GEMM
        switch (gd.epi) {
        case EPI_F32: gemm_phase<EPI_F32>(gd); break;
        case EPI_BF16: gemm_phase<EPI_BF16>(gd); break;
        case EPI_SWIGLU: gemm_phase<EPI_SWIGLU>(gd); break;
        case EPI_PROJ: gemm_phase<EPI_PROJ>(gd); break;
        case EPI_MIX: gemm_phase<EPI_MIX>(gd); break;
        default: gemm_phase<EPI_KV>(gd); break;
        }
#endif
    }
    else if (kind == 1) {
#if PROBE == 5
        rowwise_phase(rw_src, (float*)HID, rw_F, rw_scale, rw_gpost, rw_gnext, H);
#endif
        rowwise_phase(rw_src, X, rw_F, rw_scale, rw_gpost, rw_gnext, H);
    }
#ifndef DIS_REST
    else if (kind == 2) {
#if PROBE == 3
        for (int rep = 0; rep < 2; ++rep)
#endif
        conv_phase(PROJ, CV, p.in[8] + (size_t)l * 31 * 512, p.in[9] + l * 512, p.in[10] + l * 512, p.in[11] + l * 512, S);
#if PROBE == 4
        for (int rep = 0; rep < 2; ++rep)
#endif
        r1_phase(PROJ, rot, KVST, p.in[13] + l * 8, p.in[14] + l * 8, S);
    } else if (kind == 3) r2_phase(KVST, PREV, p.in[13] + l * 8, p.in[14] + l * 8, S);
    else if (kind == 4)
#if PROBE == 4
        for (int rep = 0; rep < 2; ++rep)
#endif
        r3_phase(PROJ, rot, PREV, RT, p.in[13] + l * 8, p.in[14] + l * 8, p.in[15] + l * 512, S);
    else {
#if PROBE == 2
        for (int rep = 0; rep < 2; ++rep)
#endif
        attn_phase(QB, (const bf16_t*)(ws + WS_KMEM) + (size_t)l * 2304 * 1024, (const bf16_t*)(ws + WS_VMEMT) + (size_t)l * 2304 * 1024, OB, S, g);
    }
#endif
}

__global__ void __launch_bounds__(NTHREADS) mega(const Params p) {
#if SINGLE_LAUNCH
    volatile LAS unsigned* st = (volatile LAS unsigned*)((LAS unsigned char*)g_lds + 131072);
    if (threadIdx.x == 0) { st[0] = 0u; st[1] = 0u; }
    __syncthreads();
    const XcdBarrier xb = xcd_barrier_post((unsigned*)(p.ws + WS_BAR), st);
#endif
    for (int ph = p.ph_begin; ph < p.ph_end; ++ph) {
        run_phase(p, ph);
#if SINGLE_LAUNCH
        if (ph + 1 < p.ph_end) {
            if (ph == 0) cg::this_grid().sync();
            else {
                xcd_barrier(xb);
#if PROBE == 1
                xcd_barrier(xb); xcd_barrier(xb);
#endif
            }
        }
#endif
    }
}

extern "C" void kernel_launch(void* const* d_in, const int* in_sizes, int n_in, void* d_out, int out_size, void* d_ws, size_t ws_size, hipStream_t stream) {
    static int grid = 0;
    if (grid == 0) {
        if (n_in != 25 || ws_size < WS_END) { fprintf(stderr, "kernel_launch: need 25 inputs and >= %zu bytes of workspace (got %d, %zu)\n", (size_t)WS_END, n_in, ws_size); grid = -1; return; }
        int dev = 0, cus = 0, per_cu = 0;
        hipGetDevice(&dev);
        hipDeviceGetAttribute(&cus, hipDeviceAttributeMultiprocessorCount, dev);
        if (hipFuncSetAttribute((const void*)mega, hipFuncAttributeMaxDynamicSharedMemorySize, LDS_BYTES) != hipSuccess) { fprintf(stderr, "kernel_launch: hipFuncSetAttribute failed\n"); grid = -1; return; }
        hipOccupancyMaxActiveBlocksPerMultiprocessor(&per_cu, (const void*)mega, NTHREADS, LDS_BYTES);
        if (per_cu < 1) per_cu = 1;
        (void)hipGetLastError();
        grid = cus * 1;
    }
    if (grid < 0) return;
    Params p{};
    for (int i = 0; i < 25; ++i) p.in[i] = (const float*)d_in[i];
    p.out = (float*)d_out; p.ws = (unsigned char*)d_ws;
    for (int i = 0; i < 32; ++i) p.inv_freq[i] = (float)pow(10000.0, -(double)i / 32.0);
#if SINGLE_LAUNCH
    p.ph_begin = 0; p.ph_end = N_PHASES;
    hipMemsetAsync((unsigned char*)d_ws + WS_BAR, 0, 16384, stream);
    void* args[] = {&p};
    hipError_t e = hipLaunchCooperativeKernel((const void*)mega, dim3(grid), dim3(NTHREADS), args, LDS_BYTES, stream);
    if (e != hipSuccess) fprintf(stderr, "cooperative launch failed: %s (grid %d)\n", hipGetErrorString(e), grid);
#else
    for (int ph = 0; ph < N_PHASES; ++ph) {
        p.ph_begin = ph; p.ph_end = ph + 1;
        hipLaunchKernelGGL(mega, dim3(grid), dim3(NTHREADS), LDS_BYTES, stream, p);
    }
#endif
}
```

```cpp
#include <hip/hip_runtime.h>
#include <hip/hip_bf16.h>
#include <hip/hip_cooperative_groups.h>
#include <cstdio>
#include <cmath>
namespace cg = cooperative_groups;

#ifndef PROBE
#define PROBE 0
#endif
#ifndef SINGLE_LAUNCH
#define SINGLE_LAUNCH 1
#endif

#define DEV __device__ __forceinline__
typedef unsigned short bf16_t;
typedef short bf16x8 __attribute__((ext_vector_type(8)));
typedef short bf16x4 __attribute__((ext_vector_type(4)));
typedef float f32x4 __attribute__((ext_vector_type(4)));
typedef unsigned u32x4 __attribute__((ext_vector_type(4)));
typedef unsigned u32x2 __attribute__((ext_vector_type(2)));

constexpr int TG = 16384;
constexpr int NGRP = 3;
constexpr int PC = 5120;
constexpr int C_Q = 1024, C_K = 1536, C_V = 2048, C_G = 2560, C_GC = 3072, C_GR = 4096;
constexpr int NTHREADS = 512;
constexpr int LDS_BYTES = 131072 + 16;

constexpr size_t O_GU1 = 0, O_D1 = 5767168, O_IN = 8650752, O_PW = 13893632, O_RO = 14417920, O_MIX = 14942208,
                 O_Q = 15990784, O_KV = 17039360, O_O = 19136512, O_GU2 = 20185088, O_D2 = 25952256, WL = 28835840;
constexpr size_t WS_WT = 0;
constexpr size_t WS_ROT = WS_WT + 2 * WL * 2;
constexpr size_t WS_MEMN = WS_ROT + (size_t)16384 * 32 * 8;
constexpr size_t WS_KMEM = WS_MEMN + (size_t)2 * 2304 * 1024 * 2;
constexpr size_t WS_VMEMT = WS_KMEM + (size_t)2 * 2304 * 1024 * 2;
constexpr size_t WS_H = WS_VMEMT + (size_t)2 * 2304 * 1024 * 2;
constexpr size_t WS_HID = WS_H + (size_t)TG * 1024 * 2;
constexpr size_t WS_KVST = WS_HID;
constexpr size_t WS_PREV = WS_HID + 33554432;
constexpr size_t WS_MIXB = WS_HID + 50331648;
constexpr size_t WS_PROJ = WS_HID + (size_t)TG * 2816 * 2;
constexpr size_t WS_F = WS_PROJ;
constexpr size_t WS_QB = WS_PROJ + 67108864;
constexpr size_t WS_OB = WS_PROJ + 100663296;
constexpr size_t WS_CV = WS_PROJ + (size_t)TG * PC * 2;
constexpr size_t WS_RT = WS_CV + (size_t)TG * 512 * 2;
constexpr size_t WS_BAR = WS_RT + (size_t)TG * 512 * 2;
constexpr size_t WS_END = WS_BAR + 16384;

struct Params {
    const float* in[25];
    float* out;
    unsigned char* ws;
    float inv_freq[32];
    int ph_begin, ph_end;
};

extern __shared__ __attribute__((aligned(16))) unsigned char g_lds[];

DEV unsigned cvt_pk_bf16(float lo, float hi) { unsigned r; asm("v_cvt_pk_bf16_f32 %0, %1, %2" : "=v"(r) : "v"(lo), "v"(hi)); return r; }
DEV bf16_t f2bf(float v) { return (bf16_t)(cvt_pk_bf16(v, 0.f) & 0xffffu); }
DEV float bf2f(bf16_t v) { return __uint_as_float((unsigned)v << 16); }
DEV float bflo(unsigned v) { return __uint_as_float(v << 16); }
DEV float bfhi(unsigned v) { return __uint_as_float(v & 0xffff0000u); }
DEV float sigmoidf_(float x) { return __builtin_amdgcn_rcpf(1.f + __expf(-x)); }
DEV float siluf_(float x) { return x * __builtin_amdgcn_rcpf(1.f + __expf(-x)); }
DEV float wave_sum(float v) {
#pragma unroll
    for (int o = 32; o > 0; o >>= 1) v += __shfl_xor(v, o);
    return v;
}

DEV int launder_v(int v) { asm volatile("" : "+v"(v)); return v; }
DEV int launder_s(int v) { asm volatile("" : "+s"(v)); return v; }
#define TIDX launder_v((int)threadIdx.x)
#define BIDX launder_s((int)blockIdx.x)
constexpr int BM = 256, BK = 64, HALF = 128, HT = HALF * BK, NXCD = 8, WGM = 8;
DEV int lds_byte(int r, int c) {
    int st = (r >> 4) * 2 + (c >> 5), rr = r & 15, cc = c & 31, ob = rr * 64 + cc * 2;
    return st * 1024 + (ob ^ (((ob >> 9) & 1) << 5));
}
DEV void stage_rc(int b, int& R, int& C) {
    int st = b / 1024, sb = b % 1024, swz = sb ^ (((sb >> 9) & 1) << 5);
    R = (st >> 1) * 16 + swz / 64; C = (st & 1) * 32 + (swz % 64) / 2;
}

#define LAS __attribute__((address_space(3)))
enum { EPI_F32 = 0, EPI_BF16 = 1, EPI_SWIGLU = 2, EPI_PROJ = 3, EPI_MIX = 4, EPI_KV = 5 };

struct GemmDesc {
    const bf16_t* A; const bf16_t* Bt; int M, N, K, epi;
    void* out;
    const bf16_t* A2; const bf16_t* Bt2; int K2;
    const bf16_t* proj;
    const float* gate_b;
    bf16_t* out2;
    size_t bt_layer_stride;
};

template <int EPI> DEV void gemm_phase(const GemmDesc& g) {
    LAS unsigned char* lds = (LAS unsigned char*)g_lds;
    const int tid = TIDX, wid = __builtin_amdgcn_readfirstlane(tid >> 6), lane = tid & 63, wr = wid >> 2, wc = wid & 3, fr = lane & 15, fq = lane >> 4;
    const int K = g.K, nt = K / BK;
    const int nM = g.M / BM, nN = g.N / BM, nwg = nM * nN, G = gridDim.x, cblk = BIDX;
    const bool dual = (EPI == EPI_MIX);
    unsigned voff[2];
#pragma unroll
    for (int i = 0; i < 2; ++i) { int R, C; stage_rc(tid * 16 + i * 8192, R, C); voff[i] = (unsigned)(R * K + C) * 2u; }
    const size_t kstep = (size_t)(BK * 2), hstep = (size_t)HALF * K * 2, tstep = 2 * hstep;
    const unsigned ldsw = (unsigned)wid * 1024u;
    const int aoff = lds_byte(wr * 64 + fr, fq * 8), boff = lds_byte(wc * 32 + fr, fq * 8);
#define PG_SA(b, h) (((b) * 2 + (h)) * (HT * 2))
#define PG_SB(b, h) ((4 + (b) * 2 + (h)) * (HT * 2))
#define PG_STAGE(bufoff, gbase) do { _Pragma("unroll") for (int _i = 0; _i < 2; ++_i) \
        __builtin_amdgcn_global_load_lds((const unsigned*)((const char*)(gbase) + voff[_i]), (LAS unsigned*)(lds + (bufoff) + ldsw + _i * 8192), 16, 0, 0); } while (0)
#define PG_LDA(dst, b, h) do { _Pragma("unroll") for (int m = 0; m < 4; ++m) _Pragma("unroll") for (int k = 0; k < 2; ++k) dst[m][k] = *(const LAS bf16x8*)(lds + PG_SA(b, h) + aoff + m * 2048 + k * 1024); } while (0)
#define PG_LDB(dst, b, h) do { _Pragma("unroll") for (int n = 0; n < 2; ++n) _Pragma("unroll") for (int k = 0; k < 2; ++k) dst[n][k] = *(const LAS bf16x8*)(lds + PG_SB(b, h) + boff + n * 2048 + k * 1024); } while (0)
#define PG_MMA(ai, bj, Af, Bf) do { __builtin_amdgcn_s_setprio(1); _Pragma("unroll") for (int m = 0; m < 4; ++m) _Pragma("unroll") for (int n = 0; n < 2; ++n) _Pragma("unroll") for (int k = 0; k < 2; ++k) \
        acc[ai][bj][m][n] = __builtin_amdgcn_mfma_f32_16x16x32_bf16(Bf[n][k], Af[m][k], acc[ai][bj][m][n], 0, 0, 0); __builtin_amdgcn_s_setprio(0); } while (0)
#define PG_WAIT_V(n) asm volatile("s_waitcnt vmcnt(" #n ")" ::: "memory")
#define PG_WAIT_L(n) asm volatile("s_waitcnt lgkmcnt(" #n ")" ::: "memory")
#define PG_BAR __builtin_amdgcn_s_barrier()
#define PG_SCHED __builtin_amdgcn_sched_barrier(0)
#define PG_NEXT(i, pm_, pn_, seg_, ok_) do { const int _ti = dual ? ((i) >> 1) : (i); seg_ = dual ? ((i) & 1) : 0; const int _L = _ti * G + cblk; ok_ = _L < nwg; \
        if (ok_) { int wgid = _L; { const int q = nwg / NXCD, r = nwg % NXCD, xcd = wgid % NXCD, off = wgid / NXCD; wgid = (xcd < r ? xcd * (q + 1) : r * (q + 1) + (xcd - r) * q) + off; } \
          const int nig = WGM * nN, gid = wgid / nig, fm = gid * WGM, gsz = (nM - fm) < WGM ? (nM - fm) : WGM; pm_ = fm + ((wgid % nig) % gsz); pn_ = (wgid % nig) / gsz; } } while (0)
#define PG_ABASE(pm_, seg_) ((const char*)((seg_) ? g.A2 : g.A) + (size_t)(pm_) * tstep)
#define PG_BBASE(pm_, pn_, seg_) ((const char*)((seg_) ? g.Bt2 : g.Bt) + ((EPI == EPI_KV && (pm_) >= 9) ? g.bt_layer_stride * 2 : (size_t)0) + (size_t)(pn_) * tstep)
    int pm = 0, pn = 0, seg = 0, npm = 0, npn = 0, nseg = 0, ui = 0; bool ok;
    PG_NEXT(0, pm, pn, seg, ok);
    if (!ok) return;
    f32x4 acc[2][2][4][2];
#pragma unroll
    for (int a = 0; a < 2; ++a)
#pragma unroll
        for (int b = 0; b < 2; ++b)
#pragma unroll
            for (int m = 0; m < 4; ++m)
#pragma unroll
                for (int n = 0; n < 2; ++n) acc[a][b][m][n] = (f32x4){0.f, 0.f, 0.f, 0.f};
    bf16x8 At[4][2], B0[2][2], B1[2][2];
    const char* cA = PG_ABASE(pm, seg); const char* cB = PG_BBASE(pm, pn, seg);
    asm volatile("s_waitcnt vmcnt(0) lgkmcnt(0)" ::: "memory"); PG_BAR; PG_SCHED;
    PG_STAGE(PG_SB(0, 0), cB); PG_STAGE(PG_SA(0, 0), cA); PG_STAGE(PG_SB(0, 1), cB + hstep); PG_STAGE(PG_SA(0, 1), cA + hstep);
    if (wr == 1) PG_BAR;
    PG_WAIT_V(4); PG_BAR;
    PG_STAGE(PG_SB(1, 0), cB + kstep); PG_STAGE(PG_SA(1, 0), cA + kstep); PG_STAGE(PG_SB(1, 1), cB + hstep + kstep);
    PG_WAIT_V(6); PG_BAR;
    for (;;) {
        bool has_next; PG_NEXT(ui + 1, npm, npn, nseg, has_next);
        const char* nA = has_next ? PG_ABASE(npm, nseg) : cA; const char* nB = has_next ? PG_BBASE(npm, npn, nseg) : cB;
        for (int t = 0; t < nt; t += 2) {
            const bool last = (t == nt - 2);
            const char* a1 = cA + (size_t)(t + 1) * kstep;
            const char* a2 = last ? nA : cA + (size_t)(t + 2) * kstep; const char* b2 = last ? nB : cB + (size_t)(t + 2) * kstep;
            const char* a3 = a2 + kstep; const char* b3 = b2 + kstep;
            PG_LDB(B0, 0, 0); PG_SCHED; PG_LDA(At, 0, 0); PG_STAGE(PG_SA(1, 1), a1 + hstep);
            PG_WAIT_L(8); PG_BAR; PG_WAIT_L(0); PG_MMA(0, 0, At, B0); PG_BAR; PG_SCHED;
            PG_LDB(B1, 0, 1); PG_STAGE(PG_SB(0, 0), b2);
            PG_BAR; PG_WAIT_L(0); PG_MMA(0, 1, At, B1); PG_BAR;
            PG_LDA(At, 0, 1); PG_STAGE(PG_SA(0, 0), a2);
            PG_BAR; PG_WAIT_L(0); PG_MMA(1, 0, At, B0); PG_BAR; PG_SCHED;
            PG_STAGE(PG_SB(0, 1), b2 + hstep);
            PG_WAIT_V(6); PG_BAR; PG_MMA(1, 1, At, B1); PG_BAR;
            PG_LDB(B0, 1, 0); PG_SCHED; PG_LDA(At, 1, 0); PG_STAGE(PG_SA(0, 1), a2 + hstep);
            PG_WAIT_L(8); PG_BAR; PG_WAIT_L(0); PG_MMA(0, 0, At, B0); PG_BAR; PG_SCHED;
            PG_LDB(B1, 1, 1); PG_STAGE(PG_SB(1, 0), b3);
            PG_BAR; PG_WAIT_L(0); PG_MMA(0, 1, At, B1); PG_BAR;
            PG_LDA(At, 1, 1); PG_STAGE(PG_SA(1, 0), a3);
            PG_BAR; PG_WAIT_L(0); PG_MMA(1, 0, At, B0); PG_BAR; PG_SCHED;
            PG_STAGE(PG_SB(1, 1), b3 + hstep);
            PG_WAIT_V(6); PG_BAR; PG_MMA(1, 1, At, B1); PG_BAR;
        }
        const int brow = pm * BM, bcol = pn * BM;
        const int r0 = brow + wr * 64 + fr, c0 = bcol + wc * 32 + fq * 4;
        if (EPI == EPI_MIX) {
          if (seg == 0) {
#pragma unroll
            for (int ai = 0; ai < 2; ++ai)
#pragma unroll
                for (int m = 0; m < 4; ++m) {
                    const bf16_t* pr = g.proj + (size_t)(r0 + ai * 128 + m * 16) * PC + c0;
#pragma unroll
                    for (int bj = 0; bj < 2; ++bj)
#pragma unroll
                        for (int n = 0; n < 2; ++n) {
                            const u32x2 gc = *(const u32x2*)(pr + C_GC + bj * 128 + n * 16), gr = *(const u32x2*)(pr + C_GR + bj * 128 + n * 16);
                            f32x4 v = acc[ai][bj][m][n];
                            v[0] *= bflo(gc[0]) * __builtin_amdgcn_rcpf(bflo(gr[0])); v[1] *= bfhi(gc[0]) * __builtin_amdgcn_rcpf(bfhi(gr[0]));
                            v[2] *= bflo(gc[1]) * __builtin_amdgcn_rcpf(bflo(gr[1])); v[3] *= bfhi(gc[1]) * __builtin_amdgcn_rcpf(bfhi(gr[1]));
                            acc[ai][bj][m][n] = v;
                        }
                }
          } else {
#pragma unroll
            for (int ai = 0; ai < 2; ++ai)
#pragma unroll
                for (int m = 0; m < 4; ++m) {
                    const size_t row = (size_t)(r0 + ai * 128 + m * 16);
                    const bf16_t* pr = g.proj + row * PC + c0;
                    bf16_t* o = (bf16_t*)g.out + row * 1024 + c0;
#pragma unroll
                    for (int bj = 0; bj < 2; ++bj)
#pragma unroll
                        for (int n = 0; n < 2; ++n) {
                            const u32x2 gr = *(const u32x2*)(pr + C_GR + bj * 128 + n * 16);
                            const f32x4 v = acc[ai][bj][m][n];
                            u32x2 w; w[0] = cvt_pk_bf16(v[0] * bflo(gr[0]), v[1] * bfhi(gr[0])); w[1] = cvt_pk_bf16(v[2] * bflo(gr[1]), v[3] * bfhi(gr[1]));
                            *(u32x2*)(o + bj * 128 + n * 16) = w;
                        }
                }
          }
        } else if (EPI == EPI_F32) {
#pragma unroll
            for (int ai = 0; ai < 2; ++ai)
#pragma unroll
                for (int m = 0; m < 4; ++m) {
                    float* o = (float*)g.out + (size_t)(r0 + ai * 128 + m * 16) * g.N + c0;
#pragma unroll
                    for (int bj = 0; bj < 2; ++bj)
#pragma unroll
                        for (int n = 0; n < 2; ++n) *(f32x4*)(o + bj * 128 + n * 16) = acc[ai][bj][m][n];
                }
        } else if (EPI == EPI_BF16 || EPI == EPI_PROJ) {
            const bool sg = (EPI == EPI_PROJ) && (bcol >= C_GC);
#pragma unroll
            for (int ai = 0; ai < 2; ++ai)
#pragma unroll
                for (int m = 0; m < 4; ++m) {
                    bf16_t* o = (bf16_t*)g.out + (size_t)(r0 + ai * 128 + m * 16) * g.N + c0;
#pragma unroll
                    for (int bj = 0; bj < 2; ++bj)
#pragma unroll
                        for (int n = 0; n < 2; ++n) {
                            f32x4 v = acc[ai][bj][m][n];
                            if (sg) {
                                const f32x4 b = *(const f32x4*)(g.gate_b + (c0 - C_GC) + bj * 128 + n * 16);
#pragma unroll
                                for (int j = 0; j < 4; ++j) v[j] = sigmoidf_(v[j] + b[j]);
                            }
                            u32x2 w; w[0] = cvt_pk_bf16(v[0], v[1]); w[1] = cvt_pk_bf16(v[2], v[3]);
                            *(u32x2*)(o + bj * 128 + n * 16) = w;
                        }
                }
        } else if (EPI == EPI_SWIGLU) {
            const int hc0 = (bcol >> 1) + wc * 32 + fq * 4;
#pragma unroll
            for (int ai = 0; ai < 2; ++ai)
#pragma unroll
                for (int m = 0; m < 4; ++m) {
                    bf16_t* o = (bf16_t*)g.out + (size_t)(r0 + ai * 128 + m * 16) * (g.N >> 1) + hc0;
#pragma unroll
                    for (int n = 0; n < 2; ++n) {
                        const f32x4 ga = acc[ai][0][m][n], up = acc[ai][1][m][n];
                        u32x2 w; w[0] = cvt_pk_bf16(siluf_(ga[0]) * up[0], siluf_(ga[1]) * up[1]); w[1] = cvt_pk_bf16(siluf_(ga[2]) * up[2], siluf_(ga[3]) * up[3]);
                        *(u32x2*)(o + n * 16) = w;
                    }
                }
        } else {
#pragma unroll
            for (int ai = 0; ai < 2; ++ai)
#pragma unroll
                for (int m = 0; m < 4; ++m) {
                    const int row = r0 + ai * 128 + m * 16;
#pragma unroll
                    for (int bj = 0; bj < 2; ++bj)
#pragma unroll
                        for (int n = 0; n < 2; ++n) {
                            const f32x4 v = acc[ai][bj][m][n];
                            const int col = c0 + bj * 128 + n * 16;
                            if (bcol < 1024) {
                                u32x2 w; w[0] = cvt_pk_bf16(v[0], v[1]); w[1] = cvt_pk_bf16(v[2], v[3]);
                                *(u32x2*)((bf16_t*)g.out + (size_t)row * 1024 + col) = w;
                            } else {
                                const int hh = (col - 1024) >> 8, d = (col - 1024) & 255, lb = row >> 8, mm = row & 255;
                                bf16_t* o = g.out2 + ((size_t)(lb * 4 + hh) * 256 + d) * 256 + mm;
#pragma unroll
                                for (int j = 0; j < 4; ++j) o[j * 256] = f2bf(v[j]);
                            }
                        }
                }
        }
        if (!has_next) break;
        if (!(dual && seg == 0)) {
#pragma unroll
            for (int a = 0; a < 2; ++a)
#pragma unroll
                for (int b = 0; b < 2; ++b)
#pragma unroll
                    for (int m = 0; m < 4; ++m)
#pragma unroll
                        for (int n = 0; n < 2; ++n) acc[a][b][m][n] = (f32x4){0.f, 0.f, 0.f, 0.f};
        }
        pm = npm; pn = npn; seg = nseg; cA = nA; cB = nB; ++ui;
    }
    PG_WAIT_V(0);
    if (wr == 0) PG_BAR;
    PG_BAR;
#undef PG_SA
#undef PG_SB
#undef PG_STAGE
#undef PG_LDA
#undef PG_LDB
#undef PG_MMA
#undef PG_NEXT
#undef PG_ABASE
#undef PG_BBASE
}

DEV void transpose_mat(const float* __restrict__ src, const int K, const int N, bf16_t* __restrict__ dst, const int perm, const float scale) {
    float* tile = (float*)g_lds;
    const int nkt = K / 64, ntile = nkt * (N / 64), tid = TIDX, bid = BIDX;
    for (int t = bid; t < ntile; t += gridDim.x) {
        const int rt = t / nkt, kt = t - rt * nkt, rho0 = rt * 64;
        const int cbase = perm ? (((rho0 & 255) >> 7) * 2816 + (rho0 >> 8) * 128 + (rho0 & 127)) : rho0;
        __syncthreads();
#pragma unroll
        for (int i = 0; i < 8; ++i) { const int kk = (tid >> 6) + 8 * i, cc = tid & 63; tile[kk * 65 + cc] = src[(size_t)(kt * 64 + kk) * N + cbase + cc]; }
        __syncthreads();
#pragma unroll
        for (int i = 0; i < 4; ++i) {
            const int rr = (tid >> 5) + 16 * i, k2 = (tid & 31) * 2;
            *(unsigned*)(dst + (size_t)(rho0 + rr) * K + kt * 64 + k2) = cvt_pk_bf16(tile[k2 * 65 + rr] * scale, tile[(k2 + 1) * 65 + rr] * scale);
        }
    }
}

DEV void setup_phase(const Params& p) {
    bf16_t* wt = (bf16_t*)(p.ws + WS_WT);
    for (int l = 0; l < 2; ++l) {
        bf16_t* w = wt + (size_t)l * WL;
        transpose_mat(p.in[5] + (size_t)l * 1024 * 5632, 1024, 5632, w + O_GU1, 1, 1.f);
        transpose_mat(p.in[6] + (size_t)l * 2816 * 1024, 2816, 1024, w + O_D1, 0, 1.f);
        transpose_mat(p.in[7] + (size_t)l * 1024 * 5120, 1024, 5120, w + O_IN, 0, 1.f);
        transpose_mat(p.in[12] + (size_t)l * 512 * 1024, 512, 1024, w + O_PW, 0, 1.f);
        transpose_mat(p.in[16] + (size_t)l * 512 * 1024, 512, 1024, w + O_RO, 0, 1.f);
        transpose_mat(p.in[18] + (size_t)l * 1024 * 1024, 1024, 1024, w + O_MIX, 0, 1.f);
        transpose_mat(p.in[20] + (size_t)l * 1024 * 1024, 1024, 1024, w + O_Q, 0, 0.0625f);
        transpose_mat(p.in[21] + (size_t)l * 1024 * 2048, 1024, 2048, w + O_KV, 0, 1.f);
        transpose_mat(p.in[22] + (size_t)l * 1024 * 1024, 1024, 1024, w + O_O, 0, 1.f);
        transpose_mat(p.in[23] + (size_t)l * 1024 * 5632, 1024, 5632, w + O_GU2, 1, 1.f);
        transpose_mat(p.in[24] + (size_t)l * 2816 * 1024, 2816, 1024, w + O_D2, 0, 1.f);
    }
    float2* rot = (float2*)(p.ws + WS_ROT);
    const int tid0 = TIDX, bid0 = BIDX;
    for (int idx = bid0 * NTHREADS + tid0; idx < 16384 * 32; idx += gridDim.x * NTHREADS) {
        const int pos = idx >> 5, i = idx & 31;
        const float ang = (float)pos * p.inv_freq[i];
        double rev = (double)ang * 0.15915494309189535;
        rev -= floor(rev);
        const float fr = (float)rev;
        rot[idx] = make_float2(__builtin_amdgcn_cosf(fr), __builtin_amdgcn_sinf(fr));
    }
    bf16_t* memn = (bf16_t*)(p.ws + WS_MEMN);
    const int lane = tid0 & 63, gw = bid0 * 8 + (tid0 >> 6), nw = gridDim.x * 8;
    for (int rr = gw; rr < 2 * 2304; rr += nw) {
        const int l = rr / 2304, row = rr - l * 2304;
        const float* src = row < 2048 ? p.in[2] + (size_t)row * 1024 : p.in[3] + (size_t)(row - 2048) * 1024;
        const float* mg = p.in[19] + l * 1024;
        f32x4 x[4]; float ss = 0.f;
#pragma unroll
        for (int i = 0; i < 4; ++i) { x[i] = *(const f32x4*)(src + i * 256 + lane * 4); ss += x[i][0] * x[i][0] + x[i][1] * x[i][1] + x[i][2] * x[i][2] + x[i][3] * x[i][3]; }
        ss = wave_sum(ss);
        const float r = 1.0f / sqrtf(ss * (1.f / 1024.f) + 1e-6f);
#pragma unroll
        for (int i = 0; i < 4; ++i) {
            const f32x4 gg = *(const f32x4*)(mg + i * 256 + lane * 4);
            u32x2 w; w[0] = cvt_pk_bf16(x[i][0] * r * gg[0], x[i][1] * r * gg[1]); w[1] = cvt_pk_bf16(x[i][2] * r * gg[2], x[i][3] * r * gg[3]);
            *(u32x2*)(memn + (size_t)rr * 1024 + i * 256 + lane * 4) = w;
        }
    }
}

DEV void rowwise_phase(const float* __restrict__ Xsrc, float* __restrict__ X, const float* __restrict__ F, const float scale,
                       const float* __restrict__ gpost, const float* __restrict__ gnext, bf16_t* __restrict__ H) {
    const int tid0 = TIDX, bid0 = BIDX;
    const int lane = tid0 & 63, gw = bid0 * 8 + (tid0 >> 6), nw = gridDim.x * 8;
    for (int row = gw; row < TG; row += nw) {
        f32x4 x[4];
#pragma unroll
        for (int i = 0; i < 4; ++i) x[i] = *(const f32x4*)(Xsrc + (size_t)row * 1024 + i * 256 + lane * 4);
        if (F) {
            f32x4 f[4]; float ss = 0.f;
#pragma unroll
            for (int i = 0; i < 4; ++i) { f[i] = *(const f32x4*)(F + (size_t)row * 1024 + i * 256 + lane * 4); ss += f[i][0] * f[i][0] + f[i][1] * f[i][1] + f[i][2] * f[i][2] + f[i][3] * f[i][3]; }
            ss = wave_sum(ss);
            const float r = scale / sqrtf(ss * (1.f / 1024.f) + 1e-6f);
#pragma unroll
            for (int i = 0; i < 4; ++i) { const f32x4 gp = *(const f32x4*)(gpost + i * 256 + lane * 4); x[i] += f[i] * r * gp; }
        }
#pragma unroll
        for (int i = 0; i < 4; ++i) *(f32x4*)(X + (size_t)row * 1024 + i * 256 + lane * 4) = x[i];
        if (gnext) {
            float ss = 0.f;
#pragma unroll
            for (int i = 0; i < 4; ++i) ss += x[i][0] * x[i][0] + x[i][1] * x[i][1] + x[i][2] * x[i][2] + x[i][3] * x[i][3];
            ss = wave_sum(ss);
            const float r = 1.0f / sqrtf(ss * (1.f / 1024.f) + 1e-6f);
#pragma unroll
            for (int i = 0; i < 4; ++i) {
                const f32x4 gg = *(const f32x4*)(gnext + i * 256 + lane * 4);
                u32x2 w; w[0] = cvt_pk_bf16(x[i][0] * r * gg[0], x[i][1] * r * gg[1]); w[1] = cvt_pk_bf16(x[i][2] * r * gg[2], x[i][3] * r * gg[3]);
                *(u32x2*)(H + (size_t)row * 1024 + i * 256 + lane * 4) = w;
            }
        }
    }
}

DEV void conv_phase(const bf16_t* __restrict__ PROJ, bf16_t* __restrict__ CV, const float* __restrict__ dw_w, const float* __restrict__ dw_b,
                    const float* __restrict__ ln_g, const float* __restrict__ ln_b, const int S) {
    bf16_t* us = (bf16_t*)g_lds;
    float* red = (float*)(g_lds + 62 * 512 * 2);
    float* stat = red + 8 * 32 * 2;
    const int tid = TIDX, bid = BIDX, c = tid, wid = tid >> 6, lane = tid & 63;
    float w[31];
#pragma unroll
    for (int k = 0; k < 31; ++k) w[k] = dw_w[k * 512 + c];
    const float bias = dw_b[c], lg = ln_g[c], lb = ln_b[c];
    for (int u = bid; u < TG / 32; u += gridDim.x) {
        const int t0 = u * 32, seq = t0 / S, pos0 = t0 - seq * S;
        __syncthreads();
        const int cg8 = (tid & 63) * 8;
#pragma unroll
        for (int it = 0; it < 8; ++it) {
            const int tt = it * 8 + (tid >> 6);
            if (tt < 62) {
                const int pos = pos0 - 15 + tt;
                u32x4 o = {0u, 0u, 0u, 0u};
                if (pos >= 0 && pos < S) {
                    const bf16_t* pr = PROJ + (size_t)(seq * S + pos) * PC;
                    const u32x4 v = *(const u32x4*)(pr + cg8), gt = *(const u32x4*)(pr + 512 + cg8);
#pragma unroll
                    for (int q = 0; q < 4; ++q) o[q] = cvt_pk_bf16(bflo(v[q]) * sigmoidf_(bflo(gt[q])), bfhi(v[q]) * sigmoidf_(bfhi(gt[q])));
                }
                *(u32x4*)(us + tt * 512 + cg8) = o;
            }
        }
        __syncthreads();
        float acc[32];
#pragma unroll
        for (int seg = 0; seg < 4; ++seg) {
#pragma unroll
            for (int s = 0; s < 8; ++s) acc[seg * 8 + s] = bias;
#pragma unroll
            for (int kk = 0; kk < 38; ++kk) {
                const float uv = bf2f(us[(seg * 8 + kk) * 512 + c]);
#pragma unroll
                for (int s = 0; s < 8; ++s) { const int k = kk - s; if (k >= 0 && k < 31) acc[seg * 8 + s] += w[k] * uv; }
            }
        }
#pragma unroll
        for (int s = 0; s < 32; ++s) {
            const float s1 = wave_sum(acc[s]), s2 = wave_sum(acc[s] * acc[s]);
            if (lane == 0) { red[(wid * 32 + s) * 2] = s1; red[(wid * 32 + s) * 2 + 1] = s2; }
        }
        __syncthreads();
        if (tid < 32) {
            float s1 = 0.f, s2 = 0.f;
#pragma unroll
            for (int q = 0; q < 8; ++q) { s1 += red[(q * 32 + tid) * 2]; s2 += red[(q * 32 + tid) * 2 + 1]; }
            const float mean = s1 * (1.f / 512.f), var = fmaxf(s2 * (1.f / 512.f) - mean * mean, 0.f);
            stat[tid * 2] = mean; stat[tid * 2 + 1] = 1.0f / sqrtf(var + 1e-6f);
        }
        __syncthreads();
#pragma unroll
        for (int s = 0; s < 32; ++s) {
            const float y = (acc[s] - stat[s * 2]) * stat[s * 2 + 1] * lg + lb;
            CV[(size_t)(t0 + s) * 512 + c] = f2bf(siluf_(y));
        }
    }
}

template <int I> DEV float bfel(const u32x4& v) { return (I & 1) ? bfhi(v[I >> 1]) : bflo(v[I >> 1]); }

DEV void r1_phase(const bf16_t* __restrict__ PROJ, const float2* __restrict__ rot, float* __restrict__ KVST,
                  const float* __restrict__ dec_f, const float* __restrict__ dec_b, const int S) {
    bf16_t* vT = (bf16_t*)g_lds; bf16_t* kTf = vT + 64 * 136; bf16_t* kTb = kTf + 64 * 136;
    const int tid = TIDX, bid = BIDX, wid = tid >> 6, lane = tid & 63, fr = lane & 15, fq = lane >> 4;
    const int j = tid >> 2, dq = (tid & 3) * 8;
    for (int unit = bid; unit < (TG / 128) * 8; unit += gridDim.x) {
        const int cidx = unit >> 3, h = unit & 7, t0 = cidx * 128, seq = t0 / S, pos0 = t0 - seq * S;
        const float lgf2 = -expf(dec_f[h]) * 1.4426950408889634f, lgb2 = -expf(dec_b[h]) * 1.4426950408889634f;
        __syncthreads();
        const bf16_t* pr = PROJ + (size_t)(t0 + j) * PC;
        const u32x4 k1 = *(const u32x4*)(pr + C_K + h * 64 + dq), k2 = *(const u32x4*)(pr + C_K + h * 64 + 32 + dq);
        const float2* rp = rot + (size_t)(pos0 + j) * 32 + dq;
        const float df = exp2f(lgf2 * (float)(127 - j)), db = exp2f(lgb2 * (float)j);
#pragma unroll
        for (int i = 0; i < 8; ++i) {
            const float a = (i & 1) ? bfhi(k1[i >> 1]) : bflo(k1[i >> 1]), b = (i & 1) ? bfhi(k2[i >> 1]) : bflo(k2[i >> 1]);
            const float2 cs = rp[i];
            const float r1 = (a * cs.x - b * cs.y) * 0.125f, r2 = (a * cs.y + b * cs.x) * 0.125f;
            kTf[(dq + i) * 136 + j] = f2bf(r1 * df); kTf[(32 + dq + i) * 136 + j] = f2bf(r2 * df);
            kTb[(dq + i) * 136 + j] = f2bf(r1 * db); kTb[(32 + dq + i) * 136 + j] = f2bf(r2 * db);
        }
        {
            const int e0 = (tid & 3) * 16;
            const u32x4 v1 = *(const u32x4*)(pr + C_V + h * 64 + e0), v2 = *(const u32x4*)(pr + C_V + h * 64 + e0 + 8);
#pragma unroll
            for (int i = 0; i < 4; ++i) {
                vT[(e0 + 2 * i) * 136 + j] = (bf16_t)(v1[i] & 0xffffu); vT[(e0 + 2 * i + 1) * 136 + j] = (bf16_t)(v1[i] >> 16);
                vT[(e0 + 8 + 2 * i) * 136 + j] = (bf16_t)(v2[i] & 0xffffu); vT[(e0 + 8 + 2 * i + 1) * 136 + j] = (bf16_t)(v2[i] >> 16);
            }
        }
        __syncthreads();
        const int dir = wid >> 2, et = wid & 3;
        const bf16_t* kT = dir ? kTb : kTf;
        bf16x8 a[4];
#pragma unroll
        for (int ks = 0; ks < 4; ++ks) a[ks] = *(const bf16x8*)(vT + (et * 16 + fr) * 136 + ks * 32 + fq * 8);
        float* o = KVST + ((size_t)(cidx * 8 + h) * 2 + dir) * 4096;
#pragma unroll
        for (int dt = 0; dt < 4; ++dt) {
            f32x4 acc = {0.f, 0.f, 0.f, 0.f};
#pragma unroll
            for (int ks = 0; ks < 4; ++ks) {
                const bf16x8 b = *(const bf16x8*)(kT + (dt * 16 + fr) * 136 + ks * 32 + fq * 8);
                acc = __builtin_amdgcn_mfma_f32_16x16x32_bf16(a[ks], b, acc, 0, 0, 0);
            }
#pragma unroll
            for (int jj = 0; jj < 4; ++jj) o[(et * 16 + fq * 4 + jj) * 64 + dt * 16 + fr] = acc[jj];
        }
    }
}

DEV void r2_phase(const float* __restrict__ KVST, bf16_t* __restrict__ PREV, const float* __restrict__ dec_f, const float* __restrict__ dec_b, const int S) {
    const int NC = S / 128, nseq = TG / S, total = nseq * 8 * 2 * 4096;
    const int tid0 = TIDX, bid0 = BIDX;
    for (int idx = bid0 * NTHREADS + tid0; idx < total; idx += gridDim.x * NTHREADS) {
        const int elem = idx & 4095, dir = (idx >> 12) & 1, h = (idx >> 13) & 7, seq = idx >> 16;
        const float lg = -expf((dir ? dec_b : dec_f)[h]);
        const float cd = expf(lg * 128.f);
        float st = 0.f;
#pragma unroll 8
        for (int n = 0; n < NC; ++n) {
            const int nn = dir ? NC - 1 - n : n;
            const size_t o = ((size_t)((seq * NC + nn) * 8 + h) * 2 + dir) * 4096 + elem;
            PREV[o] = f2bf(st);
            st = st * cd + KVST[o];
        }
    }
}

DEV void r3_phase(const bf16_t* __restrict__ PROJ, const float2* __restrict__ rot, const bf16_t* __restrict__ PREV, bf16_t* __restrict__ RT,
                  const float* __restrict__ dec_f, const float* __restrict__ dec_b, const float* __restrict__ gn_g, const int S) {
    bf16_t* Qs = (bf16_t*)g_lds; bf16_t* Ks = Qs + 128 * 72; bf16_t* vT = Ks + 128 * 72;
    const int tid = TIDX, bid = BIDX, wid = tid >> 6, lane = tid & 63, fr = lane & 15, fq = lane >> 4;
    const int j = tid >> 2, dq = (tid & 3) * 8;
    for (int unit = bid; unit < (TG / 128) * 8; unit += gridDim.x) {
        const int cidx = unit >> 3, h = unit & 7, t0 = cidx * 128, seq = t0 / S, pos0 = t0 - seq * S;
        const float lgf2 = -expf(dec_f[h]) * 1.4426950408889634f, lgb2 = -expf(dec_b[h]) * 1.4426950408889634f;
        __syncthreads();
        {
            const bf16_t* pr = PROJ + (size_t)(t0 + j) * PC;
            const u32x4 q1 = *(const u32x4*)(pr + C_Q + h * 64 + dq), q2 = *(const u32x4*)(pr + C_Q + h * 64 + 32 + dq);
            const u32x4 k1 = *(const u32x4*)(pr + C_K + h * 64 + dq), k2 = *(const u32x4*)(pr + C_K + h * 64 + 32 + dq);
            const float2* rp = rot + (size_t)(pos0 + j) * 32 + dq;
            u32x4 oq1, oq2, ok1, ok2;
#pragma unroll
            for (int i = 0; i < 4; ++i) {
                const float2 c0 = rp[2 * i], c1 = rp[2 * i + 1];
                const float qa0 = bflo(q1[i]), qa1 = bfhi(q1[i]), qb0 = bflo(q2[i]), qb1 = bfhi(q2[i]);
                const float ka0 = bflo(k1[i]), ka1 = bfhi(k1[i]), kb0 = bflo(k2[i]), kb1 = bfhi(k2[i]);
                oq1[i] = cvt_pk_bf16(qa0 * c0.x - qb0 * c0.y, qa1 * c1.x - qb1 * c1.y);
                oq2[i] = cvt_pk_bf16(qa0 * c0.y + qb0 * c0.x, qa1 * c1.y + qb1 * c1.x);
                ok1[i] = cvt_pk_bf16((ka0 * c0.x - kb0 * c0.y) * 0.125f, (ka1 * c1.x - kb1 * c1.y) * 0.125f);
                ok2[i] = cvt_pk_bf16((ka0 * c0.y + kb0 * c0.x) * 0.125f, (ka1 * c1.y + kb1 * c1.x) * 0.125f);
            }
            *(u32x4*)(Qs + j * 72 + dq) = oq1; *(u32x4*)(Qs + j * 72 + 32 + dq) = oq2;
            *(u32x4*)(Ks + j * 72 + dq) = ok1; *(u32x4*)(Ks + j * 72 + 32 + dq) = ok2;
            const int e0 = (tid & 3) * 16;
            const u32x4 v1 = *(const u32x4*)(pr + C_V + h * 64 + e0), v2 = *(const u32x4*)(pr + C_V + h * 64 + e0 + 8);
#pragma unroll
            for (int i = 0; i < 4; ++i) {
                vT[(e0 + 2 * i) * 136 + j] = (bf16_t)(v1[i] & 0xffffu); vT[(e0 + 2 * i + 1) * 136 + j] = (bf16_t)(v1[i] >> 16);
                vT[(e0 + 8 + 2 * i) * 136 + j] = (bf16_t)(v2[i] & 0xffffu); vT[(e0 + 8 + 2 * i + 1) * 136 + j] = (bf16_t)(v2[i] >> 16);
            }
        }
        __syncthreads();
        const int i0 = wid * 16, ii = i0 + fr;
        bf16x8 bq[2];
#pragma unroll
        for (int ks = 0; ks < 2; ++ks) bq[ks] = *(const bf16x8*)(Qs + (i0 + fr) * 72 + ks * 32 + fq * 8);
        f32x4 s[8];
#pragma unroll
        for (int jt = 0; jt < 8; ++jt) {
            s[jt] = (f32x4){0.f, 0.f, 0.f, 0.f};
#pragma unroll
            for (int ks = 0; ks < 2; ++ks) {
                const bf16x8 a = *(const bf16x8*)(Ks + (jt * 16 + fr) * 72 + ks * 32 + fq * 8);
                s[jt] = __builtin_amdgcn_mfma_f32_16x16x32_bf16(a, bq[ks], s[jt], 0, 0, 0);
            }
#pragma unroll
            for (int jj = 0; jj < 4; ++jj) {
                const int delta = ii - (jt * 16 + fq * 4 + jj);
                const float fac = delta >= 0 ? exp2f(lgf2 * (float)delta) : exp2f(lgb2 * (float)(-delta));
                s[jt][jj] *= fac;
            }
        }
        bf16x8 bp[4];
#pragma unroll
        for (int k2 = 0; k2 < 4; ++k2) {
            u32x4 w; w[0] = cvt_pk_bf16(s[2 * k2][0], s[2 * k2][1]); w[1] = cvt_pk_bf16(s[2 * k2][2], s[2 * k2][3]);
            w[2] = cvt_pk_bf16(s[2 * k2 + 1][0], s[2 * k2 + 1][1]); w[3] = cvt_pk_bf16(s[2 * k2 + 1][2], s[2 * k2 + 1][3]);
            bp[k2] = __builtin_bit_cast(bf16x8, w);
        }
        const bf16_t* pf = PREV + ((size_t)(cidx * 8 + h) * 2) * 4096;
        const bf16_t* pb = pf + 4096;
        const float qf = exp2f(lgf2 * (float)(ii + 1)), qb = exp2f(lgb2 * (float)(128 - ii));
        f32x4 o[4];
#pragma unroll
        for (int et = 0; et < 4; ++et) {
            o[et] = (f32x4){0.f, 0.f, 0.f, 0.f};
#pragma unroll
            for (int k2 = 0; k2 < 4; ++k2) {
                const u32x2 lo = *(const u32x2*)(vT + (et * 16 + fr) * 136 + (2 * k2) * 16 + fq * 4);
                const u32x2 hi = *(const u32x2*)(vT + (et * 16 + fr) * 136 + (2 * k2 + 1) * 16 + fq * 4);
                u32x4 w; w[0] = lo[0]; w[1] = lo[1]; w[2] = hi[0]; w[3] = hi[1];
                o[et] = __builtin_amdgcn_mfma_f32_16x16x32_bf16(__builtin_bit_cast(bf16x8, w), bp[k2], o[et], 0, 0, 0);
            }
            f32x4 cf = {0.f, 0.f, 0.f, 0.f}, cb = {0.f, 0.f, 0.f, 0.f};
#pragma unroll
            for (int ks = 0; ks < 2; ++ks) {
                const bf16x8 af = *(const bf16x8*)(pf + (et * 16 + fr) * 64 + ks * 32 + fq * 8);
                const bf16x8 ab = *(const bf16x8*)(pb + (et * 16 + fr) * 64 + ks * 32 + fq * 8);
                cf = __builtin_amdgcn_mfma_f32_16x16x32_bf16(af, bq[ks], cf, 0, 0, 0);
                cb = __builtin_amdgcn_mfma_f32_16x16x32_bf16(ab, bq[ks], cb, 0, 0, 0);
            }
            o[et] += cf * qf + cb * qb;
        }
        float sum = 0.f;
#pragma unroll
        for (int et = 0; et < 4; ++et) sum += (o[et][0] + o[et][1]) + (o[et][2] + o[et][3]);
        sum += __shfl_xor(sum, 16); sum += __shfl_xor(sum, 32);
        const float mu = sum * (1.f / 64.f);
        float vs = 0.f;
#pragma unroll
        for (int et = 0; et < 4; ++et) { const f32x4 d = o[et] - mu; vs += (d[0] * d[0] + d[1] * d[1]) + (d[2] * d[2] + d[3] * d[3]); }
        vs += __shfl_xor(vs, 16); vs += __shfl_xor(vs, 32);
        const float rstd = 1.0f / sqrtf(vs * (1.f / 64.f) + 1e-6f);
        const size_t tok = (size_t)(t0 + ii);
#pragma unroll
        for (int et = 0; et < 4; ++et) {
            const int e = et * 16 + fq * 4;
            const u32x2 gg = *(const u32x2*)(PROJ + tok * PC + C_G + h * 64 + e);
            const f32x4 gn = *(const f32x4*)(gn_g + h * 64 + e);
            const f32x4 y = (o[et] - mu) * rstd * gn;
            u32x2 w; w[0] = cvt_pk_bf16(siluf_(bflo(gg[0])) * y[0], siluf_(bfhi(gg[0])) * y[1]); w[1] = cvt_pk_bf16(siluf_(bflo(gg[1])) * y[2], siluf_(bfhi(gg[1])) * y[3]);
            *(u32x2*)(RT + tok * 512 + h * 64 + e) = w;
        }
    }
}

DEV int att_sw(int key) { return (key & 3) | ((key >> 1) & 12); }
DEV void attn_phase(const bf16_t* __restrict__ Q, const bf16_t* __restrict__ Kmem, const bf16_t* __restrict__ VmemT, bf16_t* __restrict__ O, const int S, const int g) {
    LAS unsigned char* lds = (LAS unsigned char*)g_lds;
    const int tid = TIDX, bid = BIDX, wid = tid >> 6, lane = tid & 63, fr = lane & 15, fq = lane >> 4;
    for (int unit = bid; unit < (TG / 256) * 4; unit += gridDim.x) {
        const int qb = unit >> 2, h = unit & 3, t0 = qb * 256, seq = t0 / S, b = (g < 2) ? g * 4 + seq : 8;
        const bf16_t* kb = Kmem + (size_t)(b * 256) * 1024 + h * 256;
        const bf16_t* vb = VmemT + ((size_t)(b * 4 + h) * 256) * 256;
        const size_t tok0 = (size_t)(t0 + wid * 16 + fr), tok1 = tok0 + 128;
        f32x4 s[2][16];
#pragma unroll
        for (int mt = 0; mt < 16; ++mt) { s[0][mt] = (f32x4){0.f, 0.f, 0.f, 0.f}; s[1][mt] = (f32x4){0.f, 0.f, 0.f, 0.f}; }
#pragma unroll 1
        for (int half = 0; half < 2; ++half) {
            __syncthreads();
#pragma unroll
            for (int i = 0; i < 8; ++i) {
                const int idx = tid + 512 * i, key = idx >> 4, ch = idx & 15;
                const u32x4 v = *(const u32x4*)(kb + (size_t)key * 1024 + half * 128 + ch * 8);
                *(LAS u32x4*)(lds + key * 256 + ((ch ^ att_sw(key)) << 4)) = v;
            }
            bf16x8 bq[2][4];
#pragma unroll
            for (int ks = 0; ks < 4; ++ks) {
                bq[0][ks] = *(const bf16x8*)(Q + tok0 * 1024 + h * 256 + half * 128 + ks * 32 + fq * 8);
                bq[1][ks] = *(const bf16x8*)(Q + tok1 * 1024 + h * 256 + half * 128 + ks * 32 + fq * 8);
            }
            __syncthreads();
#pragma unroll
            for (int mt = 0; mt < 16; ++mt) {
                const int key = 32 * (mt >> 1) + (fr >> 2) * 8 + (mt & 1) * 4 + (fr & 3);
#pragma unroll
                for (int ks = 0; ks < 4; ++ks) {
                    const bf16x8 a = *(const LAS bf16x8*)(lds + key * 256 + (((ks * 4 + fq) ^ fr) << 4));
                    s[0][mt] = __builtin_amdgcn_mfma_f32_16x16x32_bf16(a, bq[0][ks], s[0][mt], 0, 0, 0);
                    s[1][mt] = __builtin_amdgcn_mfma_f32_16x16x32_bf16(a, bq[1][ks], s[1][mt], 0, 0, 0);
                }
            }
        }
        bf16x8 bp[2][8]; float il[2];
#pragma unroll
        for (int qs = 0; qs < 2; ++qs) {
            float mx = -3.0e38f;
#pragma unroll
            for (int mt = 0; mt < 16; ++mt) mx = fmaxf(mx, fmaxf(fmaxf(s[qs][mt][0], s[qs][mt][1]), fmaxf(s[qs][mt][2], s[qs][mt][3])));
            mx = fmaxf(mx, __shfl_xor(mx, 16)); mx = fmaxf(mx, __shfl_xor(mx, 32));
            float l = 0.f;
#pragma unroll
            for (int mt = 0; mt < 16; ++mt) {
#pragma unroll
                for (int jj = 0; jj < 4; ++jj) { const float pv = __expf(s[qs][mt][jj] - mx); s[qs][mt][jj] = pv; l += pv; }
            }
            l += __shfl_xor(l, 16); l += __shfl_xor(l, 32);
            il[qs] = 1.0f / l;
#pragma unroll
            for (int k2 = 0; k2 < 8; ++k2) {
                u32x4 w; w[0] = cvt_pk_bf16(s[qs][2 * k2][0], s[qs][2 * k2][1]); w[1] = cvt_pk_bf16(s[qs][2 * k2][2], s[qs][2 * k2][3]);
                w[2] = cvt_pk_bf16(s[qs][2 * k2 + 1][0], s[qs][2 * k2 + 1][1]); w[3] = cvt_pk_bf16(s[qs][2 * k2 + 1][2], s[qs][2 * k2 + 1][3]);
                bp[qs][k2] = __builtin_bit_cast(bf16x8, w);
            }
        }
#pragma unroll 1
        for (int half = 0; half < 2; ++half) {
            __syncthreads();
#pragma unroll
            for (int i = 0; i < 8; ++i) {
                const int idx = tid + 512 * i, dd = idx >> 5, ch = idx & 31;
                const u32x4 v = *(const u32x4*)(vb + (size_t)(half * 128 + dd) * 256 + ch * 8);
                *(LAS u32x4*)(lds + dd * 512 + ((ch ^ (dd & 15)) << 4)) = v;
            }
            __syncthreads();
#pragma unroll
            for (int dt = 0; dt < 8; ++dt) {
                f32x4 o0 = {0.f, 0.f, 0.f, 0.f}, o1 = {0.f, 0.f, 0.f, 0.f};
#pragma unroll
                for (int k2 = 0; k2 < 8; ++k2) {
                    const bf16x8 a = *(const LAS bf16x8*)(lds + (dt * 16 + fr) * 512 + (((k2 * 4 + fq) ^ fr) << 4));
                    o0 = __builtin_amdgcn_mfma_f32_16x16x32_bf16(a, bp[0][k2], o0, 0, 0, 0);
                    o1 = __builtin_amdgcn_mfma_f32_16x16x32_bf16(a, bp[1][k2], o1, 0, 0, 0);
                }
                const int dcol = h * 256 + half * 128 + dt * 16 + fq * 4;
                u32x2 w; w[0] = cvt_pk_bf16(o0[0] * il[0], o0[1] * il[0]); w[1] = cvt_pk_bf16(o0[2] * il[0], o0[3] * il[0]);
                *(u32x2*)(O + tok0 * 1024 + dcol) = w;
                w[0] = cvt_pk_bf16(o1[0] * il[1], o1[1] * il[1]); w[1] = cvt_pk_bf16(o1[2] * il[1], o1[3] * il[1]);
                *(u32x2*)(O + tok1 * 1024 + dcol) = w;
            }
        }
    }
}

#define XB_TMO      128
#define XB_XCNT(j)  (256  + 64 * (j))
#define XB_XSUB(j)  (1280 + 64 * (j))
#define XB_XGEN(j)  (2304 + 64 * (j))
#define XB_TOP      3328
#define XB_TOPGEN   3392
#define XCD_BAR_WORDS 3456
#define XB_SPIN_CAP (1u << 22)
DEV unsigned xb_ld(unsigned* p)              { return __hip_atomic_load(p, __ATOMIC_RELAXED, __HIP_MEMORY_SCOPE_AGENT); }
DEV unsigned xb_add(unsigned* p, unsigned v) { return __hip_atomic_fetch_add(p, v, __ATOMIC_RELAXED, __HIP_MEMORY_SCOPE_AGENT); }
DEV unsigned xb_xcc_id() { return (unsigned)__builtin_amdgcn_s_getreg((3 << 11) | 20) & 0xFu; }
#define XB_SPIN(cond, bar) do { unsigned _sp = 0; while (cond) { __builtin_amdgcn_s_sleep(1); \
    if ((++_sp & 255u) == 0u) { if (xb_ld(&(bar)[XB_TMO])) break; if (_sp > XB_SPIN_CAP) { atomicAdd(&(bar)[XB_TMO], 1u); break; } } } } while (0)
struct XcdBarrier { unsigned* bar; unsigned x; volatile LAS unsigned* st; };
DEV XcdBarrier xcd_barrier_post(unsigned* bar, volatile LAS unsigned* st) {
    XcdBarrier b; b.bar = bar; b.x = xb_xcc_id(); b.st = st;
    if (threadIdx.x == 0) (void)xb_add(&bar[XB_XCNT(b.x)], 1u);
    return b;
}
DEV void xcd_barrier_complete(unsigned* bar, unsigned x, unsigned& nloc, unsigned& nx) {
    const unsigned G = gridDim.x * gridDim.y * gridDim.z;
    unsigned sum, cnt, mine, sp = 0u;
    for (;;) {
        sum = 0u; cnt = 0u; mine = 0u;
#pragma unroll
        for (unsigned j = 0; j < 16; ++j) { const unsigned c = xb_ld(&bar[XB_XCNT(j)]); sum += c; cnt += (c > 0u) ? 1u : 0u; mine = (j == x) ? c : mine; }
        if (sum == G) break;
        __builtin_amdgcn_s_sleep(1);
        if ((++sp & 255u) == 0u) { if (xb_ld(&bar[XB_TMO])) break; if (sp > XB_SPIN_CAP) { atomicAdd(&bar[XB_TMO], 1u); break; } }
    }
    nloc = mine > 0u ? mine : 1u; nx = cnt > 0u ? cnt : 1u;
}
DEV void xcd_barrier(const XcdBarrier& b) {
    asm volatile("s_waitcnt vmcnt(0)" ::: "memory");
    __syncthreads();
    if (threadIdx.x == 0) {
        unsigned* bar = b.bar;
        __builtin_amdgcn_s_waitcnt(0);
        unsigned nloc = b.st[0], nx = b.st[1];
        if (nloc == 0u) { xcd_barrier_complete(bar, b.x, nloc, nx); b.st[0] = nloc; b.st[1] = nx; }
        const unsigned old = xb_add(&bar[XB_XSUB(b.x)], 1u);
        const unsigned gen = old / nloc;
        if (old + 1u == (gen + 1u) * nloc) {
            __builtin_amdgcn_fence(__ATOMIC_RELEASE, "agent");
            asm volatile("s_waitcnt vmcnt(0)" ::: "memory");
            const unsigned og = xb_add(&bar[XB_TOP], 1u);
            const unsigned tg = og / nx;
            if (og + 1u == (tg + 1u) * nx) xb_add(&bar[XB_TOPGEN], 1u);
            else XB_SPIN(xb_ld(&bar[XB_TOPGEN]) == tg, bar);
            __builtin_amdgcn_fence(__ATOMIC_ACQUIRE, "agent");
            xb_add(&bar[XB_XGEN(b.x)], 1u);
            asm volatile("s_waitcnt vmcnt(0)" ::: "memory");
        } else {
            XB_SPIN(xb_ld(&bar[XB_XGEN(b.x)]) == gen, bar);
            __builtin_amdgcn_fence(__ATOMIC_ACQUIRE, "agent");
            asm volatile("s_waitcnt vmcnt(0)" ::: "memory");
        }
    }
    __syncthreads();
}

constexpr int PH_PER_GROUP = 35, N_PHASES = 2 + NGRP * PH_PER_GROUP;

DEV void run_phase(const Params& p, const int ph) {
    unsigned char* ws = p.ws;
#ifndef DIS_SETUP
    if (ph == 0) { setup_phase(p); return; }
#endif
    bf16_t* H = (bf16_t*)(ws + WS_H); bf16_t* HID = (bf16_t*)(ws + WS_HID); bf16_t* PROJ = (bf16_t*)(ws + WS_PROJ);
    float* F = (float*)(ws + WS_F); bf16_t* MIXB = (bf16_t*)(ws + WS_MIXB); bf16_t* QB = (bf16_t*)(ws + WS_QB); bf16_t* OB = (bf16_t*)(ws + WS_OB);
    bf16_t* CV = (bf16_t*)(ws + WS_CV); bf16_t* RT = (bf16_t*)(ws + WS_RT);
    float* KVST = (float*)(ws + WS_KVST); bf16_t* PREV = (bf16_t*)(ws + WS_PREV);
    const float2* rot = (const float2*)(ws + WS_ROT);
    GemmDesc gd{};
    int kind = 0;
    int g = 0, l = 0, s = 0;
    if (ph == 1) {
        gd.A = (const bf16_t*)(ws + WS_MEMN); gd.Bt = (const bf16_t*)(ws + WS_WT) + O_KV; gd.M = 2 * 2304; gd.N = 2048; gd.K = 1024; gd.epi = EPI_KV;
        gd.out = ws + WS_KMEM; gd.out2 = (bf16_t*)(ws + WS_VMEMT); gd.bt_layer_stride = WL;
    } else {
        const int idx = ph - 2; g = idx / PH_PER_GROUP; const int r = idx - g * PH_PER_GROUP;
        if (r < 18) { l = 0; s = r; } else { l = 1; s = r - 17; }
    }
    const int S = (g < 2) ? 4096 : 16384;
    const bf16_t* W = (const bf16_t*)(ws + WS_WT) + (size_t)l * WL;
    const float* ng = p.in[4] + (size_t)l * 8 * 1024;
    const float* xin = (g < 2) ? p.in[0] + (size_t)g * TG * 1024 : p.in[1];
    float* X = p.out + (size_t)g * TG * 1024;
    const float* rw_src = X; const float* rw_F = nullptr; float rw_scale = 1.f; const float* rw_gpost = nullptr; const float* rw_gnext = nullptr;
    if (ph >= 2) {
        switch (s) {
        case 0: kind = 1; rw_src = xin; rw_gnext = ng + 0 * 1024; break;
        case 1: gd.A = H; gd.Bt = W + O_GU1; gd.M = TG; gd.N = 5632; gd.K = 1024; gd.epi = EPI_SWIGLU; gd.out = HID; break;
        case 2: gd.A = HID; gd.Bt = W + O_D1; gd.M = TG; gd.N = 1024; gd.K = 2816; gd.epi = EPI_F32; gd.out = F; break;
        case 3: kind = 1; rw_F = F; rw_scale = 0.5f; rw_gpost = ng + 1 * 1024; rw_gnext = ng + 2 * 1024; break;
        case 4: gd.A = H; gd.Bt = W + O_IN; gd.M = TG; gd.N = PC; gd.K = 1024; gd.epi = EPI_PROJ; gd.out = PROJ; gd.gate_b = p.in[17] + (size_t)l * 2048; break;
        case 5: kind = 2; break;
        case 6: kind = 3; break;
        case 7: kind = 4; break;
        case 8: gd.A = CV; gd.Bt = W + O_PW; gd.M = TG; gd.N = 1024; gd.K = 512; gd.epi = EPI_MIX; gd.out = MIXB; gd.A2 = RT; gd.Bt2 = W + O_RO; gd.K2 = 512; gd.proj = PROJ; break;
        case 9: gd.A = MIXB; gd.Bt = W + O_MIX; gd.M = TG; gd.N = 1024; gd.K = 1024; gd.epi = EPI_F32; gd.out = F; break;
        case 10: kind = 1; rw_F = F; rw_scale = 1.f; rw_gpost = ng + 3 * 1024; rw_gnext = ng + 4 * 1024; break;
        case 11: gd.A = H; gd.Bt = W + O_Q; gd.M = TG; gd.N = 1024; gd.K = 1024; gd.epi = EPI_BF16; gd.out = QB; break;
        case 12: kind = 5; break;
        case 13: gd.A = OB; gd.Bt = W + O_O; gd.M = TG; gd.N = 1024; gd.K = 1024; gd.epi = EPI_F32; gd.out = F; break;
        case 14: kind = 1; rw_F = F; rw_scale = 1.f; rw_gpost = ng + 5 * 1024; rw_gnext = ng + 6 * 1024; break;
        case 15: gd.A = H; gd.Bt = W + O_GU2; gd.M = TG; gd.N = 5632; gd.K = 1024; gd.epi = EPI_SWIGLU; gd.out = HID; break;
        case 16: gd.A = HID; gd.Bt = W + O_D2; gd.M = TG; gd.N = 1024; gd.K = 2816; gd.epi = EPI_F32; gd.out = F; break;
        default: kind = 1; rw_F = F; rw_scale = 0.5f; rw_gpost = ng + 7 * 1024; rw_gnext = (l == 0) ? p.in[4] + (size_t)8 * 1024 : nullptr; break;
        }
    }
    if (kind == 0) {
#ifndef DIS_GEMM
        switch (gd.epi) {
        case EPI_F32: gemm_phase<EPI_F32>(gd); break;
        case EPI_BF16: gemm_phase<EPI_BF16>(gd); break;
        case EPI_SWIGLU: gemm_phase<EPI_SWIGLU>(gd); break;
        case EPI_PROJ: gemm_phase<EPI_PROJ>(gd); break;
        case EPI_MIX: gemm_phase<EPI_MIX>(gd); break;
        default: gemm_phase<EPI_KV>(gd); break;
        }
#endif
    }
    else if (kind == 1) {
#if PROBE == 5
        rowwise_phase(rw_src, (float*)HID, rw_F, rw_scale, rw_gpost, rw_gnext, H);
#endif
        rowwise_phase(rw_src, X, rw_F, rw_scale, rw_gpost, rw_gnext, H);
    }
#ifndef DIS_REST
    else if (kind == 2) {
#if PROBE == 3
        for (int rep = 0; rep < 2; ++rep)
#endif
        conv_phase(PROJ, CV, p.in[8] + (size_t)l * 31 * 512, p.in[9] + l * 512, p.in[10] + l * 512, p.in[11] + l * 512, S);
#if PROBE == 4
        for (int rep = 0; rep < 2; ++rep)
#endif
        r1_phase(PROJ, rot, KVST, p.in[13] + l * 8, p.in[14] + l * 8, S);
    } else if (kind == 3) r2_phase(KVST, PREV, p.in[13] + l * 8, p.in[14] + l * 8, S);
    else if (kind == 4)
#if PROBE == 4
        for (int rep = 0; rep < 2; ++rep)
#endif
        r3_phase(PROJ, rot, PREV, RT, p.in[13] + l * 8, p.in[14] + l * 8, p.in[15] + l * 512, S);
    else {
#if PROBE == 2
        for (int rep = 0; rep < 2; ++rep)
#endif
        attn_phase(QB, (const bf16_t*)(ws + WS_KMEM) + (size_t)l * 2304 * 1024, (const bf16_t*)(ws + WS_VMEMT) + (size_t)l * 2304 * 1024, OB, S, g);
    }
#endif
}

__global__ void __launch_bounds__(NTHREADS) mega(const Params p) {
#if SINGLE_LAUNCH
    volatile LAS unsigned* st = (volatile LAS unsigned*)((LAS unsigned char*)g_lds + 131072);
    if (threadIdx.x == 0) { st[0] = 0u; st[1] = 0u; }
    __syncthreads();
    const XcdBarrier xb = xcd_barrier_post((unsigned*)(p.ws + WS_BAR), st);
#endif
    for (int ph = p.ph_begin; ph < p.ph_end; ++ph) {
        run_phase(p, ph);
#if SINGLE_LAUNCH
        if (ph + 1 < p.ph_end) {
            if (ph == 0) cg::this_grid().sync();
            else {
                xcd_barrier(xb);
#if PROBE == 1
                xcd_barrier(xb); xcd_barrier(xb);
#endif
            }
        }
#endif
    }
}

extern "C" void kernel_launch(void* const* d_in, const int* in_sizes, int n_in, void* d_out, int out_size, void* d_ws, size_t ws_size, hipStream_t stream) {
    static int grid = 0;
    if (grid == 0) {
        if (n_in != 25 || ws_size < WS_END) { fprintf(stderr, "kernel_launch: need 25 inputs and >= %zu bytes of workspace (got %d, %zu)\n", (size_t)WS_END, n_in, ws_size); grid = -1; return; }
        int dev = 0, cus = 0, per_cu = 0;
        hipGetDevice(&dev);
        hipDeviceGetAttribute(&cus, hipDeviceAttributeMultiprocessorCount, dev);
        if (hipFuncSetAttribute((const void*)mega, hipFuncAttributeMaxDynamicSharedMemorySize, LDS_BYTES) != hipSuccess) { fprintf(stderr, "kernel_launch: hipFuncSetAttribute failed\n"); grid = -1; return; }
        hipOccupancyMaxActiveBlocksPerMultiprocessor(&per_cu, (const void*)mega, NTHREADS, LDS_BYTES);
        if (per_cu < 1) per_cu = 1;
        (void)hipGetLastError();
        grid = cus * 1;
    }
    if (grid < 0) return;
    Params p{};
    for (int i = 0; i < 25; ++i) p.in[i] = (const float*)d_in[i];
    p.out = (float*)d_out; p.ws = (unsigned char*)d_ws;
    for (int i = 0; i < 32; ++i) p.inv_freq[i] = (float)pow(10000.0, -(double)i / 32.0);
#if SINGLE_LAUNCH
    p.ph_begin = 0; p.ph_end = N_PHASES;
    hipMemsetAsync((unsigned char*)d_ws + WS_BAR, 0, 16384, stream);
    void* args[] = {&p};
    hipError_t e = hipLaunchCooperativeKernel((const void*)mega, dim3(grid), dim3(NTHREADS), args, LDS_BYTES, stream);
    if (e != hipSuccess) fprintf(stderr, "cooperative launch failed: %s (grid %d)\n", hipGetErrorString(e), grid);
#else
    for (int ph = 0; ph < N_PHASES; ++ph) {
        p.ph_begin = ph; p.ph_end = ph + 1;
        hipLaunchKernelGGL(mega, dim3(grid), dim3(NTHREADS), LDS_BYTES, stream, p);
    }
#endif
}
```

```cpp
#include <hip/hip_runtime.h>
#include <hip/hip_bf16.h>
#include <hip/hip_cooperative_groups.h>
#include <cstdio>
#include <cmath>
namespace cg = cooperative_groups;

#ifndef PROBE
#define PROBE 0
#endif
#ifndef SINGLE_LAUNCH
#define SINGLE_LAUNCH 1
#endif

#define DEV __device__ __forceinline__
typedef unsigned short bf16_t;
typedef short bf16x8 __attribute__((ext_vector_type(8)));
typedef short bf16x4 __attribute__((ext_vector_type(4)));
typedef float f32x4 __attribute__((ext_vector_type(4)));
typedef unsigned u32x4 __attribute__((ext_vector_type(4)));
typedef unsigned u32x2 __attribute__((ext_vector_type(2)));

constexpr int TG = 16384;
constexpr int NGRP = 3;
constexpr int PC = 5120;
constexpr int C_Q = 1024, C_K = 1536, C_V = 2048, C_G = 2560, C_GC = 3072, C_GR = 4096;
constexpr int NTHREADS = 512;
constexpr int LDS_BYTES = 131072 + 16;

constexpr size_t O_GU1 = 0, O_D1 = 5767168, O_IN = 8650752, O_PW = 13893632, O_RO = 14417920, O_MIX = 14942208,
                 O_Q = 15990784, O_KV = 17039360, O_O = 19136512, O_GU2 = 20185088, O_D2 = 25952256, WL = 28835840;
constexpr size_t WS_WT = 0;
constexpr size_t WS_ROT = WS_WT + 2 * WL * 2;
constexpr size_t WS_MEMN = WS_ROT + (size_t)16384 * 32 * 8;
constexpr size_t WS_KMEM = WS_MEMN + (size_t)2 * 2304 * 1024 * 2;
constexpr size_t WS_VMEMT = WS_KMEM + (size_t)2 * 2304 * 1024 * 2;
constexpr size_t WS_H = WS_VMEMT + (size_t)2 * 2304 * 1024 * 2;
constexpr size_t WS_HID = WS_H + (size_t)TG * 1024 * 2;
constexpr size_t WS_KVST = WS_HID;
constexpr size_t WS_PREV = WS_HID + 33554432;
constexpr size_t WS_MIXB = WS_HID + 50331648;
constexpr size_t WS_PROJ = WS_HID + (size_t)TG * 2816 * 2;
constexpr size_t WS_F = WS_PROJ;
constexpr size_t WS_QB = WS_PROJ + 67108864;
constexpr size_t WS_OB = WS_PROJ + 100663296;
constexpr size_t WS_CV = WS_PROJ + (size_t)TG * PC * 2;
constexpr size_t WS_RT = WS_CV + (size_t)TG * 512 * 2;
constexpr size_t WS_BAR = WS_RT + (size_t)TG * 512 * 2;
constexpr size_t WS_CNT = WS_BAR + 16384;
constexpr size_t WS_XBUF = WS_CNT + 32768;
constexpr size_t WS_END = WS_XBUF + 2 * 262144;

struct Params {
    const float* in[25];
    float* out;
    unsigned char* ws;
    float inv_freq[32];
    int ph_begin, ph_end;
};

extern __shared__ __attribute__((aligned(16))) unsigned char g_lds[];

DEV unsigned cvt_pk_bf16(float lo, float hi) { unsigned r; asm("v_cvt_pk_bf16_f32 %0, %1, %2" : "=v"(r) : "v"(lo), "v"(hi)); return r; }
DEV bf16_t f2bf(float v) { return (bf16_t)(cvt_pk_bf16(v, 0.f) & 0xffffu); }
DEV float bf2f(bf16_t v) { return __uint_as_float((unsigned)v << 16); }
DEV float bflo(unsigned v) { return __uint_as_float(v << 16); }
DEV float bfhi(unsigned v) { return __uint_as_float(v & 0xffff0000u); }
DEV float sigmoidf_(float x) { return __builtin_amdgcn_rcpf(1.f + __expf(-x)); }
DEV float siluf_(float x) { return x * __builtin_amdgcn_rcpf(1.f + __expf(-x)); }
DEV float wave_sum(float v) {
#pragma unroll
    for (int o = 32; o > 0; o >>= 1) v += __shfl_xor(v, o);
    return v;
}

DEV int launder_v(int v) { asm volatile("" : "+v"(v)); return v; }
DEV int launder_s(int v) { asm volatile("" : "+s"(v)); return v; }
#define TIDX launder_v((int)threadIdx.x)
#define BIDX launder_s((int)blockIdx.x)
constexpr int BM = 256, BK = 64, HALF = 128, HT = HALF * BK, NXCD = 8, WGM = 8;
DEV int lds_byte(int r, int c) {
    int st = (r >> 4) * 2 + (c >> 5), rr = r & 15, cc = c & 31, ob = rr * 64 + cc * 2;
    return st * 1024 + (ob ^ (((ob >> 9) & 1) << 5));
}
DEV void stage_rc(int b, int& R, int& C) {
    int st = b / 1024, sb = b % 1024, swz = sb ^ (((sb >> 9) & 1) << 5);
    R = (st >> 1) * 16 + swz / 64; C = (st & 1) * 32 + (swz % 64) / 2;
}

#define LAS __attribute__((address_space(3)))
enum { EPI_F32 = 0, EPI_BF16 = 1, EPI_SWIGLU = 2, EPI_PROJ = 3, EPI_MIX = 4, EPI_KV = 5, EPI_RES = 6 };

struct GemmDesc {
    const bf16_t* A; const bf16_t* Bt; int M, N, K, epi;
    void* out;
    const bf16_t* A2; const bf16_t* Bt2; int K2;
    const bf16_t* proj;
    const float* gate_b;
    bf16_t* out2;
    size_t bt_layer_stride;
    float* X; const float* gpost; const float* gnext; bf16_t* Hout; float scale; float* xbuf; unsigned* cnt; unsigned expect, skip1;
};

template <int EPI> DEV void gemm_phase(const GemmDesc& g) {
    LAS unsigned char* lds = (LAS unsigned char*)g_lds;
    const int tid = TIDX, wid = __builtin_amdgcn_readfirstlane(tid >> 6), lane = tid & 63, wr = wid >> 2, wc = wid & 3, fr = lane & 15, fq = lane >> 4;
    const int K = g.K, nt = K / BK;
    const int nM = g.M / BM, nN = g.N / BM, nwg = nM * nN, G = gridDim.x, cblk = BIDX;
    const bool dual = (EPI == EPI_MIX);
    unsigned voff[2];
#pragma unroll
    for (int i = 0; i < 2; ++i) { int R, C; stage_rc(tid * 16 + i * 8192, R, C); voff[i] = (unsigned)(R * K + C) * 2u; }
    const size_t kstep = (size_t)(BK * 2), hstep = (size_t)HALF * K * 2, tstep = 2 * hstep;
    const unsigned ldsw = (unsigned)wid * 1024u;
    const int aoff = lds_byte(wr * 64 + fr, fq * 8), boff = lds_byte(wc * 32 + fr, fq * 8);
#define PG_SA(b, h) (((b) * 2 + (h)) * (HT * 2))
#define PG_SB(b, h) ((4 + (b) * 2 + (h)) * (HT * 2))
#define PG_STAGE(bufoff, gbase) do { _Pragma("unroll") for (int _i = 0; _i < 2; ++_i) \
        __builtin_amdgcn_global_load_lds((const unsigned*)((const char*)(gbase) + voff[_i]), (LAS unsigned*)(lds + (bufoff) + ldsw + _i * 8192), 16, 0, 0); } while (0)
#define PG_LDA(dst, b, h) do { _Pragma("unroll") for (int m = 0; m < 4; ++m) _Pragma("unroll") for (int k = 0; k < 2; ++k) dst[m][k] = *(const LAS bf16x8*)(lds + PG_SA(b, h) + aoff + m * 2048 + k * 1024); } while (0)
#define PG_LDB(dst, b, h) do { _Pragma("unroll") for (int n = 0; n < 2; ++n) _Pragma("unroll") for (int k = 0; k < 2; ++k) dst[n][k] = *(const LAS bf16x8*)(lds + PG_SB(b, h) + boff + n * 2048 + k * 1024); } while (0)
#define PG_MMA(ai, bj, Af, Bf) do { __builtin_amdgcn_s_setprio(1); _Pragma("unroll") for (int m = 0; m < 4; ++m) _Pragma("unroll") for (int n = 0; n < 2; ++n) _Pragma("unroll") for (int k = 0; k < 2; ++k) \
        acc[ai][bj][m][n] = __builtin_amdgcn_mfma_f32_16x16x32_bf16(Bf[n][k], Af[m][k], acc[ai][bj][m][n], 0, 0, 0); __builtin_amdgcn_s_setprio(0); } while (0)
#define PG_WAIT_V(n) asm volatile("s_waitcnt vmcnt(" #n ")" ::: "memory")
#define PG_WAIT_L(n) asm volatile("s_waitcnt lgkmcnt(" #n ")" ::: "memory")
#define PG_BAR __builtin_amdgcn_s_barrier()
#define PG_SCHED __builtin_amdgcn_sched_barrier(0)
#define PG_NEXT(i, pm_, pn_, seg_, ok_) do { const int _ti = dual ? ((i) >> 1) : (i); seg_ = dual ? ((i) & 1) : 0; const int _L = _ti * G + cblk; ok_ = _L < nwg; \
        if (ok_) { int wgid = _L; { const int q = nwg / NXCD, r = nwg % NXCD, xcd = wgid % NXCD, off = wgid / NXCD; wgid = (xcd < r ? xcd * (q + 1) : r * (q + 1) + (xcd - r) * q) + off; } \
          const int nig = WGM * nN, gid = wgid / nig, fm = gid * WGM, gsz = (nM - fm) < WGM ? (nM - fm) : WGM; pm_ = fm + ((wgid % nig) % gsz); pn_ = (wgid % nig) / gsz; } } while (0)
#define PG_ABASE(pm_, seg_) ((const char*)((seg_) ? g.A2 : g.A) + (size_t)(pm_) * tstep)
#define PG_BBASE(pm_, pn_, seg_) ((const char*)((seg_) ? g.Bt2 : g.Bt) + ((EPI == EPI_KV && (pm_) >= 9) ? g.bt_layer_stride * 2 : (size_t)0) + (size_t)(pn_) * tstep)
    int pm = 0, pn = 0, seg = 0, npm = 0, npn = 0, nseg = 0, ui = 0; bool ok;
    PG_NEXT(0, pm, pn, seg, ok);
    if (!ok) return;
    f32x4 acc[2][2][4][2];
#pragma unroll
    for (int a = 0; a < 2; ++a)
#pragma unroll
        for (int b = 0; b < 2; ++b)
#pragma unroll
            for (int m = 0; m < 4; ++m)
#pragma unroll
                for (int n = 0; n < 2; ++n) acc[a][b][m][n] = (f32x4){0.f, 0.f, 0.f, 0.f};
    bf16x8 At[4][2], B0[2][2], B1[2][2];
    const char* cA = PG_ABASE(pm, seg); const char* cB = PG_BBASE(pm, pn, seg);
    asm volatile("s_waitcnt vmcnt(0) lgkmcnt(0)" ::: "memory"); PG_BAR; PG_SCHED;
    PG_STAGE(PG_SB(0, 0), cB); PG_STAGE(PG_SA(0, 0), cA); PG_STAGE(PG_SB(0, 1), cB + hstep); PG_STAGE(PG_SA(0, 1), cA + hstep);
    if (wr == 1) PG_BAR;
    PG_WAIT_V(4); PG_BAR;
    PG_STAGE(PG_SB(1, 0), cB + kstep); PG_STAGE(PG_SA(1, 0), cA + kstep); PG_STAGE(PG_SB(1, 1), cB + hstep + kstep);
    PG_WAIT_V(6); PG_BAR;
    for (;;) {
        bool has_next; PG_NEXT(ui + 1, npm, npn, nseg, has_next);
        const char* nA = has_next ? PG_ABASE(npm, nseg) : cA; const char* nB = has_next ? PG_BBASE(npm, npn, nseg) : cB;
        for (int t = 0; t < nt; t += 2) {
            const bool last = (t == nt - 2);
            const char* a1 = cA + (size_t)(t + 1) * kstep;
            const char* a2 = last ? nA : cA + (size_t)(t + 2) * kstep; const char* b2 = last ? nB : cB + (size_t)(t + 2) * kstep;
            const char* a3 = a2 + kstep; const char* b3 = b2 + kstep;
            PG_LDB(B0, 0, 0); PG_SCHED; PG_LDA(At, 0, 0); PG_STAGE(PG_SA(1, 1), a1 + hstep);
            PG_WAIT_L(8); PG_BAR; PG_WAIT_L(0); PG_MMA(0, 0, At, B0); PG_BAR; PG_SCHED;
            PG_LDB(B1, 0, 1); PG_STAGE(PG_SB(0, 0), b2);
            PG_BAR; PG_WAIT_L(0); PG_MMA(0, 1, At, B1); PG_BAR;
            PG_LDA(At, 0, 1); PG_STAGE(PG_SA(0, 0), a2);
            PG_BAR; PG_WAIT_L(0); PG_MMA(1, 0, At, B0); PG_BAR; PG_SCHED;
            PG_STAGE(PG_SB(0, 1), b2 + hstep);
            PG_WAIT_V(6); PG_BAR; PG_MMA(1, 1, At, B1); PG_BAR;
            PG_LDB(B0, 1, 0); PG_SCHED; PG_LDA(At, 1, 0); PG_STAGE(PG_SA(0, 1), a2 + hstep);
            PG_WAIT_L(8); PG_BAR; PG_WAIT_L(0); PG_MMA(0, 0, At, B0); PG_BAR; PG_SCHED;
            PG_LDB(B1, 1, 1); PG_STAGE(PG_SB(1, 0), b3);
            PG_BAR; PG_WAIT_L(0); PG_MMA(0, 1, At, B1); PG_BAR;
            PG_LDA(At, 1, 1); PG_STAGE(PG_SA(1, 0), a3);
            PG_BAR; PG_WAIT_L(0); PG_MMA(1, 0, At, B0); PG_BAR; PG_SCHED;
            PG_STAGE(PG_SB(1, 1), b3 + hstep);
            PG_WAIT_V(6); PG_BAR; PG_MMA(1, 1, At, B1); PG_BAR;
        }
        const int brow = pm * BM, bcol = pn * BM;
        const int r0 = brow + wr * 64 + fr, c0 = bcol + wc * 32 + fq * 4;
        if (EPI == EPI_RES) {
        } else if (EPI == EPI_MIX) {
          if (seg == 0) {
#pragma unroll
            for (int ai = 0; ai < 2; ++ai)
#pragma unroll
                for (int m = 0; m < 4; ++m) {
                    const bf16_t* pr = g.proj + (size_t)(r0 + ai * 128 + m * 16) * PC + c0;
#pragma unroll
                    for (int bj = 0; bj < 2; ++bj)
#pragma unroll
                        for (int n = 0; n < 2; ++n) {
                            const u32x2 gc = *(const u32x2*)(pr + C_GC + bj * 128 + n * 16), gr = *(const u32x2*)(pr + C_GR + bj * 128 + n * 16);
                            f32x4 v = acc[ai][bj][m][n];
                            v[0] *= bflo(gc[0]) * __builtin_amdgcn_rcpf(bflo(gr[0])); v[1] *= bfhi(gc[0]) * __builtin_amdgcn_rcpf(bfhi(gr[0]));
                            v[2] *= bflo(gc[1]) * __builtin_amdgcn_rcpf(bflo(gr[1])); v[3] *= bfhi(gc[1]) * __builtin_amdgcn_rcpf(bfhi(gr[1]));
                            acc[ai][bj][m][n] = v;
                        }
                }
          } else {
#pragma unroll
            for (int ai = 0; ai < 2; ++ai)
#pragma unroll
                for (int m = 0; m < 4; ++m) {
                    const size_t row = (size_t)(r0 + ai * 128 + m * 16);
                    const bf16_t* pr = g.proj + row * PC + c0;
                    bf16_t* o = (bf16_t*)g.out + row * 1024 + c0;
#pragma unroll
                    for (int bj = 0; bj < 2; ++bj)
#pragma unroll
                        for (int n = 0; n < 2; ++n) {
                            const u32x2 gr = *(const u32x2*)(pr + C_GR + bj * 128 + n * 16);
                            const f32x4 v = acc[ai][bj][m][n];
                            u32x2 w; w[0] = cvt_pk_bf16(v[0] * bflo(gr[0]), v[1] * bfhi(gr[0])); w[1] = cvt_pk_bf16(v[2] * bflo(gr[1]), v[3] * bfhi(gr[1]));
                            *(u32x2*)(o + bj * 128 + n * 16) = w;
                        }
                }
          }
        } else if (EPI == EPI_F32) {
#pragma unroll
            for (int ai = 0; ai < 2; ++ai)
#pragma unroll
                for (int m = 0; m < 4; ++m) {
                    float* o = (float*)g.out + (size_t)(r0 + ai * 128 + m * 16) * g.N + c0;
#pragma unroll
                    for (int bj = 0; bj < 2; ++bj)
#pragma unroll
                        for (int n = 0; n < 2; ++n) *(f32x4*)(o + bj * 128 + n * 16) = acc[ai][bj][m][n];
                }
        } else if (EPI == EPI_BF16 || EPI == EPI_PROJ) {
            const bool sg = (EPI == EPI_PROJ) && (bcol >= C_GC);
#pragma unroll
            for (int ai = 0; ai < 2; ++ai)
#pragma unroll
                for (int m = 0; m < 4; ++m) {
                    bf16_t* o = (bf16_t*)g.out + (size_t)(r0 + ai * 128 + m * 16) * g.N + c0;
#pragma unroll
                    for (int bj = 0; bj < 2; ++bj)
#pragma unroll
                        for (int n = 0; n < 2; ++n) {
                            f32x4 v = acc[ai][bj][m][n];
                            if (sg) {
                                const f32x4 b = *(const f32x4*)(g.gate_b + (c0 - C_GC) + bj * 128 + n * 16);
#pragma unroll
                                for (int j = 0; j < 4; ++j) v[j] = sigmoidf_(v[j] + b[j]);
                            }
                            u32x2 w; w[0] = cvt_pk_bf16(v[0], v[1]); w[1] = cvt_pk_bf16(v[2], v[3]);
                            *(u32x2*)(o + bj * 128 + n * 16) = w;
                        }
                }
        } else if (EPI == EPI_SWIGLU) {
            const int hc0 = (bcol >> 1) + wc * 32 + fq * 4;
#pragma unroll
            for (int ai = 0; ai < 2; ++ai)
#pragma unroll
                for (int m = 0; m < 4; ++m) {
                    bf16_t* o = (bf16_t*)g.out + (size_t)(r0 + ai * 128 + m * 16) * (g.N >> 1) + hc0;
#pragma unroll
                    for (int n = 0; n < 2; ++n) {
                        const f32x4 ga = acc[ai][0][m][n], up = acc[ai][1][m][n];
                        u32x2 w; w[0] = cvt_pk_bf16(siluf_(ga[0]) * up[0], siluf_(ga[1]) * up[1]); w[1] = cvt_pk_bf16(siluf_(ga[2]) * up[2], siluf_(ga[3]) * up[3]);
                        *(u32x2*)(o + n * 16) = w;
                    }
                }
        } else {
#pragma unroll
            for (int ai = 0; ai < 2; ++ai)
#pragma unroll
                for (int m = 0; m < 4; ++m) {
                    const int row = r0 + ai * 128 + m * 16;
#pragma unroll
                    for (int bj = 0; bj < 2; ++bj)
#pragma unroll
                        for (int n = 0; n < 2; ++n) {
                            const f32x4 v = acc[ai][bj][m][n];
                            const int col = c0 + bj * 128 + n * 16;
                            if (bcol < 1024) {
                                u32x2 w; w[0] = cvt_pk_bf16(v[0], v[1]); w[1] = cvt_pk_bf16(v[2], v[3]);
                                *(u32x2*)((bf16_t*)g.out + (size_t)row * 1024 + col) = w;
                            } else {
                                const int hh = (col - 1024) >> 8, d = (col - 1024) & 255, lb = row >> 8, mm = row & 255;
                                bf16_t* o = g.out2 + ((size_t)(lb * 4 + hh) * 256 + d) * 256 + mm;
#pragma unroll
                                for (int j = 0; j < 4; ++j) o[j * 256] = f2bf(v[j]);
                            }
                        }
                }
        }
        if (!has_next) break;
        if (!(dual && seg == 0)) {
#pragma unroll
            for (int a = 0; a < 2; ++a)
#pragma unroll
                for (int b = 0; b < 2; ++b)
#pragma unroll
                    for (int m = 0; m < 4; ++m)
#pragma unroll
                        for (int n = 0; n < 2; ++n) acc[a][b][m][n] = (f32x4){0.f, 0.f, 0.f, 0.f};
        }
        pm = npm; pn = npn; seg = nseg; cA = nA; cB = nB; ++ui;
    }
    PG_WAIT_V(0);
    if (wr == 0) PG_BAR;
    PG_BAR;
    if (EPI == EPI_RES) {
        LAS float* P = (LAS float*)lds;
        LAS float* Sr = (LAS float*)(lds + 4096);
        const int brow = pm * BM, bcol = pn * BM;
        const int r0 = brow + wr * 64 + fr, c0 = bcol + wc * 32 + fq * 4, lr0 = wr * 64 + fr;
#pragma unroll 1
        for (int e = 0; e < 2; ++e) {
            if (e == 1 && g.gnext == nullptr) break;
#pragma unroll
            for (int ai = 0; ai < 2; ++ai)
#pragma unroll
                for (int m = 0; m < 4; ++m) {
                    float q = 0.f;
#pragma unroll
                    for (int bj = 0; bj < 2; ++bj)
#pragma unroll
                        for (int n = 0; n < 2; ++n) { const f32x4 v = acc[ai][bj][m][n]; q += (v[0] * v[0] + v[1] * v[1]) + (v[2] * v[2] + v[3] * v[3]); }
                    q += __shfl_xor(q, 16); q += __shfl_xor(q, 32);
                    if (fq == 0) P[(ai * 128 + lr0 + m * 16) * 4 + wc] = q;
                }
            __syncthreads();
            float* xb = g.xbuf + (size_t)e * 65536 + (size_t)pm * 1024;
            unsigned* cn = g.cnt + (size_t)e * 4096 + (size_t)pm * 64;
            if (tid < 256) {
                const float tot = (P[tid * 4] + P[tid * 4 + 1]) + (P[tid * 4 + 2] + P[tid * 4 + 3]);
                __hip_atomic_store((unsigned*)xb + tid * 4 + pn, __float_as_uint(tot), __ATOMIC_RELAXED, __HIP_MEMORY_SCOPE_AGENT);
            }
            asm volatile("s_waitcnt vmcnt(0)" ::: "memory");
            __syncthreads();
            if (tid == 0) {
                (void)__hip_atomic_fetch_add(cn, 1u, __ATOMIC_RELAXED, __HIP_MEMORY_SCOPE_AGENT);
                unsigned sp = 0;
                const unsigned want = g.expect - (unsigned)e * g.skip1;
                while (__hip_atomic_load(cn, __ATOMIC_RELAXED, __HIP_MEMORY_SCOPE_AGENT) < want) { __builtin_amdgcn_s_sleep(1); if (++sp > (1u << 22)) break; }
            }
            __syncthreads();
            if (tid < 256) {
                unsigned* xu = (unsigned*)xb + tid * 4;
                const float t0 = __uint_as_float(__hip_atomic_load(xu + 0, __ATOMIC_RELAXED, __HIP_MEMORY_SCOPE_AGENT)), t1 = __uint_as_float(__hip_atomic_load(xu + 1, __ATOMIC_RELAXED, __HIP_MEMORY_SCOPE_AGENT));
                const float t2 = __uint_as_float(__hip_atomic_load(xu + 2, __ATOMIC_RELAXED, __HIP_MEMORY_SCOPE_AGENT)), t3 = __uint_as_float(__hip_atomic_load(xu + 3, __ATOMIC_RELAXED, __HIP_MEMORY_SCOPE_AGENT));
                Sr[tid] = 1.0f / sqrtf(((t0 + t1) + (t2 + t3)) * (1.f / 1024.f) + 1e-6f);
            }
            __syncthreads();
            if (e == 0) {
#pragma unroll
                for (int ai = 0; ai < 2; ++ai)
#pragma unroll
                    for (int m = 0; m < 4; ++m) {
                        const float r = Sr[ai * 128 + lr0 + m * 16] * g.scale;
                        float* xr = g.X + (size_t)(r0 + ai * 128 + m * 16) * 1024 + c0;
#pragma unroll
                        for (int bj = 0; bj < 2; ++bj)
#pragma unroll
                            for (int n = 0; n < 2; ++n) {
                                const f32x4 x = *(const f32x4*)(xr + bj * 128 + n * 16);
                                const f32x4 gp = *(const f32x4*)(g.gpost + c0 + bj * 128 + n * 16);
                                const f32x4 v = x + acc[ai][bj][m][n] * r * gp;
                                acc[ai][bj][m][n] = v;
                                *(f32x4*)(xr + bj * 128 + n * 16) = v;
                            }
                    }
            } else {
#pragma unroll
                for (int ai = 0; ai < 2; ++ai)
#pragma unroll
                    for (int m = 0; m < 4; ++m) {
                        const float r = Sr[ai * 128 + lr0 + m * 16];
                        bf16_t* hr = g.Hout + (size_t)(r0 + ai * 128 + m * 16) * 1024 + c0;
#pragma unroll
                        for (int bj = 0; bj < 2; ++bj)
#pragma unroll
                            for (int n = 0; n < 2; ++n) {
                                const f32x4 gn = *(const f32x4*)(g.gnext + c0 + bj * 128 + n * 16);
                                const f32x4 v = acc[ai][bj][m][n] * r * gn;
                                u32x2 w; w[0] = cvt_pk_bf16(v[0], v[1]); w[1] = cvt_pk_bf16(v[2], v[3]);
                                *(u32x2*)(hr + bj * 128 + n * 16) = w;
                            }
                    }
            }
        }
    }
#undef PG_SA
#undef PG_SB
#undef PG_STAGE
#undef PG_LDA
#undef PG_LDB
#undef PG_MMA
#undef PG_NEXT
#undef PG_ABASE
#undef PG_BBASE
}

DEV void transpose_mat(const float* __restrict__ src, const int K, const int N, bf16_t* __restrict__ dst, const int perm, const float scale) {
    float* tile = (float*)g_lds;
    const int nkt = K / 64, ntile = nkt * (N / 64), tid = TIDX, bid = BIDX;
    for (int t = bid; t < ntile; t += gridDim.x) {
        const int rt = t / nkt, kt = t - rt * nkt, rho0 = rt * 64;
        const int cbase = perm ? (((rho0 & 255) >> 7) * 2816 + (rho0 >> 8) * 128 + (rho0 & 127)) : rho0;
        __syncthreads();
#pragma unroll
        for (int i = 0; i < 8; ++i) { const int kk = (tid >> 6) + 8 * i, cc = tid & 63; tile[kk * 65 + cc] = src[(size_t)(kt * 64 + kk) * N + cbase + cc]; }
        __syncthreads();
#pragma unroll
        for (int i = 0; i < 4; ++i) {
            const int rr = (tid >> 5) + 16 * i, k2 = (tid & 31) * 2;
            *(unsigned*)(dst + (size_t)(rho0 + rr) * K + kt * 64 + k2) = cvt_pk_bf16(tile[k2 * 65 + rr] * scale, tile[(k2 + 1) * 65 + rr] * scale);
        }
    }
}

DEV void setup_phase(const Params& p) {
    bf16_t* wt = (bf16_t*)(p.ws + WS_WT);
    for (int l = 0; l < 2; ++l) {
        bf16_t* w = wt + (size_t)l * WL;
        transpose_mat(p.in[5] + (size_t)l * 1024 * 5632, 1024, 5632, w + O_GU1, 1, 1.f);
        transpose_mat(p.in[6] + (size_t)l * 2816 * 1024, 2816, 1024, w + O_D1, 0, 1.f);
        transpose_mat(p.in[7] + (size_t)l * 1024 * 5120, 1024, 5120, w + O_IN, 0, 1.f);
        transpose_mat(p.in[12] + (size_t)l * 512 * 1024, 512, 1024, w + O_PW, 0, 1.f);
        transpose_mat(p.in[16] + (size_t)l * 512 * 1024, 512, 1024, w + O_RO, 0, 1.f);
        transpose_mat(p.in[18] + (size_t)l * 1024 * 1024, 1024, 1024, w + O_MIX, 0, 1.f);
        transpose_mat(p.in[20] + (size_t)l * 1024 * 1024, 1024, 1024, w + O_Q, 0, 0.0625f);
        transpose_mat(p.in[21] + (size_t)l * 1024 * 2048, 1024, 2048, w + O_KV, 0, 1.f);
        transpose_mat(p.in[22] + (size_t)l * 1024 * 1024, 1024, 1024, w + O_O, 0, 1.f);
        transpose_mat(p.in[23] + (size_t)l * 1024 * 5632, 1024, 5632, w + O_GU2, 1, 1.f);
        transpose_mat(p.in[24] + (size_t)l * 2816 * 1024, 2816, 1024, w + O_D2, 0, 1.f);
    }
    float2* rot = (float2*)(p.ws + WS_ROT);
    const int tid0 = TIDX, bid0 = BIDX;
    for (int idx = bid0 * NTHREADS + tid0; idx < 16384 * 32; idx += gridDim.x * NTHREADS) {
        const int pos = idx >> 5, i = idx & 31;
        const float ang = (float)pos * p.inv_freq[i];
        double rev = (double)ang * 0.15915494309189535;
        rev -= floor(rev);
        const float fr = (float)rev;
        rot[idx] = make_float2(__builtin_amdgcn_cosf(fr), __builtin_amdgcn_sinf(fr));
    }
    bf16_t* memn = (bf16_t*)(p.ws + WS_MEMN);
    const int lane = tid0 & 63, gw = bid0 * 8 + (tid0 >> 6), nw = gridDim.x * 8;
    for (int rr = gw; rr < 2 * 2304; rr += nw) {
        const int l = rr / 2304, row = rr - l * 2304;
        const float* src = row < 2048 ? p.in[2] + (size_t)row * 1024 : p.in[3] + (size_t)(row - 2048) * 1024;
        const float* mg = p.in[19] + l * 1024;
        f32x4 x[4]; float ss = 0.f;
#pragma unroll
        for (int i = 0; i < 4; ++i) { x[i] = *(const f32x4*)(src + i * 256 + lane * 4); ss += x[i][0] * x[i][0] + x[i][1] * x[i][1] + x[i][2] * x[i][2] + x[i][3] * x[i][3]; }
        ss = wave_sum(ss);
        const float r = 1.0f / sqrtf(ss * (1.f / 1024.f) + 1e-6f);
#pragma unroll
        for (int i = 0; i < 4; ++i) {
            const f32x4 gg = *(const f32x4*)(mg + i * 256 + lane * 4);
            u32x2 w; w[0] = cvt_pk_bf16(x[i][0] * r * gg[0], x[i][1] * r * gg[1]); w[1] = cvt_pk_bf16(x[i][2] * r * gg[2], x[i][3] * r * gg[3]);
            *(u32x2*)(memn + (size_t)rr * 1024 + i * 256 + lane * 4) = w;
        }
    }
}

DEV void rowwise_phase(const float* __restrict__ Xsrc, float* __restrict__ X, const float* __restrict__ F, const float scale,
                       const float* __restrict__ gpost, const float* __restrict__ gnext, bf16_t* __restrict__ H) {
    const int tid0 = TIDX, bid0 = BIDX;
    const int lane = tid0 & 63, gw = bid0 * 8 + (tid0 >> 6), nw = gridDim.x * 8;
    for (int row = gw; row < TG; row += nw) {
        f32x4 x[4];
#pragma unroll
        for (int i = 0; i < 4; ++i) x[i] = *(const f32x4*)(Xsrc + (size_t)row * 1024 + i * 256 + lane * 4);
        if (F) {
            f32x4 f[4]; float ss = 0.f;
#pragma unroll
            for (int i = 0; i < 4; ++i) { f[i] = *(const f32x4*)(F + (size_t)row * 1024 + i * 256 + lane * 4); ss += f[i][0] * f[i][0] + f[i][1] * f[i][1] + f[i][2] * f[i][2] + f[i][3] * f[i][3]; }
            ss = wave_sum(ss);
            const float r = scale / sqrtf(ss * (1.f / 1024.f) + 1e-6f);
#pragma unroll
            for (int i = 0; i < 4; ++i) { const f32x4 gp = *(const f32x4*)(gpost + i * 256 + lane * 4); x[i] += f[i] * r * gp; }
        }
#pragma unroll
        for (int i = 0; i < 4; ++i) *(f32x4*)(X + (size_t)row * 1024 + i * 256 + lane * 4) = x[i];
        if (gnext) {
            float ss = 0.f;
#pragma unroll
            for (int i = 0; i < 4; ++i) ss += x[i][0] * x[i][0] + x[i][1] * x[i][1] + x[i][2] * x[i][2] + x[i][3] * x[i][3];
            ss = wave_sum(ss);
            const float r = 1.0f / sqrtf(ss * (1.f / 1024.f) + 1e-6f);
#pragma unroll
            for (int i = 0; i < 4; ++i) {
                const f32x4 gg = *(const f32x4*)(gnext + i * 256 + lane * 4);
                u32x2 w; w[0] = cvt_pk_bf16(x[i][0] * r * gg[0], x[i][1] * r * gg[1]); w[1] = cvt_pk_bf16(x[i][2] * r * gg[2], x[i][3] * r * gg[3]);
                *(u32x2*)(H + (size_t)row * 1024 + i * 256 + lane * 4) = w;
            }
        }
    }
}

DEV void conv_phase(const bf16_t* __restrict__ PROJ, bf16_t* __restrict__ CV, const float* __restrict__ dw_w, const float* __restrict__ dw_b,
                    const float* __restrict__ ln_g, const float* __restrict__ ln_b, const int S) {
    bf16_t* us = (bf16_t*)g_lds;
    float* red = (float*)(g_lds + 62 * 512 * 2);
    float* stat = red + 8 * 32 * 2;
    const int tid = TIDX, bid = BIDX, c = tid, wid = tid >> 6, lane = tid & 63;
    float w[31];
#pragma unroll
    for (int k = 0; k < 31; ++k) w[k] = dw_w[k * 512 + c];
    const float bias = dw_b[c], lg = ln_g[c], lb = ln_b[c];
    for (int u = bid; u < TG / 32; u += gridDim.x) {
        const int t0 = u * 32, seq = t0 / S, pos0 = t0 - seq * S;
        __syncthreads();
        const int cg8 = (tid & 63) * 8;
#pragma unroll
        for (int it = 0; it < 8; ++it) {
            const int tt = it * 8 + (tid >> 6);
            if (tt < 62) {
                const int pos = pos0 - 15 + tt;
                u32x4 o = {0u, 0u, 0u, 0u};
                if (pos >= 0 && pos < S) {
                    const bf16_t* pr = PROJ + (size_t)(seq * S + pos) * PC;
                    const u32x4 v = *(const u32x4*)(pr + cg8), gt = *(const u32x4*)(pr + 512 + cg8);
#pragma unroll
                    for (int q = 0; q < 4; ++q) o[q] = cvt_pk_bf16(bflo(v[q]) * sigmoidf_(bflo(gt[q])), bfhi(v[q]) * sigmoidf_(bfhi(gt[q])));
                }
                *(u32x4*)(us + tt * 512 + cg8) = o;
            }
        }
        __syncthreads();
        float acc[32];
#pragma unroll
        for (int seg = 0; seg < 4; ++seg) {
#pragma unroll
            for (int s = 0; s < 8; ++s) acc[seg * 8 + s] = bias;
#pragma unroll
            for (int kk = 0; kk < 38; ++kk) {
                const float uv = bf2f(us[(seg * 8 + kk) * 512 + c]);
#pragma unroll
                for (int s = 0; s < 8; ++s) { const int k = kk - s; if (k >= 0 && k < 31) acc[seg * 8 + s] += w[k] * uv; }
            }
        }
#pragma unroll
        for (int s = 0; s < 32; ++s) {
            const float s1 = wave_sum(acc[s]), s2 = wave_sum(acc[s] * acc[s]);
            if (lane == 0) { red[(wid * 32 + s) * 2] = s1; red[(wid * 32 + s) * 2 + 1] = s2; }
        }
        __syncthreads();
        if (tid < 32) {
            float s1 = 0.f, s2 = 0.f;
#pragma unroll
            for (int q = 0; q < 8; ++q) { s1 += red[(q * 32 + tid) * 2]; s2 += red[(q * 32 + tid) * 2 + 1]; }
            const float mean = s1 * (1.f / 512.f), var = fmaxf(s2 * (1.f / 512.f) - mean * mean, 0.f);
            stat[tid * 2] = mean; stat[tid * 2 + 1] = 1.0f / sqrtf(var + 1e-6f);
        }
        __syncthreads();
#pragma unroll
        for (int s = 0; s < 32; ++s) {
            const float y = (acc[s] - stat[s * 2]) * stat[s * 2 + 1] * lg + lb;
            CV[(size_t)(t0 + s) * 512 + c] = f2bf(siluf_(y));
        }
    }
}

template <int I> DEV float bfel(const u32x4& v) { return (I & 1) ? bfhi(v[I >> 1]) : bflo(v[I >> 1]); }

DEV void r1_phase(const bf16_t* __restrict__ PROJ, const float2* __restrict__ rot, float* __restrict__ KVST,
                  const float* __restrict__ dec_f, const float* __restrict__ dec_b, const int S) {
    bf16_t* vT = (bf16_t*)g_lds; bf16_t* kTf = vT + 64 * 136; bf16_t* kTb = kTf + 64 * 136;
    const int tid = TIDX, bid = BIDX, wid = tid >> 6, lane = tid & 63, fr = lane & 15, fq = lane >> 4;
    const int j = tid >> 2, dq = (tid & 3) * 8;
    for (int unit = bid; unit < (TG / 128) * 8; unit += gridDim.x) {
        const int cidx = unit >> 3, h = unit & 7, t0 = cidx * 128, seq = t0 / S, pos0 = t0 - seq * S;
        const float lgf2 = -expf(dec_f[h]) * 1.4426950408889634f, lgb2 = -expf(dec_b[h]) * 1.4426950408889634f;
        __syncthreads();
        const bf16_t* pr = PROJ + (size_t)(t0 + j) * PC;
        const u32x4 k1 = *(const u32x4*)(pr + C_K + h * 64 + dq), k2 = *(const u32x4*)(pr + C_K + h * 64 + 32 + dq);
        const float2* rp = rot + (size_t)(pos0 + j) * 32 + dq;
        const float df = exp2f(lgf2 * (float)(127 - j)), db = exp2f(lgb2 * (float)j);
#pragma unroll
        for (int i = 0; i < 8; ++i) {
            const float a = (i & 1) ? bfhi(k1[i >> 1]) : bflo(k1[i >> 1]), b = (i & 1) ? bfhi(k2[i >> 1]) : bflo(k2[i >> 1]);
            const float2 cs = rp[i];
            const float r1 = (a * cs.x - b * cs.y) * 0.125f, r2 = (a * cs.y + b * cs.x) * 0.125f;
            kTf[(dq + i) * 136 + j] = f2bf(r1 * df); kTf[(32 + dq + i) * 136 + j] = f2bf(r2 * df);
            kTb[(dq + i) * 136 + j] = f2bf(r1 * db); kTb[(32 + dq + i) * 136 + j] = f2bf(r2 * db);
        }
        {
            const int e0 = (tid & 3) * 16;
            const u32x4 v1 = *(const u32x4*)(pr + C_V + h * 64 + e0), v2 = *(const u32x4*)(pr + C_V + h * 64 + e0 + 8);
#pragma unroll
            for (int i = 0; i < 4; ++i) {
                vT[(e0 + 2 * i) * 136 + j] = (bf16_t)(v1[i] & 0xffffu); vT[(e0 + 2 * i + 1) * 136 + j] = (bf16_t)(v1[i] >> 16);
                vT[(e0 + 8 + 2 * i) * 136 + j] = (bf16_t)(v2[i] & 0xffffu); vT[(e0 + 8 + 2 * i + 1) * 136 + j] = (bf16_t)(v2[i] >> 16);
            }
        }
        __syncthreads();
        const int dir = wid >> 2, et = wid & 3;
        const bf16_t* kT = dir ? kTb : kTf;
        bf16x8 a[4];
#pragma unroll
        for (int ks = 0; ks < 4; ++ks) a[ks] = *(const bf16x8*)(vT + (et * 16 + fr) * 136 + ks * 32 + fq * 8);
        float* o = KVST + ((size_t)(cidx * 8 + h) * 2 + dir) * 4096;
#pragma unroll
        for (int dt = 0; dt < 4; ++dt) {
            f32x4 acc = {0.f, 0.f, 0.f, 0.f};
#pragma unroll
            for (int ks = 0; ks < 4; ++ks) {
                const bf16x8 b = *(const bf16x8*)(kT + (dt * 16 + fr) * 136 + ks * 32 + fq * 8);
                acc = __builtin_amdgcn_mfma_f32_16x16x32_bf16(a[ks], b, acc, 0, 0, 0);
            }
#pragma unroll
            for (int jj = 0; jj < 4; ++jj) o[(et * 16 + fq * 4 + jj) * 64 + dt * 16 + fr] = acc[jj];
        }
    }
}

DEV void r2_phase(const float* __restrict__ KVST, bf16_t* __restrict__ PREV, const float* __restrict__ dec_f, const float* __restrict__ dec_b, const int S) {
    const int NC = S / 128, nseq = TG / S, total = nseq * 8 * 2 * 4096;
    const int tid0 = TIDX, bid0 = BIDX;
    for (int idx = bid0 * NTHREADS + tid0; idx < total; idx += gridDim.x * NTHREADS) {
        const int elem = idx & 4095, dir = (idx >> 12) & 1, h = (idx >> 13) & 7, seq = idx >> 16;
        const float lg = -expf((dir ? dec_b : dec_f)[h]);
        const float cd = expf(lg * 128.f);
        float st = 0.f;
#pragma unroll 8
        for (int n = 0; n < NC; ++n) {
            const int nn = dir ? NC - 1 - n : n;
            const size_t o = ((size_t)((seq * NC + nn) * 8 + h) * 2 + dir) * 4096 + elem;
            PREV[o] = f2bf(st);
            st = st * cd + KVST[o];
        }
    }
}

DEV void r3_phase(const bf16_t* __restrict__ PROJ, const float2* __restrict__ rot, const bf16_t* __restrict__ PREV, bf16_t* __restrict__ RT,
                  const float* __restrict__ dec_f, const float* __restrict__ dec_b, const float* __restrict__ gn_g, const int S) {
    bf16_t* Qs = (bf16_t*)g_lds; bf16_t* Ks = Qs + 128 * 72; bf16_t* vT = Ks + 128 * 72;
    const int tid = TIDX, bid = BIDX, wid = tid >> 6, lane = tid & 63, fr = lane & 15, fq = lane >> 4;
    const int j = tid >> 2, dq = (tid & 3) * 8;
    for (int unit = bid; unit < (TG / 128) * 8; unit += gridDim.x) {
        const int cidx = unit >> 3, h = unit & 7, t0 = cidx * 128, seq = t0 / S, pos0 = t0 - seq * S;
        const float lgf2 = -expf(dec_f[h]) * 1.4426950408889634f, lgb2 = -expf(dec_b[h]) * 1.4426950408889634f;
        __syncthreads();
        {
            const bf16_t* pr = PROJ + (size_t)(t0 + j) * PC;
            const u32x4 q1 = *(const u32x4*)(pr + C_Q + h * 64 + dq), q2 = *(const u32x4*)(pr + C_Q + h * 64 + 32 + dq);
            const u32x4 k1 = *(const u32x4*)(pr + C_K + h * 64 + dq), k2 = *(const u32x4*)(pr + C_K + h * 64 + 32 + dq);
            const float2* rp = rot + (size_t)(pos0 + j) * 32 + dq;
            u32x4 oq1, oq2, ok1, ok2;
#pragma unroll
            for (int i = 0; i < 4; ++i) {
                const float2 c0 = rp[2 * i], c1 = rp[2 * i + 1];
                const float qa0 = bflo(q1[i]), qa1 = bfhi(q1[i]), qb0 = bflo(q2[i]), qb1 = bfhi(q2[i]);
                const float ka0 = bflo(k1[i]), ka1 = bfhi(k1[i]), kb0 = bflo(k2[i]), kb1 = bfhi(k2[i]);
                oq1[i] = cvt_pk_bf16(qa0 * c0.x - qb0 * c0.y, qa1 * c1.x - qb1 * c1.y);
                oq2[i] = cvt_pk_bf16(qa0 * c0.y + qb0 * c0.x, qa1 * c1.y + qb1 * c1.x);
                ok1[i] = cvt_pk_bf16((ka0 * c0.x - kb0 * c0.y) * 0.125f, (ka1 * c1.x - kb1 * c1.y) * 0.125f);
                ok2[i] = cvt_pk_bf16((ka0 * c0.y + kb0 * c0.x) * 0.125f, (ka1 * c1.y + kb1 * c1.x) * 0.125f);
            }
            *(u32x4*)(Qs + j * 72 + dq) = oq1; *(u32x4*)(Qs + j * 72 + 32 + dq) = oq2;
            *(u32x4*)(Ks + j * 72 + dq) = ok1; *(u32x4*)(Ks + j * 72 + 32 + dq) = ok2;
            const int e0 = (tid & 3) * 16;
            const u32x4 v1 = *(const u32x4*)(pr + C_V + h * 64 + e0), v2 = *(const u32x4*)(pr + C_V + h * 64 + e0 + 8);
#pragma unroll
            for (int i = 0; i < 4; ++i) {
                vT[(e0 + 2 * i) * 136 + j] = (bf16_t)(v1[i] & 0xffffu); vT[(e0 + 2 * i + 1) * 136 + j] = (bf16_t)(v1[i] >> 16);
                vT[(e0 + 8 + 2 * i) * 136 + j] = (bf16_t)(v2[i] & 0xffffu); vT[(e0 + 8 + 2 * i + 1) * 136 + j] = (bf16_t)(v2[i] >> 16);
            }
        }
        __syncthreads();
        const int i0 = wid * 16, ii = i0 + fr;
        bf16x8 bq[2];
#pragma unroll
        for (int ks = 0; ks < 2; ++ks) bq[ks] = *(const bf16x8*)(Qs + (i0 + fr) * 72 + ks * 32 + fq * 8);
        f32x4 s[8];
#pragma unroll
        for (int jt = 0; jt < 8; ++jt) {
            s[jt] = (f32x4){0.f, 0.f, 0.f, 0.f};
#pragma unroll
            for (int ks = 0; ks < 2; ++ks) {
                const bf16x8 a = *(const bf16x8*)(Ks + (jt * 16 + fr) * 72 + ks * 32 + fq * 8);
                s[jt] = __builtin_amdgcn_mfma_f32_16x16x32_bf16(a, bq[ks], s[jt], 0, 0, 0);
            }
#pragma unroll
            for (int jj = 0; jj < 4; ++jj) {
                const int delta = ii - (jt * 16 + fq * 4 + jj);
                const float fac = delta >= 0 ? exp2f(lgf2 * (float)delta) : exp2f(lgb2 * (float)(-delta));
                s[jt][jj] *= fac;
            }
        }
        bf16x8 bp[4];
#pragma unroll
        for (int k2 = 0; k2 < 4; ++k2) {
            u32x4 w; w[0] = cvt_pk_bf16(s[2 * k2][0], s[2 * k2][1]); w[1] = cvt_pk_bf16(s[2 * k2][2], s[2 * k2][3]);
            w[2] = cvt_pk_bf16(s[2 * k2 + 1][0], s[2 * k2 + 1][1]); w[3] = cvt_pk_bf16(s[2 * k2 + 1][2], s[2 * k2 + 1][3]);
            bp[k2] = __builtin_bit_cast(bf16x8, w);
        }
        const bf16_t* pf = PREV + ((size_t)(cidx * 8 + h) * 2) * 4096;
        const bf16_t* pb = pf + 4096;
        const float qf = exp2f(lgf2 * (float)(ii + 1)), qb = exp2f(lgb2 * (float)(128 - ii));
        f32x4 o[4];
#pragma unroll
        for (int et = 0; et < 4; ++et) {
            o[et] = (f32x4){0.f, 0.f, 0.f, 0.f};
#pragma unroll
            for (int k2 = 0; k2 < 4; ++k2) {
                const u32x2 lo = *(const u32x2*)(vT + (et * 16 + fr) * 136 + (2 * k2) * 16 + fq * 4);
                const u32x2 hi = *(const u32x2*)(vT + (et * 16 + fr) * 136 + (2 * k2 + 1) * 16 + fq * 4);
                u32x4 w; w[0] = lo[0]; w[1] = lo[1]; w[2] = hi[0]; w[3] = hi[1];
                o[et] = __builtin_amdgcn_mfma_f32_16x16x32_bf16(__builtin_bit_cast(bf16x8, w), bp[k2], o[et], 0, 0, 0);
            }
            f32x4 cf = {0.f, 0.f, 0.f, 0.f}, cb = {0.f, 0.f, 0.f, 0.f};
#pragma unroll
            for (int ks = 0; ks < 2; ++ks) {
                const bf16x8 af = *(const bf16x8*)(pf + (et * 16 + fr) * 64 + ks * 32 + fq * 8);
                const bf16x8 ab = *(const bf16x8*)(pb + (et * 16 + fr) * 64 + ks * 32 + fq * 8);
                cf = __builtin_amdgcn_mfma_f32_16x16x32_bf16(af, bq[ks], cf, 0, 0, 0);
                cb = __builtin_amdgcn_mfma_f32_16x16x32_bf16(ab, bq[ks], cb, 0, 0, 0);
            }
            o[et] += cf * qf + cb * qb;
        }
        float sum = 0.f;
#pragma unroll
        for (int et = 0; et < 4; ++et) sum += (o[et][0] + o[et][1]) + (o[et][2] + o[et][3]);
        sum += __shfl_xor(sum, 16); sum += __shfl_xor(sum, 32);
        const float mu = sum * (1.f / 64.f);
        float vs = 0.f;
#pragma unroll
        for (int et = 0; et < 4; ++et) { const f32x4 d = o[et] - mu; vs += (d[0] * d[0] + d[1] * d[1]) + (d[2] * d[2] + d[3] * d[3]); }
        vs += __shfl_xor(vs, 16); vs += __shfl_xor(vs, 32);
        const float rstd = 1.0f / sqrtf(vs * (1.f / 64.f) + 1e-6f);
        const size_t tok = (size_t)(t0 + ii);
#pragma unroll
        for (int et = 0; et < 4; ++et) {
            const int e = et * 16 + fq * 4;
            const u32x2 gg = *(const u32x2*)(PROJ + tok * PC + C_G + h * 64 + e);
            const f32x4 gn = *(const f32x4*)(gn_g + h * 64 + e);
            const f32x4 y = (o[et] - mu) * rstd * gn;
            u32x2 w; w[0] = cvt_pk_bf16(siluf_(bflo(gg[0])) * y[0], siluf_(bfhi(gg[0])) * y[1]); w[1] = cvt_pk_bf16(siluf_(bflo(gg[1])) * y[2], siluf_(bfhi(gg[1])) * y[3]);
            *(u32x2*)(RT + tok * 512 + h * 64 + e) = w;
        }
    }
}

DEV int att_sw(int key) { return (key & 3) | ((key >> 1) & 12); }
DEV void attn_phase(const bf16_t* __restrict__ Q, const bf16_t* __restrict__ Kmem, const bf16_t* __restrict__ VmemT, bf16_t* __restrict__ O, const int S, const int g) {
    LAS unsigned char* lds = (LAS unsigned char*)g_lds;
    const int tid = TIDX, bid = BIDX, wid = tid >> 6, lane = tid & 63, fr = lane & 15, fq = lane >> 4;
    for (int unit = bid; unit < (TG / 256) * 4; unit += gridDim.x) {
        const int qb = unit >> 2, h = unit & 3, t0 = qb * 256, seq = t0 / S, b = (g < 2) ? g * 4 + seq : 8;
        const bf16_t* kb = Kmem + (size_t)(b * 256) * 1024 + h * 256;
        const bf16_t* vb = VmemT + ((size_t)(b * 4 + h) * 256) * 256;
        const size_t tok0 = (size_t)(t0 + wid * 16 + fr), tok1 = tok0 + 128;
        f32x4 s[2][16];
#pragma unroll
        for (int mt = 0; mt < 16; ++mt) { s[0][mt] = (f32x4){0.f, 0.f, 0.f, 0.f}; s[1][mt] = (f32x4){0.f, 0.f, 0.f, 0.f}; }
#pragma unroll 1
        for (int half = 0; half < 2; ++half) {
            __syncthreads();
#pragma unroll
            for (int i = 0; i < 8; ++i) {
                const int idx = tid + 512 * i, key = idx >> 4, ch = idx & 15;
                const u32x4 v = *(const u32x4*)(kb + (size_t)key * 1024 + half * 128 + ch * 8);
                *(LAS u32x4*)(lds + key * 256 + ((ch ^ att_sw(key)) << 4)) = v;
            }
            bf16x8 bq[2][4];
#pragma unroll
            for (int ks = 0; ks < 4; ++ks) {
                bq[0][ks] = *(const bf16x8*)(Q + tok0 * 1024 + h * 256 + half * 128 + ks * 32 + fq * 8);
                bq[1][ks] = *(const bf16x8*)(Q + tok1 * 1024 + h * 256 + half * 128 + ks * 32 + fq * 8);
            }
            __syncthreads();
#pragma unroll
            for (int mt = 0; mt < 16; ++mt) {
                const int key = 32 * (mt >> 1) + (fr >> 2) * 8 + (mt & 1) * 4 + (fr & 3);
#pragma unroll
                for (int ks = 0; ks < 4; ++ks) {
                    const bf16x8 a = *(const LAS bf16x8*)(lds + key * 256 + (((ks * 4 + fq) ^ fr) << 4));
                    s[0][mt] = __builtin_amdgcn_mfma_f32_16x16x32_bf16(a, bq[0][ks], s[0][mt], 0, 0, 0);
                    s[1][mt] = __builtin_amdgcn_mfma_f32_16x16x32_bf16(a, bq[1][ks], s[1][mt], 0, 0, 0);
                }
            }
        }
        bf16x8 bp[2][8]; float il[2];
#pragma unroll
        for (int qs = 0; qs < 2; ++qs) {
            float mx = -3.0e38f;
#pragma unroll
            for (int mt = 0; mt < 16; ++mt) mx = fmaxf(mx, fmaxf(fmaxf(s[qs][mt][0], s[qs][mt][1]), fmaxf(s[qs][mt][2], s[qs][mt][3])));
            mx = fmaxf(mx, __shfl_xor(mx, 16)); mx = fmaxf(mx, __shfl_xor(mx, 32));
            float l = 0.f;
#pragma unroll
            for (int mt = 0; mt < 16; ++mt) {
#pragma unroll
                for (int jj = 0; jj < 4; ++jj) { const float pv = __expf(s[qs][mt][jj] - mx); s[qs][mt][jj] = pv; l += pv; }
            }
            l += __shfl_xor(l, 16); l += __shfl_xor(l, 32);
            il[qs] = 1.0f / l;
#pragma unroll
            for (int k2 = 0; k2 < 8; ++k2) {
                u32x4 w; w[0] = cvt_pk_bf16(s[qs][2 * k2][0], s[qs][2 * k2][1]); w[1] = cvt_pk_bf16(s[qs][2 * k2][2], s[qs][2 * k2][3]);
                w[2] = cvt_pk_bf16(s[qs][2 * k2 + 1][0], s[qs][2 * k2 + 1][1]); w[3] = cvt_pk_bf16(s[qs][2 * k2 + 1][2], s[qs][2 * k2 + 1][3]);
                bp[qs][k2] = __builtin_bit_cast(bf16x8, w);
            }
        }
#pragma unroll 1
        for (int half = 0; half < 2; ++half) {
            __syncthreads();
#pragma unroll
            for (int i = 0; i < 8; ++i) {
                const int idx = tid + 512 * i, dd = idx >> 5, ch = idx & 31;
                const u32x4 v = *(const u32x4*)(vb + (size_t)(half * 128 + dd) * 256 + ch * 8);
                *(LAS u32x4*)(lds + dd * 512 + ((ch ^ (dd & 15)) << 4)) = v;
            }
            __syncthreads();
#pragma unroll
            for (int dt = 0; dt < 8; ++dt) {
                f32x4 o0 = {0.f, 0.f, 0.f, 0.f}, o1 = {0.f, 0.f, 0.f, 0.f};
#pragma unroll
                for (int k2 = 0; k2 < 8; ++k2) {
                    const bf16x8 a = *(const LAS bf16x8*)(lds + (dt * 16 + fr) * 512 + (((k2 * 4 + fq) ^ fr) << 4));
                    o0 = __builtin_amdgcn_mfma_f32_16x16x32_bf16(a, bp[0][k2], o0, 0, 0, 0);
                    o1 = __builtin_amdgcn_mfma_f32_16x16x32_bf16(a, bp[1][k2], o1, 0, 0, 0);
                }
                const int dcol = h * 256 + half * 128 + dt * 16 + fq * 4;
                u32x2 w; w[0] = cvt_pk_bf16(o0[0] * il[0], o0[1] * il[0]); w[1] = cvt_pk_bf16(o0[2] * il[0], o0[3] * il[0]);
                *(u32x2*)(O + tok0 * 1024 + dcol) = w;
                w[0] = cvt_pk_bf16(o1[0] * il[1], o1[1] * il[1]); w[1] = cvt_pk_bf16(o1[2] * il[1], o1[3] * il[1]);
                *(u32x2*)(O + tok1 * 1024 + dcol) = w;
            }
        }
    }
}

#define XB_TMO      128
#define XB_XCNT(j)  (256  + 64 * (j))
#define XB_XSUB(j)  (1280 + 64 * (j))
#define XB_XGEN(j)  (2304 + 64 * (j))
#define XB_TOP      3328
#define XB_TOPGEN   3392
#define XCD_BAR_WORDS 3456
#define XB_SPIN_CAP (1u << 22)
DEV unsigned xb_ld(unsigned* p)              { return __hip_atomic_load(p, __ATOMIC_RELAXED, __HIP_MEMORY_SCOPE_AGENT); }
DEV unsigned xb_add(unsigned* p, unsigned v) { return __hip_atomic_fetch_add(p, v, __ATOMIC_RELAXED, __HIP_MEMORY_SCOPE_AGENT); }
DEV unsigned xb_xcc_id() { return (unsigned)__builtin_amdgcn_s_getreg((3 << 11) | 20) & 0xFu; }
#define XB_SPIN(cond, bar) do { unsigned _sp = 0; while (cond) { __builtin_amdgcn_s_sleep(1); \
    if ((++_sp & 255u) == 0u) { if (xb_ld(&(bar)[XB_TMO])) break; if (_sp > XB_SPIN_CAP) { atomicAdd(&(bar)[XB_TMO], 1u); break; } } } } while (0)
struct XcdBarrier { unsigned* bar; unsigned x; volatile LAS unsigned* st; };
DEV XcdBarrier xcd_barrier_post(unsigned* bar, volatile LAS unsigned* st) {
    XcdBarrier b; b.bar = bar; b.x = xb_xcc_id(); b.st = st;
    if (threadIdx.x == 0) (void)xb_add(&bar[XB_XCNT(b.x)], 1u);
    return b;
}
DEV void xcd_barrier_complete(unsigned* bar, unsigned x, unsigned& nloc, unsigned& nx) {
    const unsigned G = gridDim.x * gridDim.y * gridDim.z;
    unsigned sum, cnt, mine, sp = 0u;
    for (;;) {
        sum = 0u; cnt = 0u; mine = 0u;
#pragma unroll
        for (unsigned j = 0; j < 16; ++j) { const unsigned c = xb_ld(&bar[XB_XCNT(j)]); sum += c; cnt += (c > 0u) ? 1u : 0u; mine = (j == x) ? c : mine; }
        if (sum == G) break;
        __builtin_amdgcn_s_sleep(1);
        if ((++sp & 255u) == 0u) { if (xb_ld(&bar[XB_TMO])) break; if (sp > XB_SPIN_CAP) { atomicAdd(&bar[XB_TMO], 1u); break; } }
    }
    nloc = mine > 0u ? mine : 1u; nx = cnt > 0u ? cnt : 1u;
}
DEV void xcd_barrier(const XcdBarrier& b) {
    asm volatile("s_waitcnt vmcnt(0)" ::: "memory");
    __syncthreads();
    if (threadIdx.x == 0) {
        unsigned* bar = b.bar;
        __builtin_amdgcn_s_waitcnt(0);
        unsigned nloc = b.st[0], nx = b.st[1];
        if (nloc == 0u) { xcd_barrier_complete(bar, b.x, nloc, nx); b.st[0] = nloc; b.st[1] = nx; }
        const unsigned old = xb_add(&bar[XB_XSUB(b.x)], 1u);
        const unsigned gen = old / nloc;
        if (old + 1u == (gen + 1u) * nloc) {
            __builtin_amdgcn_fence(__ATOMIC_RELEASE, "agent");
            asm volatile("s_waitcnt vmcnt(0)" ::: "memory");
            const unsigned og = xb_add(&bar[XB_TOP], 1u);
            const unsigned tg = og / nx;
            if (og + 1u == (tg + 1u) * nx) xb_add(&bar[XB_TOPGEN], 1u);
            else XB_SPIN(xb_ld(&bar[XB_TOPGEN]) == tg, bar);
            __builtin_amdgcn_fence(__ATOMIC_ACQUIRE, "agent");
            xb_add(&bar[XB_XGEN(b.x)], 1u);
            asm volatile("s_waitcnt vmcnt(0)" ::: "memory");
        } else {
            XB_SPIN(xb_ld(&bar[XB_XGEN(b.x)]) == gen, bar);
            __builtin_amdgcn_fence(__ATOMIC_ACQUIRE, "agent");
            asm volatile("s_waitcnt vmcnt(0)" ::: "memory");
        }
    }
    __syncthreads();
}

constexpr int PH_PER_GROUP = 27, N_PHASES = 2 + NGRP * PH_PER_GROUP;

DEV void run_phase(const Params& p, const int ph) {
    unsigned char* ws = p.ws;
    if (ph == 0) { setup_phase(p); return; }
    bf16_t* H = (bf16_t*)(ws + WS_H); bf16_t* HID = (bf16_t*)(ws + WS_HID); bf16_t* PROJ = (bf16_t*)(ws + WS_PROJ);
    bf16_t* MIXB = (bf16_t*)(ws + WS_MIXB); bf16_t* QB = (bf16_t*)(ws + WS_QB); bf16_t* OB = (bf16_t*)(ws + WS_OB);
    bf16_t* CV = (bf16_t*)(ws + WS_CV); bf16_t* RT = (bf16_t*)(ws + WS_RT);
    float* KVST = (float*)(ws + WS_KVST); bf16_t* PREV = (bf16_t*)(ws + WS_PREV);
    const float2* rot = (const float2*)(ws + WS_ROT);
    GemmDesc gd{};
    int kind = 0;
    int g = 0, l = 0, s = 0;
    if (ph == 1) {
        gd.A = (const bf16_t*)(ws + WS_MEMN); gd.Bt = (const bf16_t*)(ws + WS_WT) + O_KV; gd.M = 2 * 2304; gd.N = 2048; gd.K = 1024; gd.epi = EPI_KV;
        gd.out = ws + WS_KMEM; gd.out2 = (bf16_t*)(ws + WS_VMEMT); gd.bt_layer_stride = WL;
    } else {
        const int idx = ph - 2; g = idx / PH_PER_GROUP; const int r = idx - g * PH_PER_GROUP;
        if (r < 14) { l = 0; s = r; } else { l = 1; s = r - 13; }
    }
    const int S = (g < 2) ? 4096 : 16384;
    const bf16_t* W = (const bf16_t*)(ws + WS_WT) + (size_t)l * WL;
    const float* ng = p.in[4] + (size_t)l * 8 * 1024;
    const float* xin = (g < 2) ? p.in[0] + (size_t)g * TG * 1024 : p.in[1];
    float* X = p.out + (size_t)g * TG * 1024;
    int fk = -1;
    if (ph >= 2) {
        gd.M = TG; gd.X = X; gd.Hout = H; gd.xbuf = (float*)(ws + WS_XBUF); gd.cnt = (unsigned*)(ws + WS_CNT);
        switch (s) {
        case 0: kind = 1; break;
        case 1: gd.A = H; gd.Bt = W + O_GU1; gd.N = 5632; gd.K = 1024; gd.epi = EPI_SWIGLU; gd.out = HID; break;
        case 2: gd.A = HID; gd.Bt = W + O_D1; gd.N = 1024; gd.K = 2816; gd.epi = EPI_RES; fk = 0; gd.scale = 0.5f; gd.gpost = ng + 1 * 1024; gd.gnext = ng + 2 * 1024; break;
        case 3: gd.A = H; gd.Bt = W + O_IN; gd.N = PC; gd.K = 1024; gd.epi = EPI_PROJ; gd.out = PROJ; gd.gate_b = p.in[17] + (size_t)l * 2048; break;
        case 4: kind = 2; break;
        case 5: kind = 3; break;
        case 6: kind = 4; break;
        case 7: gd.A = CV; gd.Bt = W + O_PW; gd.N = 1024; gd.K = 512; gd.epi = EPI_MIX; gd.out = MIXB; gd.A2 = RT; gd.Bt2 = W + O_RO; gd.K2 = 512; gd.proj = PROJ; break;
        case 8: gd.A = MIXB; gd.Bt = W + O_MIX; gd.N = 1024; gd.K = 1024; gd.epi = EPI_RES; fk = 1; gd.scale = 1.f; gd.gpost = ng + 3 * 1024; gd.gnext = ng + 4 * 1024; break;
        case 9: gd.A = H; gd.Bt = W + O_Q; gd.N = 1024; gd.K = 1024; gd.epi = EPI_BF16; gd.out = QB; break;
        case 10: kind = 5; break;
        case 11: gd.A = OB; gd.Bt = W + O_O; gd.N = 1024; gd.K = 1024; gd.epi = EPI_RES; fk = 2; gd.scale = 1.f; gd.gpost = ng + 5 * 1024; gd.gnext = ng + 6 * 1024; break;
        case 12: gd.A = H; gd.Bt = W + O_GU2; gd.N = 5632; gd.K = 1024; gd.epi = EPI_SWIGLU; gd.out = HID; break;
        default: gd.A = HID; gd.Bt = W + O_D2; gd.N = 1024; gd.K = 2816; gd.epi = EPI_RES; fk = 3; gd.scale = 0.5f; gd.gpost = ng + 7 * 1024; gd.gnext = (l == 0) ? p.in[4] + (size_t)8 * 1024 : nullptr; break;
        }
        gd.expect = 4u * (unsigned)(g * 8 + l * 4 + fk + 1); gd.skip1 = 4u * (unsigned)g;
    }
    if (kind == 0) {
        switch (gd.epi) {
        case EPI_RES: gemm_phase<EPI_RES>(gd); break;
        case EPI_BF16: gemm_phase<EPI_BF16>(gd); break;
        case EPI_SWIGLU: gemm_phase<EPI_SWIGLU>(gd); break;
        case EPI_PROJ: gemm_phase<EPI_PROJ>(gd); break;
        case EPI_MIX: gemm_phase<EPI_MIX>(gd); break;
        default: gemm_phase<EPI_KV>(gd); break;
        }
    }
    else if (kind == 1) rowwise_phase(xin, X, nullptr, 1.f, nullptr, ng, H);
    else if (kind == 2) {
        conv_phase(PROJ, CV, p.in[8] + (size_t)l * 31 * 512, p.in[9] + l * 512, p.in[10] + l * 512, p.in[11] + l * 512, S);
        r1_phase(PROJ, rot, KVST, p.in[13] + l * 8, p.in[14] + l * 8, S);
    } else if (kind == 3) r2_phase(KVST, PREV, p.in[13] + l * 8, p.in[14] + l * 8, S);
    else if (kind == 4) r3_phase(PROJ, rot, PREV, RT, p.in[13] + l * 8, p.in[14] + l * 8, p.in[15] + l * 512, S);
    else attn_phase(QB, (const bf16_t*)(ws + WS_KMEM) + (size_t)l * 2304 * 1024, (const bf16_t*)(ws + WS_VMEMT) + (size_t)l * 2304 * 1024, OB, S, g);
}

__global__ void __launch_bounds__(NTHREADS) mega(const Params p) {
#if SINGLE_LAUNCH
    volatile LAS unsigned* st = (volatile LAS unsigned*)((LAS unsigned char*)g_lds + 131072);
    if (threadIdx.x == 0) { st[0] = 0u; st[1] = 0u; }
    __syncthreads();
    const XcdBarrier xb = xcd_barrier_post((unsigned*)(p.ws + WS_BAR), st);
#endif
    for (int ph = p.ph_begin; ph < p.ph_end; ++ph) {
        run_phase(p, ph);
#if SINGLE_LAUNCH
        if (ph + 1 < p.ph_end) {
            if (ph == 0) cg::this_grid().sync();
            else {
                xcd_barrier(xb);
#if PROBE == 1
                xcd_barrier(xb); xcd_barrier(xb);
#endif
            }
        }
#endif
    }
}

extern "C" void kernel_launch(void* const* d_in, const int* in_sizes, int n_in, void* d_out, int out_size, void* d_ws, size_t ws_size, hipStream_t stream) {
    static int grid = 0;
    if (grid == 0) {
        if (n_in != 25 || ws_size < WS_END) { fprintf(stderr, "kernel_launch: need 25 inputs and >= %zu bytes of workspace (got %d, %zu)\n", (size_t)WS_END, n_in, ws_size); grid = -1; return; }
        int dev = 0, cus = 0, per_cu = 0;
        hipGetDevice(&dev);
        hipDeviceGetAttribute(&cus, hipDeviceAttributeMultiprocessorCount, dev);
        if (hipFuncSetAttribute((const void*)mega, hipFuncAttributeMaxDynamicSharedMemorySize, LDS_BYTES) != hipSuccess) { fprintf(stderr, "kernel_launch: hipFuncSetAttribute failed\n"); grid = -1; return; }
        hipOccupancyMaxActiveBlocksPerMultiprocessor(&per_cu, (const void*)mega, NTHREADS, LDS_BYTES);
        if (per_cu < 1) per_cu = 1;
        (void)hipGetLastError();
        grid = cus * 1;
    }
    if (grid < 0) return;
    Params p{};
    for (int i = 0; i < 25; ++i) p.in[i] = (const float*)d_in[i];
    p.out = (float*)d_out; p.ws = (unsigned char*)d_ws;
    for (int i = 0; i < 32; ++i) p.inv_freq[i] = (float)pow(10000.0, -(double)i / 32.0);
#if SINGLE_LAUNCH
    p.ph_begin = 0; p.ph_end = N_PHASES;
    hipMemsetAsync((unsigned char*)d_ws + WS_BAR, 0, 16384 + 32768, stream);
    void* args[] = {&p};
    hipError_t e = hipLaunchCooperativeKernel((const void*)mega, dim3(grid), dim3(NTHREADS), args, LDS_BYTES, stream);
    if (e != hipSuccess) fprintf(stderr, "cooperative launch failed: %s (grid %d)\n", hipGetErrorString(e), grid);
#else
    for (int ph = 0; ph < N_PHASES; ++ph) {
        p.ph_begin = ph; p.ph_end = ph + 1;
        hipLaunchKernelGGL(mega, dim3(grid), dim3(NTHREADS), LDS_BYTES, stream, p);
    }
#endif
}
```

```cpp
#include <hip/hip_runtime.h>
#include <hip/hip_bf16.h>
#include <hip/hip_cooperative_groups.h>
#include <cstdio>
#include <cmath>
namespace cg = cooperative_groups;

#ifndef PROBE
#define PROBE 0
#endif
#ifndef SINGLE_LAUNCH
#define SINGLE_LAUNCH 1
#endif

#define DEV __device__ __forceinline__
typedef unsigned short bf16_t;
typedef short bf16x8 __attribute__((ext_vector_type(8)));
typedef short bf16x4 __attribute__((ext_vector_type(4)));
typedef float f32x4 __attribute__((ext_vector_type(4)));
typedef unsigned u32x4 __attribute__((ext_vector_type(4)));
typedef unsigned u32x2 __attribute__((ext_vector_type(2)));

constexpr int TG = 16384;
constexpr int NGRP = 3;
constexpr int PC = 5120;
constexpr int C_Q = 1024, C_K = 1536, C_V = 2048, C_G = 2560, C_GC = 3072, C_GR = 4096;
constexpr int NTHREADS = 512;
constexpr int LDS_BYTES = 131072 + 16;

constexpr size_t O_GU1 = 0, O_D1 = 5767168, O_IN = 8650752, O_PW = 13893632, O_RO = 14417920, O_MIX = 14942208,
                 O_Q = 15990784, O_KV = 17039360, O_O = 19136512, O_GU2 = 20185088, O_D2 = 25952256, WL = 28835840;
constexpr size_t WS_WT = 0;
constexpr size_t WS_ROT = WS_WT + 2 * WL * 2;
constexpr size_t WS_MEMN = WS_ROT + (size_t)16384 * 32 * 8;
constexpr size_t WS_KMEM = WS_MEMN + (size_t)2 * 2304 * 1024 * 2;
constexpr size_t WS_VMEMT = WS_KMEM + (size_t)2 * 2304 * 1024 * 2;
constexpr size_t WS_H = WS_VMEMT + (size_t)2 * 2304 * 1024 * 2;
constexpr size_t WS_HID = WS_H + (size_t)TG * 1024 * 2;
constexpr size_t WS_KVST = WS_HID;
constexpr size_t WS_PREV = WS_HID + 33554432;
constexpr size_t WS_MIXB = WS_HID + 50331648;
constexpr size_t WS_PROJ = WS_HID + (size_t)TG * 2816 * 2;
constexpr size_t WS_F = WS_PROJ;
constexpr size_t WS_QB = WS_PROJ + 67108864;
constexpr size_t WS_OB = WS_PROJ + 100663296;
constexpr size_t WS_CV = WS_PROJ + (size_t)TG * PC * 2;
constexpr size_t WS_RT = WS_CV + (size_t)TG * 512 * 2;
constexpr size_t WS_BAR = WS_RT + (size_t)TG * 512 * 2;
constexpr size_t WS_CNT = WS_BAR + 16384;
constexpr size_t WS_XBUF = WS_CNT + 32768;
constexpr size_t WS_END = WS_XBUF + 2 * 262144;

struct Params {
    const float* in[25];
    float* out;
    unsigned char* ws;
    float inv_freq[32];
    int ph_begin, ph_end;
};

extern __shared__ __attribute__((aligned(16))) unsigned char g_lds[];

DEV unsigned cvt_pk_bf16(float lo, float hi) { unsigned r; asm("v_cvt_pk_bf16_f32 %0, %1, %2" : "=v"(r) : "v"(lo), "v"(hi)); return r; }
DEV bf16_t f2bf(float v) { return (bf16_t)(cvt_pk_bf16(v, 0.f) & 0xffffu); }
DEV float bf2f(bf16_t v) { return __uint_as_float((unsigned)v << 16); }
DEV float bflo(unsigned v) { return __uint_as_float(v << 16); }
DEV float bfhi(unsigned v) { return __uint_as_float(v & 0xffff0000u); }
DEV float sigmoidf_(float x) { return __builtin_amdgcn_rcpf(1.f + __expf(-x)); }
DEV float siluf_(float x) { return x * __builtin_amdgcn_rcpf(1.f + __expf(-x)); }
DEV float wave_sum(float v) {
#pragma unroll
    for (int o = 32; o > 0; o >>= 1) v += __shfl_xor(v, o);
    return v;
}

DEV int launder_v(int v) { asm volatile("" : "+v"(v)); return v; }
DEV int launder_s(int v) { asm volatile("" : "+s"(v)); return v; }
#define TIDX launder_v((int)threadIdx.x)
#define BIDX launder_s((int)blockIdx.x)
constexpr int BM = 256, BK = 64, HALF = 128, HT = HALF * BK, NXCD = 8, WGM = 8;
DEV int lds_byte(int r, int c) {
    int st = (r >> 4) * 2 + (c >> 5), rr = r & 15, cc = c & 31, ob = rr * 64 + cc * 2;
    return st * 1024 + (ob ^ (((ob >> 9) & 1) << 5));
}
DEV void stage_rc(int b, int& R, int& C) {
    int st = b / 1024, sb = b % 1024, swz = sb ^ (((sb >> 9) & 1) << 5);
    R = (st >> 1) * 16 + swz / 64; C = (st & 1) * 32 + (swz % 64) / 2;
}

#define LAS __attribute__((address_space(3)))
enum { EPI_F32 = 0, EPI_BF16 = 1, EPI_SWIGLU = 2, EPI_PROJ = 3, EPI_MIX = 4, EPI_KV = 5, EPI_RES = 6 };

struct GemmDesc {
    const bf16_t* A; const bf16_t* Bt; int M, N, K, epi;
    void* out;
    const bf16_t* A2; const bf16_t* Bt2; int K2;
    const bf16_t* proj;
    const float* gate_b;
    bf16_t* out2;
    size_t bt_layer_stride;
    float* X; const float* gpost; const float* gnext; bf16_t* Hout; float scale; float* xbuf; unsigned* cnt; unsigned expect, skip1;
};

template <int EPI> DEV void gemm_phase(const GemmDesc& g) {
    LAS unsigned char* lds = (LAS unsigned char*)g_lds;
    const int tid = TIDX, wid = __builtin_amdgcn_readfirstlane(tid >> 6), lane = tid & 63, wr = wid >> 2, wc = wid & 3, fr = lane & 15, fq = lane >> 4;
    const int K = g.K, nt = K / BK;
    const int nM = g.M / BM, nN = g.N / BM, nwg = nM * nN, G = gridDim.x, cblk = BIDX;
    const bool dual = (EPI == EPI_MIX);
    unsigned voff[2];
#pragma unroll
    for (int i = 0; i < 2; ++i) { int R, C; stage_rc(tid * 16 + i * 8192, R, C); voff[i] = (unsigned)(R * K + C) * 2u; }
    const size_t kstep = (size_t)(BK * 2), hstep = (size_t)HALF * K * 2, tstep = 2 * hstep;
    const unsigned ldsw = (unsigned)wid * 1024u;
    const int aoff = lds_byte(wr * 64 + fr, fq * 8), boff = lds_byte(wc * 32 + fr, fq * 8);
#define PG_SA(b, h) (((b) * 2 + (h)) * (HT * 2))
#define PG_SB(b, h) ((4 + (b) * 2 + (h)) * (HT * 2))
#define PG_STAGE(bufoff, gbase) do { _Pragma("unroll") for (int _i = 0; _i < 2; ++_i) \
        __builtin_amdgcn_global_load_lds((const unsigned*)((const char*)(gbase) + voff[_i]), (LAS unsigned*)(lds + (bufoff) + ldsw + _i * 8192), 16, 0, 0); } while (0)
#define PG_LDA(dst, b, h) do { _Pragma("unroll") for (int m = 0; m < 4; ++m) _Pragma("unroll") for (int k = 0; k < 2; ++k) dst[m][k] = *(const LAS bf16x8*)(lds + PG_SA(b, h) + aoff + m * 2048 + k * 1024); } while (0)
#define PG_LDB(dst, b, h) do { _Pragma("unroll") for (int n = 0; n < 2; ++n) _Pragma("unroll") for (int k = 0; k < 2; ++k) dst[n][k] = *(const LAS bf16x8*)(lds + PG_SB(b, h) + boff + n * 2048 + k * 1024); } while (0)
#define PG_MMA(ai, bj, Af, Bf) do { __builtin_amdgcn_s_setprio(1); _Pragma("unroll") for (int m = 0; m < 4; ++m) _Pragma("unroll") for (int n = 0; n < 2; ++n) _Pragma("unroll") for (int k = 0; k < 2; ++k) \
        acc[ai][bj][m][n] = __builtin_amdgcn_mfma_f32_16x16x32_bf16(Bf[n][k], Af[m][k], acc[ai][bj][m][n], 0, 0, 0); __builtin_amdgcn_s_setprio(0); } while (0)
#define PG_WAIT_V(n) asm volatile("s_waitcnt vmcnt(" #n ")" ::: "memory")
#define PG_WAIT_L(n) asm volatile("s_waitcnt lgkmcnt(" #n ")" ::: "memory")
#define PG_BAR __builtin_amdgcn_s_barrier()
#define PG_SCHED __builtin_amdgcn_sched_barrier(0)
#define PG_NEXT(i, pm_, pn_, seg_, ok_) do { const int _ti = dual ? ((i) >> 1) : (i); seg_ = dual ? ((i) & 1) : 0; const int _L = _ti * G + cblk; ok_ = _L < nwg; \
        if (ok_) { int wgid = _L; { const int q = nwg / NXCD, r = nwg % NXCD, xcd = wgid % NXCD, off = wgid / NXCD; wgid = (xcd < r ? xcd * (q + 1) : r * (q + 1) + (xcd - r) * q) + off; } \
          const int nig = WGM * nN, gid = wgid / nig, fm = gid * WGM, gsz = (nM - fm) < WGM ? (nM - fm) : WGM; pm_ = fm + ((wgid % nig) % gsz); pn_ = (wgid % nig) / gsz; } } while (0)
#define PG_ABASE(pm_, seg_) ((const char*)((seg_) ? g.A2 : g.A) + (size_t)(pm_) * tstep)
#define PG_BBASE(pm_, pn_, seg_) ((const char*)((seg_) ? g.Bt2 : g.Bt) + ((EPI == EPI_KV && (pm_) >= 9) ? g.bt_layer_stride * 2 : (size_t)0) + (size_t)(pn_) * tstep)
    int pm = 0, pn = 0, seg = 0, npm = 0, npn = 0, nseg = 0, ui = 0; bool ok;
    PG_NEXT(0, pm, pn, seg, ok);
    if (!ok) return;
    f32x4 acc[2][2][4][2];
#pragma unroll
    for (int a = 0; a < 2; ++a)
#pragma unroll
        for (int b = 0; b < 2; ++b)
#pragma unroll
            for (int m = 0; m < 4; ++m)
#pragma unroll
                for (int n = 0; n < 2; ++n) acc[a][b][m][n] = (f32x4){0.f, 0.f, 0.f, 0.f};
    bf16x8 At[4][2], B0[2][2], B1[2][2];
    const char* cA = PG_ABASE(pm, seg); const char* cB = PG_BBASE(pm, pn, seg);
    asm volatile("s_waitcnt vmcnt(0) lgkmcnt(0)" ::: "memory"); PG_BAR; PG_SCHED;
    PG_STAGE(PG_SB(0, 0), cB); PG_STAGE(PG_SA(0, 0), cA); PG_STAGE(PG_SB(0, 1), cB + hstep); PG_STAGE(PG_SA(0, 1), cA + hstep);
    if (wr == 1) PG_BAR;
    PG_WAIT_V(4); PG_BAR;
    PG_STAGE(PG_SB(1, 0), cB + kstep); PG_STAGE(PG_SA(1, 0), cA + kstep); PG_STAGE(PG_SB(1, 1), cB + hstep + kstep);
    PG_WAIT_V(6); PG_BAR;
    for (;;) {
        bool has_next; PG_NEXT(ui + 1, npm, npn, nseg, has_next);
        const char* nA = has_next ? PG_ABASE(npm, nseg) : cA; const char* nB = has_next ? PG_BBASE(npm, npn, nseg) : cB;
        for (int t = 0; t < nt; t += 2) {
            const bool last = (t == nt - 2);
            const char* a1 = cA + (size_t)(t + 1) * kstep;
            const char* a2 = last ? nA : cA + (size_t)(t + 2) * kstep; const char* b2 = last ? nB : cB + (size_t)(t + 2) * kstep;
            const char* a3 = a2 + kstep; const char* b3 = b2 + kstep;
            PG_LDB(B0, 0, 0); PG_SCHED; PG_LDA(At, 0, 0); PG_STAGE(PG_SA(1, 1), a1 + hstep);
            PG_WAIT_L(8); PG_BAR; PG_WAIT_L(0); PG_MMA(0, 0, At, B0); PG_BAR; PG_SCHED;
            PG_LDB(B1, 0, 1); PG_STAGE(PG_SB(0, 0), b2);
            PG_BAR; PG_WAIT_L(0); PG_MMA(0, 1, At, B1); PG_BAR;
            PG_LDA(At, 0, 1); PG_STAGE(PG_SA(0, 0), a2);
            PG_BAR; PG_WAIT_L(0); PG_MMA(1, 0, At, B0); PG_BAR; PG_SCHED;
            PG_STAGE(PG_SB(0, 1), b2 + hstep);
            PG_WAIT_V(6); PG_BAR; PG_MMA(1, 1, At, B1); PG_BAR;
            PG_LDB(B0, 1, 0); PG_SCHED; PG_LDA(At, 1, 0); PG_STAGE(PG_SA(0, 1), a2 + hstep);
            PG_WAIT_L(8); PG_BAR; PG_WAIT_L(0); PG_MMA(0, 0, At, B0); PG_BAR; PG_SCHED;
            PG_LDB(B1, 1, 1); PG_STAGE(PG_SB(1, 0), b3);
            PG_BAR; PG_WAIT_L(0); PG_MMA(0, 1, At, B1); PG_BAR;
            PG_LDA(At, 1, 1); PG_STAGE(PG_SA(1, 0), a3);
            PG_BAR; PG_WAIT_L(0); PG_MMA(1, 0, At, B0); PG_BAR; PG_SCHED;
            PG_STAGE(PG_SB(1, 1), b3 + hstep);
            PG_WAIT_V(6); PG_BAR; PG_MMA(1, 1, At, B1); PG_BAR;
        }
        const int brow = pm * BM, bcol = pn * BM;
        const int r0 = brow + wr * 64 + fr, c0 = bcol + wc * 32 + fq * 8;
        if (EPI == EPI_RES || EPI == 7) {
            if (EPI == 7) { float q = 0.f;
#pragma unroll
                for (int ai = 0; ai < 2; ++ai)
#pragma unroll
                    for (int bj = 0; bj < 2; ++bj)
#pragma unroll
                        for (int m = 0; m < 4; ++m)
#pragma unroll
                            for (int n = 0; n < 2; ++n) q += acc[ai][bj][m][n][0] + acc[ai][bj][m][n][1] + acc[ai][bj][m][n][2] + acc[ai][bj][m][n][3];
                if (q == 1.2345e-30f) ((float*)g.xbuf)[tid] = q; }
        } else if (EPI == EPI_MIX) {
          if (seg == 0) {
#pragma unroll
            for (int ai = 0; ai < 2; ++ai)
#pragma unroll
                for (int m = 0; m < 4; ++m) {
                    const bf16_t* pr = g.proj + (size_t)(r0 + ai * 128 + m * 16) * PC + c0;
#pragma unroll
                    for (int bj = 0; bj < 2; ++bj) {
                        const u32x4 gc = *(const u32x4*)(pr + C_GC + bj * 128), gr = *(const u32x4*)(pr + C_GR + bj * 128);
#pragma unroll
                        for (int n = 0; n < 2; ++n) {
                            f32x4 v = acc[ai][bj][m][n];
                            v[0] *= bflo(gc[2 * n]) * __builtin_amdgcn_rcpf(bflo(gr[2 * n])); v[1] *= bfhi(gc[2 * n]) * __builtin_amdgcn_rcpf(bfhi(gr[2 * n]));
                            v[2] *= bflo(gc[2 * n + 1]) * __builtin_amdgcn_rcpf(bflo(gr[2 * n + 1])); v[3] *= bfhi(gc[2 * n + 1]) * __builtin_amdgcn_rcpf(bfhi(gr[2 * n + 1]));
                            acc[ai][bj][m][n] = v;
                        }
                    }
                }
          } else {
#pragma unroll
            for (int ai = 0; ai < 2; ++ai)
#pragma unroll
                for (int m = 0; m < 4; ++m) {
                    const size_t row = (size_t)(r0 + ai * 128 + m * 16);
                    const bf16_t* pr = g.proj + row * PC + c0;
                    bf16_t* o = (bf16_t*)g.out + row * 1024 + c0;
#pragma unroll
                    for (int bj = 0; bj < 2; ++bj) {
                        const u32x4 gr = *(const u32x4*)(pr + C_GR + bj * 128);
                        const f32x4 v0 = acc[ai][bj][m][0], v1 = acc[ai][bj][m][1];
                        u32x4 w; w[0] = cvt_pk_bf16(v0[0] * bflo(gr[0]), v0[1] * bfhi(gr[0])); w[1] = cvt_pk_bf16(v0[2] * bflo(gr[1]), v0[3] * bfhi(gr[1]));
                        w[2] = cvt_pk_bf16(v1[0] * bflo(gr[2]), v1[1] * bfhi(gr[2])); w[3] = cvt_pk_bf16(v1[2] * bflo(gr[3]), v1[3] * bfhi(gr[3]));
                        *(u32x4*)(o + bj * 128) = w;
                    }
                }
          }
        } else if (EPI == EPI_F32) {
#pragma unroll
            for (int ai = 0; ai < 2; ++ai)
#pragma unroll
                for (int m = 0; m < 4; ++m) {
                    float* o = (float*)g.out + (size_t)(r0 + ai * 128 + m * 16) * g.N + c0;
#pragma unroll
                    for (int bj = 0; bj < 2; ++bj)
#pragma unroll
                        for (int n = 0; n < 2; ++n) *(f32x4*)(o + bj * 128 + n * 4) = acc[ai][bj][m][n];
                }
        } else if (EPI == EPI_BF16 || EPI == EPI_PROJ) {
            const bool sg = (EPI == EPI_PROJ) && (bcol >= C_GC);
#pragma unroll
            for (int ai = 0; ai < 2; ++ai)
#pragma unroll
                for (int m = 0; m < 4; ++m) {
                    bf16_t* o = (bf16_t*)g.out + (size_t)(r0 + ai * 128 + m * 16) * g.N + c0;
#pragma unroll
                    for (int bj = 0; bj < 2; ++bj) {
                        f32x4 v0 = acc[ai][bj][m][0], v1 = acc[ai][bj][m][1];
                        if (sg) {
                            const f32x4 b0 = *(const f32x4*)(g.gate_b + (c0 - C_GC) + bj * 128), b1 = *(const f32x4*)(g.gate_b + (c0 - C_GC) + bj * 128 + 4);
#pragma unroll
                            for (int j = 0; j < 4; ++j) { v0[j] = sigmoidf_(v0[j] + b0[j]); v1[j] = sigmoidf_(v1[j] + b1[j]); }
                        }
                        u32x4 w; w[0] = cvt_pk_bf16(v0[0], v0[1]); w[1] = cvt_pk_bf16(v0[2], v0[3]); w[2] = cvt_pk_bf16(v1[0], v1[1]); w[3] = cvt_pk_bf16(v1[2], v1[3]);
                        *(u32x4*)(o + bj * 128) = w;
                    }
                }
        } else if (EPI == EPI_SWIGLU) {
            const int hc0 = (bcol >> 1) + wc * 32 + fq * 8;
#pragma unroll
            for (int ai = 0; ai < 2; ++ai)
#pragma unroll
                for (int m = 0; m < 4; ++m) {
                    bf16_t* o = (bf16_t*)g.out + (size_t)(r0 + ai * 128 + m * 16) * (g.N >> 1) + hc0;
                    const f32x4 g0 = acc[ai][0][m][0], g1 = acc[ai][0][m][1], u0 = acc[ai][1][m][0], u1 = acc[ai][1][m][1];
                    u32x4 w; w[0] = cvt_pk_bf16(siluf_(g0[0]) * u0[0], siluf_(g0[1]) * u0[1]); w[1] = cvt_pk_bf16(siluf_(g0[2]) * u0[2], siluf_(g0[3]) * u0[3]);
                    w[2] = cvt_pk_bf16(siluf_(g1[0]) * u1[0], siluf_(g1[1]) * u1[1]); w[3] = cvt_pk_bf16(siluf_(g1[2]) * u1[2], siluf_(g1[3]) * u1[3]);
                    *(u32x4*)o = w;
                }
        } else {
#pragma unroll
            for (int ai = 0; ai < 2; ++ai)
#pragma unroll
                for (int m = 0; m < 4; ++m) {
                    const int row = r0 + ai * 128 + m * 16;
#pragma unroll
                    for (int bj = 0; bj < 2; ++bj) {
                        const f32x4 v0 = acc[ai][bj][m][0], v1 = acc[ai][bj][m][1];
                        const int col = c0 + bj * 128;
                        if (bcol < 1024) {
                            u32x4 w; w[0] = cvt_pk_bf16(v0[0], v0[1]); w[1] = cvt_pk_bf16(v0[2], v0[3]); w[2] = cvt_pk_bf16(v1[0], v1[1]); w[3] = cvt_pk_bf16(v1[2], v1[3]);
                            *(u32x4*)((bf16_t*)g.out + (size_t)row * 1024 + col) = w;
                        } else {
                            const int hh = (col - 1024) >> 8, d = (col - 1024) & 255, lb = row >> 8, mm = row & 255;
                            bf16_t* o = g.out2 + ((size_t)(lb * 4 + hh) * 256 + d) * 256 + mm;
#pragma unroll
                            for (int j = 0; j < 4; ++j) { o[j * 256] = f2bf(v0[j]); o[(j + 4) * 256] = f2bf(v1[j]); }
                        }
                    }
                }
        }
        if (!has_next) break;
        if (!(dual && seg == 0)) {
#pragma unroll
            for (int a = 0; a < 2; ++a)
#pragma unroll
                for (int b = 0; b < 2; ++b)
#pragma unroll
                    for (int m = 0; m < 4; ++m)
#pragma unroll
                        for (int n = 0; n < 2; ++n) acc[a][b][m][n] = (f32x4){0.f, 0.f, 0.f, 0.f};
        }
        pm = npm; pn = npn; seg = nseg; cA = nA; cB = nB; ++ui;
    }
    PG_WAIT_V(0);
    if (wr == 0) PG_BAR;
    PG_BAR;
    if (EPI == EPI_RES) {
        LAS float* P = (LAS float*)lds;
        LAS float* Sr = (LAS float*)(lds + 4096);
        const int brow = pm * BM, bcol = pn * BM;
        const int r0 = brow + wr * 64 + fr, c0 = bcol + wc * 32 + fq * 8, lr0 = wr * 64 + fr;
#pragma unroll 1
        for (int e = 0; e < 2; ++e) {
            if (e == 1 && g.gnext == nullptr) break;
#pragma unroll
            for (int ai = 0; ai < 2; ++ai)
#pragma unroll
                for (int m = 0; m < 4; ++m) {
                    float q = 0.f;
#pragma unroll
                    for (int bj = 0; bj < 2; ++bj)
#pragma unroll
                        for (int n = 0; n < 2; ++n) { const f32x4 v = acc[ai][bj][m][n]; q += (v[0] * v[0] + v[1] * v[1]) + (v[2] * v[2] + v[3] * v[3]); }
                    q += __shfl_xor(q, 16); q += __shfl_xor(q, 32);
                    if (fq == 0) P[(ai * 128 + lr0 + m * 16) * 4 + wc] = q;
                }
            __syncthreads();
            float* xb = g.xbuf + (size_t)e * 65536 + (size_t)pm * 1024;
            unsigned* cn = g.cnt + (size_t)e * 4096 + (size_t)pm * 64;
            if (tid < 256) {
                const float tot = (P[tid * 4] + P[tid * 4 + 1]) + (P[tid * 4 + 2] + P[tid * 4 + 3]);
                __hip_atomic_store((unsigned*)xb + tid * 4 + pn, __float_as_uint(tot), __ATOMIC_RELAXED, __HIP_MEMORY_SCOPE_AGENT);
            }
            asm volatile("s_waitcnt vmcnt(0)" ::: "memory");
            __syncthreads();
            if (tid == 0) {
                (void)__hip_atomic_fetch_add(cn, 1u, __ATOMIC_RELAXED, __HIP_MEMORY_SCOPE_AGENT);
                unsigned sp = 0;
                const unsigned want = g.expect - (unsigned)e * g.skip1;
                while (__hip_atomic_load(cn, __ATOMIC_RELAXED, __HIP_MEMORY_SCOPE_AGENT) < want) { __builtin_amdgcn_s_sleep(1); if (++sp > (1u << 22)) break; }
            }
            __syncthreads();
            if (tid < 256) {
                unsigned* xu = (unsigned*)xb + tid * 4;
                const float t0 = __uint_as_float(__hip_atomic_load(xu + 0, __ATOMIC_RELAXED, __HIP_MEMORY_SCOPE_AGENT)), t1 = __uint_as_float(__hip_atomic_load(xu + 1, __ATOMIC_RELAXED, __HIP_MEMORY_SCOPE_AGENT));
                const float t2 = __uint_as_float(__hip_atomic_load(xu + 2, __ATOMIC_RELAXED, __HIP_MEMORY_SCOPE_AGENT)), t3 = __uint_as_float(__hip_atomic_load(xu + 3, __ATOMIC_RELAXED, __HIP_MEMORY_SCOPE_AGENT));
                Sr[tid] = 1.0f / sqrtf(((t0 + t1) + (t2 + t3)) * (1.f / 1024.f) + 1e-6f);
            }
            __syncthreads();
            if (e == 0) {
#pragma unroll
                for (int ai = 0; ai < 2; ++ai)
#pragma unroll
                    for (int m = 0; m < 4; ++m) {
                        const float r = Sr[ai * 128 + lr0 + m * 16] * g.scale;
                        float* xr = g.X + (size_t)(r0 + ai * 128 + m * 16) * 1024 + c0;
#pragma unroll
                        for (int bj = 0; bj < 2; ++bj)
#pragma unroll
                            for (int n = 0; n < 2; ++n) {
                                const f32x4 x = *(const f32x4*)(xr + bj * 128 + n * 4);
                                const f32x4 gp = *(const f32x4*)(g.gpost + c0 + bj * 128 + n * 4);
                                const f32x4 v = x + acc[ai][bj][m][n] * r * gp;
                                acc[ai][bj][m][n] = v;
                                *(f32x4*)(xr + bj * 128 + n * 4) = v;
                            }
                    }
            } else {
#pragma unroll
                for (int ai = 0; ai < 2; ++ai)
#pragma unroll
                    for (int m = 0; m < 4; ++m) {
                        const float r = Sr[ai * 128 + lr0 + m * 16];
                        bf16_t* hr = g.Hout + (size_t)(r0 + ai * 128 + m * 16) * 1024 + c0;
#pragma unroll
                        for (int bj = 0; bj < 2; ++bj) {
                            const f32x4 gn0 = *(const f32x4*)(g.gnext + c0 + bj * 128), gn1 = *(const f32x4*)(g.gnext + c0 + bj * 128 + 4);
                            const f32x4 v0 = acc[ai][bj][m][0] * r * gn0, v1 = acc[ai][bj][m][1] * r * gn1;
                            u32x4 w; w[0] = cvt_pk_bf16(v0[0], v0[1]); w[1] = cvt_pk_bf16(v0[2], v0[3]); w[2] = cvt_pk_bf16(v1[0], v1[1]); w[3] = cvt_pk_bf16(v1[2], v1[3]);
                            *(u32x4*)(hr + bj * 128) = w;
                        }
                    }
            }
        }
    }
#undef PG_SA
#undef PG_SB
#undef PG_STAGE
#undef PG_LDA
#undef PG_LDB
#undef PG_MMA
#undef PG_NEXT
#undef PG_ABASE
#undef PG_BBASE
}

DEV void transpose_mat(const float* __restrict__ src, const int K, const int N, bf16_t* __restrict__ dst, const int perm, const float scale) {
    float* tile = (float*)g_lds;
    const int nkt = K / 64, ntile = nkt * (N / 64), tid = TIDX, bid = BIDX;
    for (int t = bid; t < ntile; t += gridDim.x) {
        const int rt = t / nkt, kt = t - rt * nkt, rho0 = rt * 64;
        const int cbase = perm ? (((rho0 & 255) >> 7) * 2816 + (rho0 >> 8) * 128 + (rho0 & 127)) : rho0;
        __syncthreads();
#pragma unroll
        for (int i = 0; i < 8; ++i) { const int kk = (tid >> 6) + 8 * i, cc = tid & 63; tile[kk * 65 + cc] = src[(size_t)(kt * 64 + kk) * N + cbase + cc]; }
        __syncthreads();
#pragma unroll
        for (int i = 0; i < 4; ++i) {
            const int rr = (tid >> 5) + 16 * i, k2 = (tid & 31) * 2;
            const int r32 = rr & 31, cc = (rr & 32) + 8 * ((r32 & 15) >> 2) + 4 * (r32 >> 4) + (r32 & 3);
            *(unsigned*)(dst + (size_t)(rho0 + rr) * K + kt * 64 + k2) = cvt_pk_bf16(tile[k2 * 65 + cc] * scale, tile[(k2 + 1) * 65 + cc] * scale);
        }
    }
}

DEV void setup_phase(const Params& p) {
    bf16_t* wt = (bf16_t*)(p.ws + WS_WT);
    for (int l = 0; l < 2; ++l) {
        bf16_t* w = wt + (size_t)l * WL;
        transpose_mat(p.in[5] + (size_t)l * 1024 * 5632, 1024, 5632, w + O_GU1, 1, 1.f);
        transpose_mat(p.in[6] + (size_t)l * 2816 * 1024, 2816, 1024, w + O_D1, 0, 1.f);
        transpose_mat(p.in[7] + (size_t)l * 1024 * 5120, 1024, 5120, w + O_IN, 0, 1.f);
        transpose_mat(p.in[12] + (size_t)l * 512 * 1024, 512, 1024, w + O_PW, 0, 1.f);
        transpose_mat(p.in[16] + (size_t)l * 512 * 1024, 512, 1024, w + O_RO, 0, 1.f);
        transpose_mat(p.in[18] + (size_t)l * 1024 * 1024, 1024, 1024, w + O_MIX, 0, 1.f);
        transpose_mat(p.in[20] + (size_t)l * 1024 * 1024, 1024, 1024, w + O_Q, 0, 0.0625f);
        transpose_mat(p.in[21] + (size_t)l * 1024 * 2048, 1024, 2048, w + O_KV, 0, 1.f);
        transpose_mat(p.in[22] + (size_t)l * 1024 * 1024, 1024, 1024, w + O_O, 0, 1.f);
        transpose_mat(p.in[23] + (size_t)l * 1024 * 5632, 1024, 5632, w + O_GU2, 1, 1.f);
        transpose_mat(p.in[24] + (size_t)l * 2816 * 1024, 2816, 1024, w + O_D2, 0, 1.f);
    }
    float2* rot = (float2*)(p.ws + WS_ROT);
    const int tid0 = TIDX, bid0 = BIDX;
    for (int idx = bid0 * NTHREADS + tid0; idx < 16384 * 32; idx += gridDim.x * NTHREADS) {
        const int pos = idx >> 5, i = idx & 31;
        const float ang = (float)pos * p.inv_freq[i];
        double rev = (double)ang * 0.15915494309189535;
        rev -= floor(rev);
        const float fr = (float)rev;
        rot[idx] = make_float2(__builtin_amdgcn_cosf(fr), __builtin_amdgcn_sinf(fr));
    }
    bf16_t* memn = (bf16_t*)(p.ws + WS_MEMN);
    const int lane = tid0 & 63, gw = bid0 * 8 + (tid0 >> 6), nw = gridDim.x * 8;
    for (int rr = gw; rr < 2 * 2304; rr += nw) {
        const int l = rr / 2304, row = rr - l * 2304;
        const float* src = row < 2048 ? p.in[2] + (size_t)row * 1024 : p.in[3] + (size_t)(row - 2048) * 1024;
        const float* mg = p.in[19] + l * 1024;
        f32x4 x[4]; float ss = 0.f;
#pragma unroll
        for (int i = 0; i < 4; ++i) { x[i] = *(const f32x4*)(src + i * 256 + lane * 4); ss += x[i][0] * x[i][0] + x[i][1] * x[i][1] + x[i][2] * x[i][2] + x[i][3] * x[i][3]; }
        ss = wave_sum(ss);
        const float r = 1.0f / sqrtf(ss * (1.f / 1024.f) + 1e-6f);
#pragma unroll
        for (int i = 0; i < 4; ++i) {
            const f32x4 gg = *(const f32x4*)(mg + i * 256 + lane * 4);
            u32x2 w; w[0] = cvt_pk_bf16(x[i][0] * r * gg[0], x[i][1] * r * gg[1]); w[1] = cvt_pk_bf16(x[i][2] * r * gg[2], x[i][3] * r * gg[3]);
            *(u32x2*)(memn + (size_t)rr * 1024 + i * 256 + lane * 4) = w;
        }
    }
}

DEV void rowwise_phase(const float* __restrict__ Xsrc, float* __restrict__ X, const float* __restrict__ F, const float scale,
                       const float* __restrict__ gpost, const float* __restrict__ gnext, bf16_t* __restrict__ H) {
    const int tid0 = TIDX, bid0 = BIDX;
    const int lane = tid0 & 63, gw = bid0 * 8 + (tid0 >> 6), nw = gridDim.x * 8;
    for (int row = gw; row < TG; row += nw) {
        f32x4 x[4];
#pragma unroll
        for (int i = 0; i < 4; ++i) x[i] = *(const f32x4*)(Xsrc + (size_t)row * 1024 + i * 256 + lane * 4);
        if (F) {
            f32x4 f[4]; float ss = 0.f;
#pragma unroll
            for (int i = 0; i < 4; ++i) { f[i] = *(const f32x4*)(F + (size_t)row * 1024 + i * 256 + lane * 4); ss += f[i][0] * f[i][0] + f[i][1] * f[i][1] + f[i][2] * f[i][2] + f[i][3] * f[i][3]; }
            ss = wave_sum(ss);
            const float r = scale / sqrtf(ss * (1.f / 1024.f) + 1e-6f);
#pragma unroll
            for (int i = 0; i < 4; ++i) { const f32x4 gp = *(const f32x4*)(gpost + i * 256 + lane * 4); x[i] += f[i] * r * gp; }
        }
#pragma unroll
        for (int i = 0; i < 4; ++i) *(f32x4*)(X + (size_t)row * 1024 + i * 256 + lane * 4) = x[i];
        if (gnext) {
            float ss = 0.f;
#pragma unroll
            for (int i = 0; i < 4; ++i) ss += x[i][0] * x[i][0] + x[i][1] * x[i][1] + x[i][2] * x[i][2] + x[i][3] * x[i][3];
            ss = wave_sum(ss);
            const float r = 1.0f / sqrtf(ss * (1.f / 1024.f) + 1e-6f);
#pragma unroll
            for (int i = 0; i < 4; ++i) {
                const f32x4 gg = *(const f32x4*)(gnext + i * 256 + lane * 4);
                u32x2 w; w[0] = cvt_pk_bf16(x[i][0] * r * gg[0], x[i][1] * r * gg[1]); w[1] = cvt_pk_bf16(x[i][2] * r * gg[2], x[i][3] * r * gg[3]);
                *(u32x2*)(H + (size_t)row * 1024 + i * 256 + lane * 4) = w;
            }
        }
    }
}

DEV void conv_phase(const bf16_t* __restrict__ PROJ, bf16_t* __restrict__ CV, const float* __restrict__ dw_w, const float* __restrict__ dw_b,
                    const float* __restrict__ ln_g, const float* __restrict__ ln_b, const int S) {
    bf16_t* us = (bf16_t*)g_lds;
    float* red = (float*)(g_lds + 62 * 512 * 2);
    float* stat = red + 8 * 32 * 2;
    const int tid = TIDX, bid = BIDX, c = tid, wid = tid >> 6, lane = tid & 63;
    float w[31];
#pragma unroll
    for (int k = 0; k < 31; ++k) w[k] = dw_w[k * 512 + c];
    const float bias = dw_b[c], lg = ln_g[c], lb = ln_b[c];
    for (int u = bid; u < TG / 32; u += gridDim.x) {
        const int t0 = u * 32, seq = t0 / S, pos0 = t0 - seq * S;
        __syncthreads();
        const int cg8 = (tid & 63) * 8;
#pragma unroll
        for (int it = 0; it < 8; ++it) {
            const int tt = it * 8 + (tid >> 6);
            if (tt < 62) {
                const int pos = pos0 - 15 + tt;
                u32x4 o = {0u, 0u, 0u, 0u};
                if (pos >= 0 && pos < S) {
                    const bf16_t* pr = PROJ + (size_t)(seq * S + pos) * PC;
                    const u32x4 v = *(const u32x4*)(pr + cg8), gt = *(const u32x4*)(pr + 512 + cg8);
#pragma unroll
                    for (int q = 0; q < 4; ++q) o[q] = cvt_pk_bf16(bflo(v[q]) * sigmoidf_(bflo(gt[q])), bfhi(v[q]) * sigmoidf_(bfhi(gt[q])));
                }
                *(u32x4*)(us + tt * 512 + cg8) = o;
            }
        }
        __syncthreads();
        float acc[32];
#pragma unroll
        for (int seg = 0; seg < 4; ++seg) {
#pragma unroll
            for (int s = 0; s < 8; ++s) acc[seg * 8 + s] = bias;
#pragma unroll
            for (int kk = 0; kk < 38; ++kk) {
                const float uv = bf2f(us[(seg * 8 + kk) * 512 + c]);
#pragma unroll
                for (int s = 0; s < 8; ++s) { const int k = kk - s; if (k >= 0 && k < 31) acc[seg * 8 + s] += w[k] * uv; }
            }
        }
#pragma unroll
        for (int s = 0; s < 32; ++s) {
            const float s1 = wave_sum(acc[s]), s2 = wave_sum(acc[s] * acc[s]);
            if (lane == 0) { red[(wid * 32 + s) * 2] = s1; red[(wid * 32 + s) * 2 + 1] = s2; }
        }
        __syncthreads();
        if (tid < 32) {
            float s1 = 0.f, s2 = 0.f;
#pragma unroll
            for (int q = 0; q < 8; ++q) { s1 += red[(q * 32 + tid) * 2]; s2 += red[(q * 32 + tid) * 2 + 1]; }
            const float mean = s1 * (1.f / 512.f), var = fmaxf(s2 * (1.f / 512.f) - mean * mean, 0.f);
            stat[tid * 2] = mean; stat[tid * 2 + 1] = 1.0f / sqrtf(var + 1e-6f);
        }
        __syncthreads();
#pragma unroll
        for (int s = 0; s < 32; ++s) {
            const float y = (acc[s] - stat[s * 2]) * stat[s * 2 + 1] * lg + lb;
            CV[(size_t)(t0 + s) * 512 + c] = f2bf(siluf_(y));
        }
    }
}

template <int I> DEV float bfel(const u32x4& v) { return (I & 1) ? bfhi(v[I >> 1]) : bflo(v[I >> 1]); }

DEV void r1_phase(const bf16_t* __restrict__ PROJ, const float2* __restrict__ rot, float* __restrict__ KVST,
                  const float* __restrict__ dec_f, const float* __restrict__ dec_b, const int S) {
    bf16_t* vT = (bf16_t*)g_lds; bf16_t* kTf = vT + 64 * 136; bf16_t* kTb = kTf + 64 * 136;
    const int tid = TIDX, bid = BIDX, wid = tid >> 6, lane = tid & 63, fr = lane & 15, fq = lane >> 4;
    const int j = tid >> 2, dq = (tid & 3) * 8;
    for (int unit = bid; unit < (TG / 128) * 8; unit += gridDim.x) {
        const int cidx = unit >> 3, h = unit & 7, t0 = cidx * 128, seq = t0 / S, pos0 = t0 - seq * S;
        const float lgf2 = -expf(dec_f[h]) * 1.4426950408889634f, lgb2 = -expf(dec_b[h]) * 1.4426950408889634f;
        __syncthreads();
        const bf16_t* pr = PROJ + (size_t)(t0 + j) * PC;
        const u32x4 k1 = *(const u32x4*)(pr + C_K + h * 64 + dq), k2 = *(const u32x4*)(pr + C_K + h * 64 + 32 + dq);
        const float2* rp = rot + (size_t)(pos0 + j) * 32 + dq;
        const float df = exp2f(lgf2 * (float)(127 - j)), db = exp2f(lgb2 * (float)j);
#pragma unroll
        for (int i = 0; i < 8; ++i) {
            const float a = (i & 1) ? bfhi(k1[i >> 1]) : bflo(k1[i >> 1]), b = (i & 1) ? bfhi(k2[i >> 1]) : bflo(k2[i >> 1]);
            const float2 cs = rp[i];
            const float r1 = (a * cs.x - b * cs.y) * 0.125f, r2 = (a * cs.y + b * cs.x) * 0.125f;
            kTf[(dq + i) * 136 + j] = f2bf(r1 * df); kTf[(32 + dq + i) * 136 + j] = f2bf(r2 * df);
            kTb[(dq + i) * 136 + j] = f2bf(r1 * db); kTb[(32 + dq + i) * 136 + j] = f2bf(r2 * db);
        }
        {
            const int e0 = (tid & 3) * 16;
            const u32x4 v1 = *(const u32x4*)(pr + C_V + h * 64 + e0), v2 = *(const u32x4*)(pr + C_V + h * 64 + e0 + 8);
#pragma unroll
            for (int i = 0; i < 4; ++i) {
                vT[(e0 + 2 * i) * 136 + j] = (bf16_t)(v1[i] & 0xffffu); vT[(e0 + 2 * i + 1) * 136 + j] = (bf16_t)(v1[i] >> 16);
                vT[(e0 + 8 + 2 * i) * 136 + j] = (bf16_t)(v2[i] & 0xffffu); vT[(e0 + 8 + 2 * i + 1) * 136 + j] = (bf16_t)(v2[i] >> 16);
            }
        }
        __syncthreads();
        const int dir = wid >> 2, et = wid & 3;
        const bf16_t* kT = dir ? kTb : kTf;
        bf16x8 a[4];
#pragma unroll
        for (int ks = 0; ks < 4; ++ks) a[ks] = *(const bf16x8*)(vT + (et * 16 + fr) * 136 + ks * 32 + fq * 8);
        float* o = KVST + ((size_t)(cidx * 8 + h) * 2 + dir) * 4096;
#pragma unroll
        for (int dt = 0; dt < 4; ++dt) {
            f32x4 acc = {0.f, 0.f, 0.f, 0.f};
#pragma unroll
            for (int ks = 0; ks < 4; ++ks) {
                const bf16x8 b = *(const bf16x8*)(kT + (dt * 16 + fr) * 136 + ks * 32 + fq * 8);
                acc = __builtin_amdgcn_mfma_f32_16x16x32_bf16(a[ks], b, acc, 0, 0, 0);
            }
#pragma unroll
            for (int jj = 0; jj < 4; ++jj) o[(et * 16 + fq * 4 + jj) * 64 + dt * 16 + fr] = acc[jj];
        }
    }
}

DEV void r2_phase(const float* __restrict__ KVST, bf16_t* __restrict__ PREV, const float* __restrict__ dec_f, const float* __restrict__ dec_b, const int S) {
    const int NC = S / 128, nseq = TG / S, total = nseq * 8 * 2 * 4096;
    const int tid0 = TIDX, bid0 = BIDX;
    for (int idx = bid0 * NTHREADS + tid0; idx < total; idx += gridDim.x * NTHREADS) {
        const int elem = idx & 4095, dir = (idx >> 12) & 1, h = (idx >> 13) & 7, seq = idx >> 16;
        const float lg = -expf((dir ? dec_b : dec_f)[h]);
        const float cd = expf(lg * 128.f);
        float st = 0.f;
#pragma unroll 8
        for (int n = 0; n < NC; ++n) {
            const int nn = dir ? NC - 1 - n : n;
            const size_t o = ((size_t)((seq * NC + nn) * 8 + h) * 2 + dir) * 4096 + elem;
            PREV[o] = f2bf(st);
            st = st * cd + KVST[o];
        }
    }
}

DEV void r3_phase(const bf16_t* __restrict__ PROJ, const float2* __restrict__ rot, const bf16_t* __restrict__ PREV, bf16_t* __restrict__ RT,
                  const float* __restrict__ dec_f, const float* __restrict__ dec_b, const float* __restrict__ gn_g, const int S) {
    bf16_t* Qs = (bf16_t*)g_lds; bf16_t* Ks = Qs + 128 * 72; bf16_t* vT = Ks + 128 * 72;
    const int tid = TIDX, bid = BIDX, wid = tid >> 6, lane = tid & 63, fr = lane & 15, fq = lane >> 4;
    const int j = tid >> 2, dq = (tid & 3) * 8;
    for (int unit = bid; unit < (TG / 128) * 8; unit += gridDim.x) {
        const int cidx = unit >> 3, h = unit & 7, t0 = cidx * 128, seq = t0 / S, pos0 = t0 - seq * S;
        const float lgf2 = -expf(dec_f[h]) * 1.4426950408889634f, lgb2 = -expf(dec_b[h]) * 1.4426950408889634f;
        __syncthreads();
        {
            const bf16_t* pr = PROJ + (size_t)(t0 + j) * PC;
            const u32x4 q1 = *(const u32x4*)(pr + C_Q + h * 64 + dq), q2 = *(const u32x4*)(pr + C_Q + h * 64 + 32 + dq);
            const u32x4 k1 = *(const u32x4*)(pr + C_K + h * 64 + dq), k2 = *(const u32x4*)(pr + C_K + h * 64 + 32 + dq);
            const float2* rp = rot + (size_t)(pos0 + j) * 32 + dq;
            u32x4 oq1, oq2, ok1, ok2;
#pragma unroll
            for (int i = 0; i < 4; ++i) {
                const float2 c0 = rp[2 * i], c1 = rp[2 * i + 1];
                const float qa0 = bflo(q1[i]), qa1 = bfhi(q1[i]), qb0 = bflo(q2[i]), qb1 = bfhi(q2[i]);
                const float ka0 = bflo(k1[i]), ka1 = bfhi(k1[i]), kb0 = bflo(k2[i]), kb1 = bfhi(k2[i]);
                oq1[i] = cvt_pk_bf16(qa0 * c0.x - qb0 * c0.y, qa1 * c1.x - qb1 * c1.y);
                oq2[i] = cvt_pk_bf16(qa0 * c0.y + qb0 * c0.x, qa1 * c1.y + qb1 * c1.x);
                ok1[i] = cvt_pk_bf16((ka0 * c0.x - kb0 * c0.y) * 0.125f, (ka1 * c1.x - kb1 * c1.y) * 0.125f);
                ok2[i] = cvt_pk_bf16((ka0 * c0.y + kb0 * c0.x) * 0.125f, (ka1 * c1.y + kb1 * c1.x) * 0.125f);
            }
            *(u32x4*)(Qs + j * 72 + dq) = oq1; *(u32x4*)(Qs + j * 72 + 32 + dq) = oq2;
            *(u32x4*)(Ks + j * 72 + dq) = ok1; *(u32x4*)(Ks + j * 72 + 32 + dq) = ok2;
            const int e0 = (tid & 3) * 16;
            const u32x4 v1 = *(const u32x4*)(pr + C_V + h * 64 + e0), v2 = *(const u32x4*)(pr + C_V + h * 64 + e0 + 8);
#pragma unroll
            for (int i = 0; i < 4; ++i) {
                vT[(e0 + 2 * i) * 136 + j] = (bf16_t)(v1[i] & 0xffffu); vT[(e0 + 2 * i + 1) * 136 + j] = (bf16_t)(v1[i] >> 16);
                vT[(e0 + 8 + 2 * i) * 136 + j] = (bf16_t)(v2[i] & 0xffffu); vT[(e0 + 8 + 2 * i + 1) * 136 + j] = (bf16_t)(v2[i] >> 16);
            }
        }
        __syncthreads();
        const int i0 = wid * 16, ii = i0 + fr;
        bf16x8 bq[2];
#pragma unroll
        for (int ks = 0; ks < 2; ++ks) bq[ks] = *(const bf16x8*)(Qs + (i0 + fr) * 72 + ks * 32 + fq * 8);
        f32x4 s[8];
#pragma unroll
        for (int jt = 0; jt < 8; ++jt) {
            s[jt] = (f32x4){0.f, 0.f, 0.f, 0.f};
#pragma unroll
            for (int ks = 0; ks < 2; ++ks) {
                const bf16x8 a = *(const bf16x8*)(Ks + (jt * 16 + fr) * 72 + ks * 32 + fq * 8);
                s[jt] = __builtin_amdgcn_mfma_f32_16x16x32_bf16(a, bq[ks], s[jt], 0, 0, 0);
            }
#pragma unroll
            for (int jj = 0; jj < 4; ++jj) {
                const int delta = ii - (jt * 16 + fq * 4 + jj);
                const float fac = delta >= 0 ? exp2f(lgf2 * (float)delta) : exp2f(lgb2 * (float)(-delta));
                s[jt][jj] *= fac;
            }
        }
        bf16x8 bp[4];
#pragma unroll
        for (int k2 = 0; k2 < 4; ++k2) {
            u32x4 w; w[0] = cvt_pk_bf16(s[2 * k2][0], s[2 * k2][1]); w[1] = cvt_pk_bf16(s[2 * k2][2], s[2 * k2][3]);
            w[2] = cvt_pk_bf16(s[2 * k2 + 1][0], s[2 * k2 + 1][1]); w[3] = cvt_pk_bf16(s[2 * k2 + 1][2], s[2 * k2 + 1][3]);
            bp[k2] = __builtin_bit_cast(bf16x8, w);
        }
        const bf16_t* pf = PREV + ((size_t)(cidx * 8 + h) * 2) * 4096;
        const bf16_t* pb = pf + 4096;
        const float qf = exp2f(lgf2 * (float)(ii + 1)), qb = exp2f(lgb2 * (float)(128 - ii));
        f32x4 o[4];
#pragma unroll
        for (int et = 0; et < 4; ++et) {
            o[et] = (f32x4){0.f, 0.f, 0.f, 0.f};
#pragma unroll
            for (int k2 = 0; k2 < 4; ++k2) {
                const u32x2 lo = *(const u32x2*)(vT + (et * 16 + fr) * 136 + (2 * k2) * 16 + fq * 4);
                const u32x2 hi = *(const u32x2*)(vT + (et * 16 + fr) * 136 + (2 * k2 + 1) * 16 + fq * 4);
                u32x4 w; w[0] = lo[0]; w[1] = lo[1]; w[2] = hi[0]; w[3] = hi[1];
                o[et] = __builtin_amdgcn_mfma_f32_16x16x32_bf16(__builtin_bit_cast(bf16x8, w), bp[k2], o[et], 0, 0, 0);
            }
            f32x4 cf = {0.f, 0.f, 0.f, 0.f}, cb = {0.f, 0.f, 0.f, 0.f};
#pragma unroll
            for (int ks = 0; ks < 2; ++ks) {
                const bf16x8 af = *(const bf16x8*)(pf + (et * 16 + fr) * 64 + ks * 32 + fq * 8);
                const bf16x8 ab = *(const bf16x8*)(pb + (et * 16 + fr) * 64 + ks * 32 + fq * 8);
                cf = __builtin_amdgcn_mfma_f32_16x16x32_bf16(af, bq[ks], cf, 0, 0, 0);
                cb = __builtin_amdgcn_mfma_f32_16x16x32_bf16(ab, bq[ks], cb, 0, 0, 0);
            }
            o[et] += cf * qf + cb * qb;
        }
        float sum = 0.f;
#pragma unroll
        for (int et = 0; et < 4; ++et) sum += (o[et][0] + o[et][1]) + (o[et][2] + o[et][3]);
        sum += __shfl_xor(sum, 16); sum += __shfl_xor(sum, 32);
        const float mu = sum * (1.f / 64.f);
        float vs = 0.f;
#pragma unroll
        for (int et = 0; et < 4; ++et) { const f32x4 d = o[et] - mu; vs += (d[0] * d[0] + d[1] * d[1]) + (d[2] * d[2] + d[3] * d[3]); }
        vs += __shfl_xor(vs, 16); vs += __shfl_xor(vs, 32);
        const float rstd = 1.0f / sqrtf(vs * (1.f / 64.f) + 1e-6f);
        const size_t tok = (size_t)(t0 + ii);
#pragma unroll
        for (int et = 0; et < 4; ++et) {
            const int e = et * 16 + fq * 4;
            const u32x2 gg = *(const u32x2*)(PROJ + tok * PC + C_G + h * 64 + e);
            const f32x4 gn = *(const f32x4*)(gn_g + h * 64 + e);
            const f32x4 y = (o[et] - mu) * rstd * gn;
            u32x2 w; w[0] = cvt_pk_bf16(siluf_(bflo(gg[0])) * y[0], siluf_(bfhi(gg[0])) * y[1]); w[1] = cvt_pk_bf16(siluf_(bflo(gg[1])) * y[2], siluf_(bfhi(gg[1])) * y[3]);
            *(u32x2*)(RT + tok * 512 + h * 64 + e) = w;
        }
    }
}

DEV int att_sw(int key) { return (key & 3) | ((key >> 1) & 12); }
DEV void attn_phase(const bf16_t* __restrict__ Q, const bf16_t* __restrict__ Kmem, const bf16_t* __restrict__ VmemT, bf16_t* __restrict__ O, const int S, const int g) {
    LAS unsigned char* lds = (LAS unsigned char*)g_lds;
    const int tid = TIDX, bid = BIDX, wid = tid >> 6, lane = tid & 63, fr = lane & 15, fq = lane >> 4;
    for (int unit = bid; unit < (TG / 256) * 4; unit += gridDim.x) {
        const int qb = unit >> 2, h = unit & 3, t0 = qb * 256, seq = t0 / S, b = (g < 2) ? g * 4 + seq : 8;
        const bf16_t* kb = Kmem + (size_t)(b * 256) * 1024 + h * 256;
        const bf16_t* vb = VmemT + ((size_t)(b * 4 + h) * 256) * 256;
        const size_t tok0 = (size_t)(t0 + wid * 16 + fr), tok1 = tok0 + 128;
        f32x4 s[2][16];
#pragma unroll
        for (int mt = 0; mt < 16; ++mt) { s[0][mt] = (f32x4){0.f, 0.f, 0.f, 0.f}; s[1][mt] = (f32x4){0.f, 0.f, 0.f, 0.f}; }
#pragma unroll 1
        for (int half = 0; half < 2; ++half) {
            __syncthreads();
#pragma unroll
            for (int i = 0; i < 8; ++i) {
                const int idx = tid + 512 * i, key = idx >> 4, ch = idx & 15;
                const u32x4 v = *(const u32x4*)(kb + (size_t)key * 1024 + half * 128 + ch * 8);
                *(LAS u32x4*)(lds + key * 256 + ((ch ^ att_sw(key)) << 4)) = v;
            }
            bf16x8 bq[2][4];
#pragma unroll
            for (int ks = 0; ks < 4; ++ks) {
                bq[0][ks] = *(const bf16x8*)(Q + tok0 * 1024 + h * 256 + half * 128 + ks * 32 + fq * 8);
                bq[1][ks] = *(const bf16x8*)(Q + tok1 * 1024 + h * 256 + half * 128 + ks * 32 + fq * 8);
            }
            __syncthreads();
#pragma unroll
            for (int mt = 0; mt < 16; ++mt) {
                const int key = 32 * (mt >> 1) + (fr >> 2) * 8 + (mt & 1) * 4 + (fr & 3);
#pragma unroll
                for (int ks = 0; ks < 4; ++ks) {
                    const bf16x8 a = *(const LAS bf16x8*)(lds + key * 256 + (((ks * 4 + fq) ^ fr) << 4));
                    s[0][mt] = __builtin_amdgcn_mfma_f32_16x16x32_bf16(a, bq[0][ks], s[0][mt], 0, 0, 0);
                    s[1][mt] = __builtin_amdgcn_mfma_f32_16x16x32_bf16(a, bq[1][ks], s[1][mt], 0, 0, 0);
                }
            }
        }
        bf16x8 bp[2][8]; float il[2];
#pragma unroll
        for (int qs = 0; qs < 2; ++qs) {
            float mx = -3.0e38f;
#pragma unroll
            for (int mt = 0; mt < 16; ++mt) mx = fmaxf(mx, fmaxf(fmaxf(s[qs][mt][0], s[qs][mt][1]), fmaxf(s[qs][mt][2], s[qs][mt][3])));
            mx = fmaxf(mx, __shfl_xor(mx, 16)); mx = fmaxf(mx, __shfl_xor(mx, 32));
            float l = 0.f;
#pragma unroll
            for (int mt = 0; mt < 16; ++mt) {
#pragma unroll
                for (int jj = 0; jj < 4; ++jj) { const float pv = __expf(s[qs][mt][jj] - mx); s[qs][mt][jj] = pv; l += pv; }
            }
            l += __shfl_xor(l, 16); l += __shfl_xor(l, 32);
            il[qs] = 1.0f / l;
#pragma unroll
            for (int k2 = 0; k2 < 8; ++k2) {
                u32x4 w; w[0] = cvt_pk_bf16(s[qs][2 * k2][0], s[qs][2 * k2][1]); w[1] = cvt_pk_bf16(s[qs][2 * k2][2], s[qs][2 * k2][3]);
                w[2] = cvt_pk_bf16(s[qs][2 * k2 + 1][0], s[qs][2 * k2 + 1][1]); w[3] = cvt_pk_bf16(s[qs][2 * k2 + 1][2], s[qs][2 * k2 + 1][3]);
                bp[qs][k2] = __builtin_bit_cast(bf16x8, w);
            }
        }
#pragma unroll 1
        for (int half = 0; half < 2; ++half) {
            __syncthreads();
#pragma unroll
            for (int i = 0; i < 8; ++i) {
                const int idx = tid + 512 * i, dd = idx >> 5, ch = idx & 31;
                const u32x4 v = *(const u32x4*)(vb + (size_t)(half * 128 + dd) * 256 + ch * 8);
                *(LAS u32x4*)(lds + dd * 512 + ((ch ^ (dd & 15)) << 4)) = v;
            }
            __syncthreads();
#pragma unroll
            for (int dt = 0; dt < 8; ++dt) {
                f32x4 o0 = {0.f, 0.f, 0.f, 0.f}, o1 = {0.f, 0.f, 0.f, 0.f};
#pragma unroll
                for (int k2 = 0; k2 < 8; ++k2) {
                    const bf16x8 a = *(const LAS bf16x8*)(lds + (dt * 16 + fr) * 512 + (((k2 * 4 + fq) ^ fr) << 4));
                    o0 = __builtin_amdgcn_mfma_f32_16x16x32_bf16(a, bp[0][k2], o0, 0, 0, 0);
                    o1 = __builtin_amdgcn_mfma_f32_16x16x32_bf16(a, bp[1][k2], o1, 0, 0, 0);
                }
                const int dcol = h * 256 + half * 128 + dt * 16 + fq * 4;
                u32x2 w; w[0] = cvt_pk_bf16(o0[0] * il[0], o0[1] * il[0]); w[1] = cvt_pk_bf16(o0[2] * il[0], o0[3] * il[0]);
                *(u32x2*)(O + tok0 * 1024 + dcol) = w;
                w[0] = cvt_pk_bf16(o1[0] * il[1], o1[1] * il[1]); w[1] = cvt_pk_bf16(o1[2] * il[1], o1[3] * il[1]);
                *(u32x2*)(O + tok1 * 1024 + dcol) = w;
            }
        }
    }
}

#define XB_TMO      128
#define XB_XCNT(j)  (256  + 64 * (j))
#define XB_XSUB(j)  (1280 + 64 * (j))
#define XB_XGEN(j)  (2304 + 64 * (j))
#define XB_TOP      3328
#define XB_TOPGEN   3392
#define XCD_BAR_WORDS 3456
#define XB_SPIN_CAP (1u << 22)
DEV unsigned xb_ld(unsigned* p)              { return __hip_atomic_load(p, __ATOMIC_RELAXED, __HIP_MEMORY_SCOPE_AGENT); }
DEV unsigned xb_add(unsigned* p, unsigned v) { return __hip_atomic_fetch_add(p, v, __ATOMIC_RELAXED, __HIP_MEMORY_SCOPE_AGENT); }
DEV unsigned xb_xcc_id() { return (unsigned)__builtin_amdgcn_s_getreg((3 << 11) | 20) & 0xFu; }
#define XB_SPIN(cond, bar) do { unsigned _sp = 0; while (cond) { __builtin_amdgcn_s_sleep(1); \
    if ((++_sp & 255u) == 0u) { if (xb_ld(&(bar)[XB_TMO])) break; if (_sp > XB_SPIN_CAP) { atomicAdd(&(bar)[XB_TMO], 1u); break; } } } } while (0)
struct XcdBarrier { unsigned* bar; unsigned x; volatile LAS unsigned* st; };
DEV XcdBarrier xcd_barrier_post(unsigned* bar, volatile LAS unsigned* st) {
    XcdBarrier b; b.bar = bar; b.x = xb_xcc_id(); b.st = st;
    if (threadIdx.x == 0) (void)xb_add(&bar[XB_XCNT(b.x)], 1u);
    return b;
}
DEV void xcd_barrier_complete(unsigned* bar, unsigned x, unsigned& nloc, unsigned& nx) {
    const unsigned G = gridDim.x * gridDim.y * gridDim.z;
    unsigned sum, cnt, mine, sp = 0u;
    for (;;) {
        sum = 0u; cnt = 0u; mine = 0u;
#pragma unroll
        for (unsigned j = 0; j < 16; ++j) { const unsigned c = xb_ld(&bar[XB_XCNT(j)]); sum += c; cnt += (c > 0u) ? 1u : 0u; mine = (j == x) ? c : mine; }
        if (sum == G) break;
        __builtin_amdgcn_s_sleep(1);
        if ((++sp & 255u) == 0u) { if (xb_ld(&bar[XB_TMO])) break; if (sp > XB_SPIN_CAP) { atomicAdd(&bar[XB_TMO], 1u); break; } }
    }
    nloc = mine > 0u ? mine : 1u; nx = cnt > 0u ? cnt : 1u;
}
DEV void xcd_barrier(const XcdBarrier& b) {
    asm volatile("s_waitcnt vmcnt(0)" ::: "memory");
    __syncthreads();
    if (threadIdx.x == 0) {
        unsigned* bar = b.bar;
        __builtin_amdgcn_s_waitcnt(0);
        unsigned nloc = b.st[0], nx = b.st[1];
        if (nloc == 0u) { xcd_barrier_complete(bar, b.x, nloc, nx); b.st[0] = nloc; b.st[1] = nx; }
        const unsigned old = xb_add(&bar[XB_XSUB(b.x)], 1u);
        const unsigned gen = old / nloc;
        if (old + 1u == (gen + 1u) * nloc) {
            __builtin_amdgcn_fence(__ATOMIC_RELEASE, "agent");
            asm volatile("s_waitcnt vmcnt(0)" ::: "memory");
            const unsigned og = xb_add(&bar[XB_TOP], 1u);
            const unsigned tg = og / nx;
            if (og + 1u == (tg + 1u) * nx) xb_add(&bar[XB_TOPGEN], 1u);
            else XB_SPIN(xb_ld(&bar[XB_TOPGEN]) == tg, bar);
            __builtin_amdgcn_fence(__ATOMIC_ACQUIRE, "agent");
            xb_add(&bar[XB_XGEN(b.x)], 1u);
            asm volatile("s_waitcnt vmcnt(0)" ::: "memory");
        } else {
            XB_SPIN(xb_ld(&bar[XB_XGEN(b.x)]) == gen, bar);
            __builtin_amdgcn_fence(__ATOMIC_ACQUIRE, "agent");
            asm volatile("s_waitcnt vmcnt(0)" ::: "memory");
        }
    }
    __syncthreads();
}

constexpr int PH_PER_GROUP = 27, N_PHASES = 2 + NGRP * PH_PER_GROUP;

DEV void run_phase(const Params& p, const int ph) {
    unsigned char* ws = p.ws;
    if (ph == 0) {
#if PROBE == 9
        setup_phase(p);
#endif
        setup_phase(p); return; }
    bf16_t* H = (bf16_t*)(ws + WS_H); bf16_t* HID = (bf16_t*)(ws + WS_HID); bf16_t* PROJ = (bf16_t*)(ws + WS_PROJ);
    bf16_t* MIXB = (bf16_t*)(ws + WS_MIXB); bf16_t* QB = (bf16_t*)(ws + WS_QB); bf16_t* OB = (bf16_t*)(ws + WS_OB);
    bf16_t* CV = (bf16_t*)(ws + WS_CV); bf16_t* RT = (bf16_t*)(ws + WS_RT);
    float* KVST = (float*)(ws + WS_KVST); bf16_t* PREV = (bf16_t*)(ws + WS_PREV);
    const float2* rot = (const float2*)(ws + WS_ROT);
    GemmDesc gd{};
    int kind = 0;
    int g = 0, l = 0, s = 0;
    if (ph == 1) {
        gd.A = (const bf16_t*)(ws + WS_MEMN); gd.Bt = (const bf16_t*)(ws + WS_WT) + O_KV; gd.M = 2 * 2304; gd.N = 2048; gd.K = 1024; gd.epi = EPI_KV;
        gd.out = ws + WS_KMEM; gd.out2 = (bf16_t*)(ws + WS_VMEMT); gd.bt_layer_stride = WL;
    } else {
        const int idx = ph - 2; g = idx / PH_PER_GROUP; const int r = idx - g * PH_PER_GROUP;
        if (r < 14) { l = 0; s = r; } else { l = 1; s = r - 13; }
    }
    const int S = (g < 2) ? 4096 : 16384;
    const bf16_t* W = (const bf16_t*)(ws + WS_WT) + (size_t)l * WL;
    const float* ng = p.in[4] + (size_t)l * 8 * 1024;
    const float* xin = (g < 2) ? p.in[0] + (size_t)g * TG * 1024 : p.in[1];
    float* X = p.out + (size_t)g * TG * 1024;
    int fk = -1;
    if (ph >= 2) {
        gd.M = TG; gd.X = X; gd.Hout = H; gd.xbuf = (float*)(ws + WS_XBUF); gd.cnt = (unsigned*)(ws + WS_CNT);
        switch (s) {
        case 0: kind = 1; break;
        case 1: gd.A = H; gd.Bt = W + O_GU1; gd.N = 5632; gd.K = 1024; gd.epi = EPI_SWIGLU; gd.out = HID; break;
        case 2: gd.A = HID; gd.Bt = W + O_D1; gd.N = 1024; gd.K = 2816; gd.epi = EPI_RES; fk = 0; gd.scale = 0.5f; gd.gpost = ng + 1 * 1024; gd.gnext = ng + 2 * 1024; break;
        case 3: gd.A = H; gd.Bt = W + O_IN; gd.N = PC; gd.K = 1024; gd.epi = EPI_PROJ; gd.out = PROJ; gd.gate_b = p.in[17] + (size_t)l * 2048; break;
        case 4: kind = 2; break;
        case 5: kind = 3; break;
        case 6: kind = 4; break;
        case 7: gd.A = CV; gd.Bt = W + O_PW; gd.N = 1024; gd.K = 512; gd.epi = EPI_MIX; gd.out = MIXB; gd.A2 = RT; gd.Bt2 = W + O_RO; gd.K2 = 512; gd.proj = PROJ; break;
        case 8: gd.A = MIXB; gd.Bt = W + O_MIX; gd.N = 1024; gd.K = 1024; gd.epi = EPI_RES; fk = 1; gd.scale = 1.f; gd.gpost = ng + 3 * 1024; gd.gnext = ng + 4 * 1024; break;
        case 9: gd.A = H; gd.Bt = W + O_Q; gd.N = 1024; gd.K = 1024; gd.epi = EPI_BF16; gd.out = QB; break;
        case 10: kind = 5; break;
        case 11: gd.A = OB; gd.Bt = W + O_O; gd.N = 1024; gd.K = 1024; gd.epi = EPI_RES; fk = 2; gd.scale = 1.f; gd.gpost = ng + 5 * 1024; gd.gnext = ng + 6 * 1024; break;
        case 12: gd.A = H; gd.Bt = W + O_GU2; gd.N = 5632; gd.K = 1024; gd.epi = EPI_SWIGLU; gd.out = HID; break;
        default: gd.A = HID; gd.Bt = W + O_D2; gd.N = 1024; gd.K = 2816; gd.epi = EPI_RES; fk = 3; gd.scale = 0.5f; gd.gpost = ng + 7 * 1024; gd.gnext = (l == 0) ? p.in[4] + (size_t)8 * 1024 : nullptr; break;
        }
        gd.expect = 4u * (unsigned)(g * 8 + l * 4 + fk + 1); gd.skip1 = 4u * (unsigned)g;
    }
    if (kind == 0) {
        switch (gd.epi) {
        case EPI_RES: gemm_phase<EPI_RES>(gd); break;
        case EPI_BF16:
#if PROBE == 12
            gemm_phase<EPI_BF16>(gd);
#endif
            gemm_phase<EPI_BF16>(gd); break;
        case EPI_SWIGLU:
#if PROBE == 6
            for (int rep = 0; rep < 2; ++rep)
#endif
            gemm_phase<EPI_SWIGLU>(gd);
#if PROBE == 10
            gemm_phase<7>(gd);
#endif
            break;
        case EPI_PROJ:
#if PROBE == 7
            for (int rep = 0; rep < 2; ++rep)
#endif
            gemm_phase<EPI_PROJ>(gd); break;
        case EPI_MIX:
#if PROBE == 13
            gemm_phase<EPI_MIX>(gd);
#endif
            gemm_phase<EPI_MIX>(gd); break;
        default: gemm_phase<EPI_KV>(gd); break;
        }
    }
    else if (kind == 1) rowwise_phase(xin, X, nullptr, 1.f, nullptr, ng, H);
    else if (kind == 2) {
        conv_phase(PROJ, CV, p.in[8] + (size_t)l * 31 * 512, p.in[9] + l * 512, p.in[10] + l * 512, p.in[11] + l * 512, S);
        r1_phase(PROJ, rot, KVST, p.in[13] + l * 8, p.in[14] + l * 8, S);
    } else if (kind == 3) {
#if PROBE == 11
        r2_phase(KVST, PREV, p.in[13] + l * 8, p.in[14] + l * 8, S);
#endif
        r2_phase(KVST, PREV, p.in[13] + l * 8, p.in[14] + l * 8, S);
    }
    else if (kind == 4) r3_phase(PROJ, rot, PREV, RT, p.in[13] + l * 8, p.in[14] + l * 8, p.in[15] + l * 512, S);
    else attn_phase(QB, (const bf16_t*)(ws + WS_KMEM) + (size_t)l * 2304 * 1024, (const bf16_t*)(ws + WS_VMEMT) + (size_t)l * 2304 * 1024, OB, S, g);
}

__global__ void __launch_bounds__(NTHREADS) mega(const Params p) {
#if SINGLE_LAUNCH
    volatile LAS unsigned* st = (volatile LAS unsigned*)((LAS unsigned char*)g_lds + 131072);
    if (threadIdx.x == 0) { st[0] = 0u; st[1] = 0u; }
    __syncthreads();
    const XcdBarrier xb = xcd_barrier_post((unsigned*)(p.ws + WS_BAR), st);
#endif
    for (int ph = p.ph_begin; ph < p.ph_end; ++ph) {
        run_phase(p, ph);
#if SINGLE_LAUNCH
        if (ph + 1 < p.ph_end) {
            if (ph == 0) cg::this_grid().sync();
            else {
                xcd_barrier(xb);
#if PROBE == 1
                xcd_barrier(xb); xcd_barrier(xb);
#endif
            }
        }
#endif
    }
}

extern "C" void kernel_launch(void* const* d_in, const int* in_sizes, int n_in, void* d_out, int out_size, void* d_ws, size_t ws_size, hipStream_t stream) {
    static int grid = 0;
    if (grid == 0) {
        if (n_in != 25 || ws_size < WS_END) { fprintf(stderr, "kernel_launch: need 25 inputs and >= %zu bytes of workspace (got %d, %zu)\n", (size_t)WS_END, n_in, ws_size); grid = -1; return; }
        int dev = 0, cus = 0, per_cu = 0;
        hipGetDevice(&dev);
        hipDeviceGetAttribute(&cus, hipDeviceAttributeMultiprocessorCount, dev);
        if (hipFuncSetAttribute((const void*)mega, hipFuncAttributeMaxDynamicSharedMemorySize, LDS_BYTES) != hipSuccess) { fprintf(stderr, "kernel_launch: hipFuncSetAttribute failed\n"); grid = -1; return; }
        hipOccupancyMaxActiveBlocksPerMultiprocessor(&per_cu, (const void*)mega, NTHREADS, LDS_BYTES);
        if (per_cu < 1) per_cu = 1;
        (void)hipGetLastError();
        grid = cus * 1;
    }
    if (grid < 0) return;
    Params p{};
    for (int i = 0; i < 25; ++i) p.in[i] = (const float*)d_in[i];
    p.out = (float*)d_out; p.ws = (unsigned char*)d_ws;
    for (int i = 0; i < 32; ++i) p.inv_freq[i] = (float)pow(10000.0, -(double)i / 32.0);
#if SINGLE_LAUNCH
    p.ph_begin = 0; p.ph_end = N_PHASES;
    hipMemsetAsync((unsigned char*)d_ws + WS_BAR, 0, 16384 + 32768, stream);
    void* args[] = {&p};
    hipError_t e = hipLaunchCooperativeKernel((const void*)mega, dim3(grid), dim3(NTHREADS), args, LDS_BYTES, stream);
    if (e != hipSuccess) fprintf(stderr, "cooperative launch failed: %s (grid %d)\n", hipGetErrorString(e), grid);
#else
    for (int ph = 0; ph < N_PHASES; ++ph) {
        p.ph_begin = ph; p.ph_end = ph + 1;
        hipLaunchKernelGGL(mega, dim3(grid), dim3(NTHREADS), LDS_BYTES, stream, p);
    }
#endif
}
```

```cpp
#include <hip/hip_runtime.h>
#include <hip/hip_bf16.h>
#include <hip/hip_cooperative_groups.h>
#include <cstdio>
#include <cmath>
namespace cg = cooperative_groups;

#ifndef PROBE
#define PROBE 0
#endif
#ifndef SINGLE_LAUNCH
#define SINGLE_LAUNCH 1
#endif

#define DEV __device__ __forceinline__
typedef unsigned short bf16_t;
typedef short bf16x8 __attribute__((ext_vector_type(8)));
typedef short bf16x4 __attribute__((ext_vector_type(4)));
typedef float f32x4 __attribute__((ext_vector_type(4)));
typedef unsigned u32x4 __attribute__((ext_vector_type(4)));
typedef unsigned u32x2 __attribute__((ext_vector_type(2)));

constexpr int TG = 16384;
constexpr int NGRP = 3;
constexpr int PC = 5120;
constexpr int C_Q = 1024, C_K = 1536, C_V = 2048, C_G = 2560, C_GC = 3072, C_GR = 4096;
constexpr int NTHREADS = 512;
constexpr int LDS_BYTES = 131072 + 16;

constexpr size_t O_GU1 = 0, O_D1 = 5767168, O_IN = 8650752, O_PW = 13893632, O_RO = 14417920, O_MIX = 14942208,
                 O_Q = 15990784, O_KV = 17039360, O_O = 19136512, O_GU2 = 20185088, O_D2 = 25952256, WL = 28835840;
constexpr size_t WS_WT = 0;
constexpr size_t WS_ROT = WS_WT + 2 * WL * 2;
constexpr size_t WS_MEMN = WS_ROT + (size_t)16384 * 32 * 8;
constexpr size_t WS_KMEM = WS_MEMN + (size_t)2 * 2304 * 1024 * 2;
constexpr size_t WS_VMEMT = WS_KMEM + (size_t)2 * 2304 * 1024 * 2;
constexpr size_t WS_H = WS_VMEMT + (size_t)2 * 2304 * 1024 * 2;
constexpr size_t WS_HID = WS_H + (size_t)TG * 1024 * 2;
constexpr size_t WS_KVST = WS_HID;
constexpr size_t WS_PREV = WS_HID + 33554432;
constexpr size_t WS_MIXB = WS_HID + 50331648;
constexpr size_t WS_PROJ = WS_HID + (size_t)TG * 2816 * 2;
constexpr size_t WS_F = WS_PROJ;
constexpr size_t WS_QB = WS_PROJ + 67108864;
constexpr size_t WS_OB = WS_PROJ + 100663296;
constexpr size_t WS_CV = WS_PROJ + (size_t)TG * PC * 2;
constexpr size_t WS_RT = WS_CV + (size_t)TG * 512 * 2;
constexpr size_t WS_BAR = WS_RT + (size_t)TG * 512 * 2;
constexpr size_t WS_CNT = WS_BAR + 16384;
constexpr size_t WS_XBUF = WS_CNT + 32768;
constexpr size_t WS_ROWSS = WS_XBUF + 2 * 262144;
constexpr size_t WS_END = WS_ROWSS + (size_t)TG * 16;

struct Params {
    const float* in[25];
    float* out;
    unsigned char* ws;
    float inv_freq[32];
    int ph_begin, ph_end;
};

extern __shared__ __attribute__((aligned(16))) unsigned char g_lds[];

DEV unsigned cvt_pk_bf16(float lo, float hi) { unsigned r; asm("v_cvt_pk_bf16_f32 %0, %1, %2" : "=v"(r) : "v"(lo), "v"(hi)); return r; }
DEV bf16_t f2bf(float v) { return (bf16_t)(cvt_pk_bf16(v, 0.f) & 0xffffu); }
DEV float bf2f(bf16_t v) { return __uint_as_float((unsigned)v << 16); }
DEV float bflo(unsigned v) { return __uint_as_float(v << 16); }
DEV float bfhi(unsigned v) { return __uint_as_float(v & 0xffff0000u); }
DEV float sigmoidf_(float x) { return __builtin_amdgcn_rcpf(1.f + __expf(-x)); }
DEV float siluf_(float x) { return x * __builtin_amdgcn_rcpf(1.f + __expf(-x)); }
DEV float wave_sum(float v) {
#pragma unroll
    for (int o = 32; o > 0; o >>= 1) v += __shfl_xor(v, o);
    return v;
}

DEV int launder_v(int v) { asm volatile("" : "+v"(v)); return v; }
DEV int launder_s(int v) { asm volatile("" : "+s"(v)); return v; }
#define TIDX launder_v((int)threadIdx.x)
#define BIDX launder_s((int)blockIdx.x)
constexpr int BM = 256, BK = 64, HALF = 128, HT = HALF * BK, NXCD = 8, WGM = 8;
DEV int lds_byte(int r, int c) {
    int st = (r >> 4) * 2 + (c >> 5), rr = r & 15, cc = c & 31, ob = rr * 64 + cc * 2;
    return st * 1024 + (ob ^ (((ob >> 9) & 1) << 5));
}
DEV void stage_rc(int b, int& R, int& C) {
    int st = b / 1024, sb = b % 1024, swz = sb ^ (((sb >> 9) & 1) << 5);
    R = (st >> 1) * 16 + swz / 64; C = (st & 1) * 32 + (swz % 64) / 2;
}

#define LAS __attribute__((address_space(3)))
enum { EPI_F32 = 0, EPI_BF16 = 1, EPI_SWIGLU = 2, EPI_PROJ = 3, EPI_MIX = 4, EPI_KV = 5, EPI_RES = 6 };

struct GemmDesc {
    const bf16_t* A; const bf16_t* Bt; int M, N, K, epi;
    void* out;
    const bf16_t* A2; const bf16_t* Bt2; int K2;
    const bf16_t* proj;
    const float* gate_b;
    bf16_t* out2;
    size_t bt_layer_stride;
    bf16_t* XB; const float* gpost; float scale; float* xbuf; unsigned* cnt; unsigned expect;
    float* rowss_out;
    float* outf;
    const float* rowss;
};

template <int EPI> DEV void gemm_phase(const GemmDesc& g) {
    LAS unsigned char* lds = (LAS unsigned char*)g_lds;
    const int tid = TIDX, wid = __builtin_amdgcn_readfirstlane(tid >> 6), lane = tid & 63, wr = wid >> 2, wc = wid & 3, fr = lane & 15, fq = lane >> 4;
    const int K = g.K, nt = K / BK;
    const int nM = g.M / BM, nN = g.N / BM, nwg = nM * nN, G = gridDim.x, cblk = BIDX;
    const bool dual = (EPI == EPI_MIX);
    unsigned voff[2];
#pragma unroll
    for (int i = 0; i < 2; ++i) { int R, C; stage_rc(tid * 16 + i * 8192, R, C); voff[i] = (unsigned)(R * K + C) * 2u; }
    const size_t kstep = (size_t)(BK * 2), hstep = (size_t)HALF * K * 2, tstep = 2 * hstep;
    const unsigned ldsw = (unsigned)wid * 1024u;
    const int aoff = lds_byte(wr * 64 + fr, fq * 8), boff = lds_byte(wc * 32 + fr, fq * 8);
#define PG_SA(b, h) (((b) * 2 + (h)) * (HT * 2))
#define PG_SB(b, h) ((4 + (b) * 2 + (h)) * (HT * 2))
#define PG_STAGE(bufoff, gbase) do { _Pragma("unroll") for (int _i = 0; _i < 2; ++_i) \
        __builtin_amdgcn_global_load_lds((const unsigned*)((const char*)(gbase) + voff[_i]), (LAS unsigned*)(lds + (bufoff) + ldsw + _i * 8192), 16, 0, 0); } while (0)
#define PG_LDA(dst, b, h) do { _Pragma("unroll") for (int m = 0; m < 4; ++m) _Pragma("unroll") for (int k = 0; k < 2; ++k) dst[m][k] = *(const LAS bf16x8*)(lds + PG_SA(b, h) + aoff + m * 2048 + k * 1024); } while (0)
#define PG_LDB(dst, b, h) do { _Pragma("unroll") for (int n = 0; n < 2; ++n) _Pragma("unroll") for (int k = 0; k < 2; ++k) dst[n][k] = *(const LAS bf16x8*)(lds + PG_SB(b, h) + boff + n * 2048 + k * 1024); } while (0)
#define PG_MMA(ai, bj, Af, Bf) do { __builtin_amdgcn_s_setprio(1); _Pragma("unroll") for (int m = 0; m < 4; ++m) _Pragma("unroll") for (int n = 0; n < 2; ++n) _Pragma("unroll") for (int k = 0; k < 2; ++k) \
        acc[ai][bj][m][n] = __builtin_amdgcn_mfma_f32_16x16x32_bf16(Bf[n][k], Af[m][k], acc[ai][bj][m][n], 0, 0, 0); __builtin_amdgcn_s_setprio(0); } while (0)
#define PG_WAIT_V(n) asm volatile("s_waitcnt vmcnt(" #n ")" ::: "memory")
#define PG_WAIT_L(n) asm volatile("s_waitcnt lgkmcnt(" #n ")" ::: "memory")
#define PG_BAR __builtin_amdgcn_s_barrier()
#define PG_SCHED __builtin_amdgcn_sched_barrier(0)
#define PG_NEXT(i, pm_, pn_, seg_, ok_) do { const int _ti = dual ? ((i) >> 1) : (i); seg_ = dual ? ((i) & 1) : 0; const int _L = _ti * G + cblk; ok_ = _L < nwg; \
        if (ok_) { int wgid = _L; { const int q = nwg / NXCD, r = nwg % NXCD, xcd = wgid % NXCD, off = wgid / NXCD; wgid = (xcd < r ? xcd * (q + 1) : r * (q + 1) + (xcd - r) * q) + off; } \
          const int nig = WGM * nN, gid = wgid / nig, fm = gid * WGM, gsz = (nM - fm) < WGM ? (nM - fm) : WGM; pm_ = fm + ((wgid % nig) % gsz); pn_ = (wgid % nig) / gsz; } } while (0)
#define PG_ABASE(pm_, seg_) ((const char*)((seg_) ? g.A2 : g.A) + (size_t)(pm_) * tstep)
#define PG_BBASE(pm_, pn_, seg_) ((const char*)((seg_) ? g.Bt2 : g.Bt) + ((EPI == EPI_KV && (pm_) >= 9) ? g.bt_layer_stride * 2 : (size_t)0) + (size_t)(pn_) * tstep)
    int pm = 0, pn = 0, seg = 0, npm = 0, npn = 0, nseg = 0, ui = 0; bool ok;
    PG_NEXT(0, pm, pn, seg, ok);
    if (!ok) return;
    f32x4 acc[2][2][4][2];
#pragma unroll
    for (int a = 0; a < 2; ++a)
#pragma unroll
        for (int b = 0; b < 2; ++b)
#pragma unroll
            for (int m = 0; m < 4; ++m)
#pragma unroll
                for (int n = 0; n < 2; ++n) acc[a][b][m][n] = (f32x4){0.f, 0.f, 0.f, 0.f};
    bf16x8 At[4][2], B0[2][2], B1[2][2];
    const char* cA = PG_ABASE(pm, seg); const char* cB = PG_BBASE(pm, pn, seg);
    asm volatile("s_waitcnt vmcnt(0) lgkmcnt(0)" ::: "memory"); PG_BAR; PG_SCHED;
    PG_STAGE(PG_SB(0, 0), cB); PG_STAGE(PG_SA(0, 0), cA); PG_STAGE(PG_SB(0, 1), cB + hstep); PG_STAGE(PG_SA(0, 1), cA + hstep);
    if (wr == 1) PG_BAR;
    PG_WAIT_V(4); PG_BAR;
    PG_STAGE(PG_SB(1, 0), cB + kstep); PG_STAGE(PG_SA(1, 0), cA + kstep); PG_STAGE(PG_SB(1, 1), cB + hstep + kstep);
    PG_WAIT_V(6); PG_BAR;
    for (;;) {
        bool has_next; PG_NEXT(ui + 1, npm, npn, nseg, has_next);
        const char* nA = has_next ? PG_ABASE(npm, nseg) : cA; const char* nB = has_next ? PG_BBASE(npm, npn, nseg) : cB;
        for (int t = 0; t < nt; t += 2) {
            const bool last = (t == nt - 2);
            const char* a1 = cA + (size_t)(t + 1) * kstep;
            const char* a2 = last ? nA : cA + (size_t)(t + 2) * kstep; const char* b2 = last ? nB : cB + (size_t)(t + 2) * kstep;
            const char* a3 = a2 + kstep; const char* b3 = b2 + kstep;
            PG_LDB(B0, 0, 0); PG_SCHED; PG_LDA(At, 0, 0); PG_STAGE(PG_SA(1, 1), a1 + hstep);
            PG_WAIT_L(8); PG_BAR; PG_WAIT_L(0); PG_MMA(0, 0, At, B0); PG_BAR; PG_SCHED;
            PG_LDB(B1, 0, 1); PG_STAGE(PG_SB(0, 0), b2);
            PG_BAR; PG_WAIT_L(0); PG_MMA(0, 1, At, B1); PG_BAR;
            PG_LDA(At, 0, 1); PG_STAGE(PG_SA(0, 0), a2);
            PG_BAR; PG_WAIT_L(0); PG_MMA(1, 0, At, B0); PG_BAR; PG_SCHED;
            PG_STAGE(PG_SB(0, 1), b2 + hstep);
            PG_WAIT_V(6); PG_BAR; PG_MMA(1, 1, At, B1); PG_BAR;
            PG_LDB(B0, 1, 0); PG_SCHED; PG_LDA(At, 1, 0); PG_STAGE(PG_SA(0, 1), a2 + hstep);
            PG_WAIT_L(8); PG_BAR; PG_WAIT_L(0); PG_MMA(0, 0, At, B0); PG_BAR; PG_SCHED;
            PG_LDB(B1, 1, 1); PG_STAGE(PG_SB(1, 0), b3);
            PG_BAR; PG_WAIT_L(0); PG_MMA(0, 1, At, B1); PG_BAR;
            PG_LDA(At, 1, 1); PG_STAGE(PG_SA(1, 0), a3);
            PG_BAR; PG_WAIT_L(0); PG_MMA(1, 0, At, B0); PG_BAR; PG_SCHED;
            PG_STAGE(PG_SB(1, 1), b3 + hstep);
            PG_WAIT_V(6); PG_BAR; PG_MMA(1, 1, At, B1); PG_BAR;
        }
        const int brow = pm * BM, bcol = pn * BM;
        const int r0 = brow + wr * 64 + fr, c0 = bcol + wc * 32 + fq * 8;
        if (EPI == EPI_RES || EPI == 7) {
            if (EPI == 7) { float q = 0.f;
#pragma unroll
                for (int ai = 0; ai < 2; ++ai)
#pragma unroll
                    for (int bj = 0; bj < 2; ++bj)
#pragma unroll
                        for (int m = 0; m < 4; ++m)
#pragma unroll
                            for (int n = 0; n < 2; ++n) q += acc[ai][bj][m][n][0] + acc[ai][bj][m][n][1] + acc[ai][bj][m][n][2] + acc[ai][bj][m][n][3];
                if (q == 1.2345e-30f) ((float*)g.xbuf)[tid] = q; }
        } else if (EPI == EPI_MIX) {
          if (seg == 0) {
#pragma unroll
            for (int ai = 0; ai < 2; ++ai)
#pragma unroll
                for (int m = 0; m < 4; ++m) {
                    const bf16_t* pr = g.proj + (size_t)(r0 + ai * 128 + m * 16) * PC + c0;
#pragma unroll
                    for (int bj = 0; bj < 2; ++bj) {
                        const u32x4 gc = *(const u32x4*)(pr + C_GC + bj * 128), gr = *(const u32x4*)(pr + C_GR + bj * 128);
#pragma unroll
                        for (int n = 0; n < 2; ++n) {
                            f32x4 v = acc[ai][bj][m][n];
                            v[0] *= bflo(gc[2 * n]) * __builtin_amdgcn_rcpf(bflo(gr[2 * n])); v[1] *= bfhi(gc[2 * n]) * __builtin_amdgcn_rcpf(bfhi(gr[2 * n]));
                            v[2] *= bflo(gc[2 * n + 1]) * __builtin_amdgcn_rcpf(bflo(gr[2 * n + 1])); v[3] *= bfhi(gc[2 * n + 1]) * __builtin_amdgcn_rcpf(bfhi(gr[2 * n + 1]));
                            acc[ai][bj][m][n] = v;
                        }
                    }
                }
          } else {
#pragma unroll
            for (int ai = 0; ai < 2; ++ai)
#pragma unroll
                for (int m = 0; m < 4; ++m) {
                    const size_t row = (size_t)(r0 + ai * 128 + m * 16);
                    const bf16_t* pr = g.proj + row * PC + c0;
                    bf16_t* o = (bf16_t*)g.out + row * 1024 + c0;
#pragma unroll
                    for (int bj = 0; bj < 2; ++bj) {
                        const u32x4 gr = *(const u32x4*)(pr + C_GR + bj * 128);
                        const f32x4 v0 = acc[ai][bj][m][0], v1 = acc[ai][bj][m][1];
                        u32x4 w; w[0] = cvt_pk_bf16(v0[0] * bflo(gr[0]), v0[1] * bfhi(gr[0])); w[1] = cvt_pk_bf16(v0[2] * bflo(gr[1]), v0[3] * bfhi(gr[1]));
                        w[2] = cvt_pk_bf16(v1[0] * bflo(gr[2]), v1[1] * bfhi(gr[2])); w[3] = cvt_pk_bf16(v1[2] * bflo(gr[3]), v1[3] * bfhi(gr[3]));
                        *(u32x4*)(o + bj * 128) = w;
                    }
                }
          }
        } else if (EPI == EPI_F32) {
#pragma unroll
            for (int ai = 0; ai < 2; ++ai)
#pragma unroll
                for (int m = 0; m < 4; ++m) {
                    float* o = (float*)g.out + (size_t)(r0 + ai * 128 + m * 16) * g.N + c0;
#pragma unroll
                    for (int bj = 0; bj < 2; ++bj)
#pragma unroll
                        for (int n = 0; n < 2; ++n) *(f32x4*)(o + bj * 128 + n * 4) = acc[ai][bj][m][n];
                }
        } else if (EPI == EPI_BF16 || EPI == EPI_PROJ) {
            const bool sg = (EPI == EPI_PROJ) && (bcol >= C_GC);
#pragma unroll
            for (int ai = 0; ai < 2; ++ai)
#pragma unroll
                for (int m = 0; m < 4; ++m) {
                    const f32x4 q = *(const f32x4*)(g.rowss + (size_t)(r0 + ai * 128 + m * 16) * 4);
                    const float rs = 1.0f / sqrtf(((q[0] + q[1]) + (q[2] + q[3])) * (1.f / 1024.f) + 1e-6f);
#pragma unroll
                    for (int bj = 0; bj < 2; ++bj) { acc[ai][bj][m][0] *= rs; acc[ai][bj][m][1] *= rs; }
                }
#pragma unroll
            for (int ai = 0; ai < 2; ++ai)
#pragma unroll
                for (int m = 0; m < 4; ++m) {
                    bf16_t* o = (bf16_t*)g.out + (size_t)(r0 + ai * 128 + m * 16) * g.N + c0;
#pragma unroll
                    for (int bj = 0; bj < 2; ++bj) {
                        f32x4 v0 = acc[ai][bj][m][0], v1 = acc[ai][bj][m][1];
                        if (sg) {
                            const f32x4 b0 = *(const f32x4*)(g.gate_b + (c0 - C_GC) + bj * 128), b1 = *(const f32x4*)(g.gate_b + (c0 - C_GC) + bj * 128 + 4);
#pragma unroll
                            for (int j = 0; j < 4; ++j) { v0[j] = sigmoidf_(v0[j] + b0[j]); v1[j] = sigmoidf_(v1[j] + b1[j]); }
                        }
                        u32x4 w; w[0] = cvt_pk_bf16(v0[0], v0[1]); w[1] = cvt_pk_bf16(v0[2], v0[3]); w[2] = cvt_pk_bf16(v1[0], v1[1]); w[3] = cvt_pk_bf16(v1[2], v1[3]);
                        *(u32x4*)(o + bj * 128) = w;
                    }
                }
        } else if (EPI == EPI_SWIGLU) {
            const int hc0 = (bcol >> 1) + wc * 32 + fq * 8;
#pragma unroll
            for (int ai = 0; ai < 2; ++ai)
#pragma unroll
                for (int m = 0; m < 4; ++m) {
                    const f32x4 q = *(const f32x4*)(g.rowss + (size_t)(r0 + ai * 128 + m * 16) * 4);
                    const float rs = 1.0f / sqrtf(((q[0] + q[1]) + (q[2] + q[3])) * (1.f / 1024.f) + 1e-6f);
#pragma unroll
                    for (int bj = 0; bj < 2; ++bj) { acc[ai][bj][m][0] *= rs; acc[ai][bj][m][1] *= rs; }
                }
#pragma unroll
            for (int ai = 0; ai < 2; ++ai)
#pragma unroll
                for (int m = 0; m < 4; ++m) {
                    bf16_t* o = (bf16_t*)g.out + (size_t)(r0 + ai * 128 + m * 16) * (g.N >> 1) + hc0;
                    const f32x4 g0 = acc[ai][0][m][0], g1 = acc[ai][0][m][1], u0 = acc[ai][1][m][0], u1 = acc[ai][1][m][1];
                    u32x4 w; w[0] = cvt_pk_bf16(siluf_(g0[0]) * u0[0], siluf_(g0[1]) * u0[1]); w[1] = cvt_pk_bf16(siluf_(g0[2]) * u0[2], siluf_(g0[3]) * u0[3]);
                    w[2] = cvt_pk_bf16(siluf_(g1[0]) * u1[0], siluf_(g1[1]) * u1[1]); w[3] = cvt_pk_bf16(siluf_(g1[2]) * u1[2], siluf_(g1[3]) * u1[3]);
                    *(u32x4*)o = w;
                }
        } else {
#pragma unroll
            for (int ai = 0; ai < 2; ++ai)
#pragma unroll
                for (int m = 0; m < 4; ++m) {
                    const int row = r0 + ai * 128 + m * 16;
#pragma unroll
                    for (int bj = 0; bj < 2; ++bj) {
                        const f32x4 v0 = acc[ai][bj][m][0], v1 = acc[ai][bj][m][1];
                        const int col = c0 + bj * 128;
                        if (bcol < 1024) {
                            u32x4 w; w[0] = cvt_pk_bf16(v0[0], v0[1]); w[1] = cvt_pk_bf16(v0[2], v0[3]); w[2] = cvt_pk_bf16(v1[0], v1[1]); w[3] = cvt_pk_bf16(v1[2], v1[3]);
                            *(u32x4*)((bf16_t*)g.out + (size_t)row * 1024 + col) = w;
                        } else {
                            const int hh = (col - 1024) >> 8, d = (col - 1024) & 255, lb = row >> 8, mm = row & 255;
                            bf16_t* o = g.out2 + ((size_t)(lb * 4 + hh) * 256 + d) * 256 + mm;
#pragma unroll
                            for (int j = 0; j < 4; ++j) { o[j * 256] = f2bf(v0[j]); o[(j + 4) * 256] = f2bf(v1[j]); }
                        }
                    }
                }
        }
        if (!has_next) break;
        if (!(dual && seg == 0)) {
#pragma unroll
            for (int a = 0; a < 2; ++a)
#pragma unroll
                for (int b = 0; b < 2; ++b)
#pragma unroll
                    for (int m = 0; m < 4; ++m)
#pragma unroll
                        for (int n = 0; n < 2; ++n) acc[a][b][m][n] = (f32x4){0.f, 0.f, 0.f, 0.f};
        }
        pm = npm; pn = npn; seg = nseg; cA = nA; cB = nB; ++ui;
    }
    PG_WAIT_V(0);
    if (wr == 0) PG_BAR;
    PG_BAR;
    if (EPI == EPI_RES) {
        LAS float* P = (LAS float*)lds;
        LAS float* Sr = (LAS float*)(lds + 4096);
        const int brow = pm * BM, bcol = pn * BM;
        const int r0 = brow + wr * 64 + fr, c0 = bcol + wc * 32 + fq * 8, lr0 = wr * 64 + fr;
#pragma unroll
        for (int ai = 0; ai < 2; ++ai)
#pragma unroll
            for (int m = 0; m < 4; ++m) {
                float q = 0.f;
#pragma unroll
                for (int bj = 0; bj < 2; ++bj)
#pragma unroll
                    for (int n = 0; n < 2; ++n) { const f32x4 v = acc[ai][bj][m][n]; q += (v[0] * v[0] + v[1] * v[1]) + (v[2] * v[2] + v[3] * v[3]); }
                q += __shfl_xor(q, 16); q += __shfl_xor(q, 32);
                if (fq == 0) P[(ai * 128 + lr0 + m * 16) * 4 + wc] = q;
            }
        __syncthreads();
        unsigned* xb = (unsigned*)g.xbuf + (size_t)pm * 1024;
        unsigned* cn = g.cnt + (size_t)pm * 64;
        if (tid < 256) {
            const float tot = (P[tid * 4] + P[tid * 4 + 1]) + (P[tid * 4 + 2] + P[tid * 4 + 3]);
            __hip_atomic_store(xb + tid * 4 + pn, __float_as_uint(tot), __ATOMIC_RELAXED, __HIP_MEMORY_SCOPE_AGENT);
        }
        asm volatile("s_waitcnt vmcnt(0)" ::: "memory");
        __syncthreads();
        if (tid == 0) {
            (void)__hip_atomic_fetch_add(cn, 1u, __ATOMIC_RELAXED, __HIP_MEMORY_SCOPE_AGENT);
            unsigned sp = 0;
            while (__hip_atomic_load(cn, __ATOMIC_RELAXED, __HIP_MEMORY_SCOPE_AGENT) < g.expect) { __builtin_amdgcn_s_sleep(1); if (++sp > (1u << 22)) break; }
        }
        __syncthreads();
        if (tid < 256) {
            unsigned* xu = xb + tid * 4;
            const float t0 = __uint_as_float(__hip_atomic_load(xu + 0, __ATOMIC_RELAXED, __HIP_MEMORY_SCOPE_AGENT)), t1 = __uint_as_float(__hip_atomic_load(xu + 1, __ATOMIC_RELAXED, __HIP_MEMORY_SCOPE_AGENT));
            const float t2 = __uint_as_float(__hip_atomic_load(xu + 2, __ATOMIC_RELAXED, __HIP_MEMORY_SCOPE_AGENT)), t3 = __uint_as_float(__hip_atomic_load(xu + 3, __ATOMIC_RELAXED, __HIP_MEMORY_SCOPE_AGENT));
            Sr[tid] = g.scale / sqrtf(((t0 + t1) + (t2 + t3)) * (1.f / 1024.f) + 1e-6f);
        }
        __syncthreads();
        f32x4 gp[2][2];
#pragma unroll
        for (int bj = 0; bj < 2; ++bj)
#pragma unroll
            for (int n = 0; n < 2; ++n) gp[bj][n] = *(const f32x4*)(g.gpost + c0 + bj * 128 + n * 4);
        const bool fin = (g.outf != nullptr);
#pragma unroll
        for (int ai = 0; ai < 2; ++ai)
#pragma unroll
            for (int m = 0; m < 4; ++m) {
                const float av = Sr[ai * 128 + lr0 + m * 16];
                bf16_t* xr = g.XB + (size_t)(r0 + ai * 128 + m * 16) * 1024 + c0;
                float q = 0.f;
#pragma unroll
                for (int bj = 0; bj < 2; ++bj) {
                    const u32x4 xw = *(const u32x4*)(xr + bj * 128);
                    f32x4 v0 = acc[ai][bj][m][0] * av * gp[bj][0], v1 = acc[ai][bj][m][1] * av * gp[bj][1];
                    v0[0] += bflo(xw[0]); v0[1] += bfhi(xw[0]); v0[2] += bflo(xw[1]); v0[3] += bfhi(xw[1]);
                    v1[0] += bflo(xw[2]); v1[1] += bfhi(xw[2]); v1[2] += bflo(xw[3]); v1[3] += bfhi(xw[3]);
                    q += ((v0[0] * v0[0] + v0[1] * v0[1]) + (v0[2] * v0[2] + v0[3] * v0[3])) + ((v1[0] * v1[0] + v1[1] * v1[1]) + (v1[2] * v1[2] + v1[3] * v1[3]));
                    if (fin) {
                        float* orow = g.outf + (size_t)(r0 + ai * 128 + m * 16) * 1024 + c0 + bj * 128;
                        *(f32x4*)orow = v0; *(f32x4*)(orow + 4) = v1;
                    } else {
                        u32x4 w; w[0] = cvt_pk_bf16(v0[0], v0[1]); w[1] = cvt_pk_bf16(v0[2], v0[3]); w[2] = cvt_pk_bf16(v1[0], v1[1]); w[3] = cvt_pk_bf16(v1[2], v1[3]);
                        *(u32x4*)(xr + bj * 128) = w;
                    }
                }
                q += __shfl_xor(q, 16); q += __shfl_xor(q, 32);
                if (fq == 0) P[(ai * 128 + lr0 + m * 16) * 4 + wc] = q;
            }
        __syncthreads();
        if (tid < 256) g.rowss_out[(size_t)(brow + tid) * 4 + pn] = (P[tid * 4] + P[tid * 4 + 1]) + (P[tid * 4 + 2] + P[tid * 4 + 3]);
    }
#undef PG_SA
#undef PG_SB
#undef PG_STAGE
#undef PG_LDA
#undef PG_LDB
#undef PG_MMA
#undef PG_NEXT
#undef PG_ABASE
#undef PG_BBASE
}

DEV void transpose_mat(const float* __restrict__ src, const int K, const int N, bf16_t* __restrict__ dst, const int perm, const float scale, const float* __restrict__ kscale) {
    float* tile = (float*)g_lds;
    const int nkt = K / 64, ntile = nkt * (N / 64), tid = TIDX, bid = BIDX;
    for (int t = bid; t < ntile; t += gridDim.x) {
        const int rt = t / nkt, kt = t - rt * nkt, rho0 = rt * 64;
        const int cbase = perm ? (((rho0 & 255) >> 7) * 2816 + (rho0 >> 8) * 128 + (rho0 & 127)) : rho0;
        __syncthreads();
#pragma unroll
        for (int i = 0; i < 8; ++i) { const int kk = (tid >> 6) + 8 * i, cc = tid & 63; tile[kk * 65 + cc] = src[(size_t)(kt * 64 + kk) * N + cbase + cc] * (kscale ? kscale[kt * 64 + kk] : 1.0f); }
        __syncthreads();
#pragma unroll
        for (int i = 0; i < 4; ++i) {
            const int rr = (tid >> 5) + 16 * i, k2 = (tid & 31) * 2;
            const int r32 = rr & 31, cc = (rr & 32) + 8 * ((r32 & 15) >> 2) + 4 * (r32 >> 4) + (r32 & 3);
            *(unsigned*)(dst + (size_t)(rho0 + rr) * K + kt * 64 + k2) = cvt_pk_bf16(tile[k2 * 65 + cc] * scale, tile[(k2 + 1) * 65 + cc] * scale);
        }
    }
}

DEV void setup_phase(const Params& p) {
    bf16_t* wt = (bf16_t*)(p.ws + WS_WT);
    for (int l = 0; l < 2; ++l) {
        bf16_t* w = wt + (size_t)l * WL;
        const float* ngl = p.in[4] + (size_t)l * 8 * 1024;
        transpose_mat(p.in[5] + (size_t)l * 1024 * 5632, 1024, 5632, w + O_GU1, 1, 1.f, ngl + 0 * 1024);
        transpose_mat(p.in[6] + (size_t)l * 2816 * 1024, 2816, 1024, w + O_D1, 0, 1.f, nullptr);
        transpose_mat(p.in[7] + (size_t)l * 1024 * 5120, 1024, 5120, w + O_IN, 0, 1.f, ngl + 2 * 1024);
        transpose_mat(p.in[12] + (size_t)l * 512 * 1024, 512, 1024, w + O_PW, 0, 1.f, nullptr);
        transpose_mat(p.in[16] + (size_t)l * 512 * 1024, 512, 1024, w + O_RO, 0, 1.f, nullptr);
        transpose_mat(p.in[18] + (size_t)l * 1024 * 1024, 1024, 1024, w + O_MIX, 0, 1.f, nullptr);
        transpose_mat(p.in[20] + (size_t)l * 1024 * 1024, 1024, 1024, w + O_Q, 0, 0.0625f, ngl + 4 * 1024);
        transpose_mat(p.in[21] + (size_t)l * 1024 * 2048, 1024, 2048, w + O_KV, 0, 1.f, nullptr);
        transpose_mat(p.in[22] + (size_t)l * 1024 * 1024, 1024, 1024, w + O_O, 0, 1.f, nullptr);
        transpose_mat(p.in[23] + (size_t)l * 1024 * 5632, 1024, 5632, w + O_GU2, 1, 1.f, ngl + 6 * 1024);
        transpose_mat(p.in[24] + (size_t)l * 2816 * 1024, 2816, 1024, w + O_D2, 0, 1.f, nullptr);
    }
    float2* rot = (float2*)(p.ws + WS_ROT);
    const int tid0 = TIDX, bid0 = BIDX;
    for (int idx = bid0 * NTHREADS + tid0; idx < 16384 * 32; idx += gridDim.x * NTHREADS) {
        const int pos = idx >> 5, i = idx & 31;
        const float ang = (float)pos * p.inv_freq[i];
        double rev = (double)ang * 0.15915494309189535;
        rev -= floor(rev);
        const float fr = (float)rev;
        rot[idx] = make_float2(__builtin_amdgcn_cosf(fr), __builtin_amdgcn_sinf(fr));
    }
    bf16_t* memn = (bf16_t*)(p.ws + WS_MEMN);
    const int lane = tid0 & 63, gw = bid0 * 8 + (tid0 >> 6), nw = gridDim.x * 8;
    for (int rr = gw; rr < 2 * 2304; rr += nw) {
        const int l = rr / 2304, row = rr - l * 2304;
        const float* src = row < 2048 ? p.in[2] + (size_t)row * 1024 : p.in[3] + (size_t)(row - 2048) * 1024;
        const float* mg = p.in[19] + l * 1024;
        f32x4 x[4]; float ss = 0.f;
#pragma unroll
        for (int i = 0; i < 4; ++i) { x[i] = *(const f32x4*)(src + i * 256 + lane * 4); ss += x[i][0] * x[i][0] + x[i][1] * x[i][1] + x[i][2] * x[i][2] + x[i][3] * x[i][3]; }
        ss = wave_sum(ss);
        const float r = 1.0f / sqrtf(ss * (1.f / 1024.f) + 1e-6f);
#pragma unroll
        for (int i = 0; i < 4; ++i) {
            const f32x4 gg = *(const f32x4*)(mg + i * 256 + lane * 4);
            u32x2 w; w[0] = cvt_pk_bf16(x[i][0] * r * gg[0], x[i][1] * r * gg[1]); w[1] = cvt_pk_bf16(x[i][2] * r * gg[2], x[i][3] * r * gg[3]);
            *(u32x2*)(memn + (size_t)rr * 1024 + i * 256 + lane * 4) = w;
        }
    }
}

DEV void rw0_phase(const float* __restrict__ Xsrc, bf16_t* __restrict__ XB, float* __restrict__ rowss) {
    const int tid0 = TIDX, bid0 = BIDX;
    const int lane = tid0 & 63, gw = bid0 * 8 + (tid0 >> 6), nw = gridDim.x * 8;
    for (int row = gw; row < TG; row += nw) {
        f32x4 x[4]; float ss = 0.f;
#pragma unroll
        for (int i = 0; i < 4; ++i) { x[i] = *(const f32x4*)(Xsrc + (size_t)row * 1024 + i * 256 + lane * 4); ss += x[i][0] * x[i][0] + x[i][1] * x[i][1] + x[i][2] * x[i][2] + x[i][3] * x[i][3]; }
        ss = wave_sum(ss);
#pragma unroll
        for (int i = 0; i < 4; ++i) {
            u32x2 w; w[0] = cvt_pk_bf16(x[i][0], x[i][1]); w[1] = cvt_pk_bf16(x[i][2], x[i][3]);
            *(u32x2*)(XB + (size_t)row * 1024 + i * 256 + lane * 4) = w;
        }
        if (lane == 0) *(f32x4*)(rowss + (size_t)row * 4) = (f32x4){ss, 0.f, 0.f, 0.f};
    }
}

DEV void conv_phase(const bf16_t* __restrict__ PROJ, bf16_t* __restrict__ CV, const float* __restrict__ dw_w, const float* __restrict__ dw_b,
                    const float* __restrict__ ln_g, const float* __restrict__ ln_b, const int S) {
    bf16_t* us = (bf16_t*)g_lds;
    float* red = (float*)(g_lds + 62 * 512 * 2);
    float* stat = red + 8 * 32 * 2;
    const int tid = TIDX, bid = BIDX, c = tid, wid = tid >> 6, lane = tid & 63;
    float w[31];
#pragma unroll
    for (int k = 0; k < 31; ++k) w[k] = dw_w[k * 512 + c];
    const float bias = dw_b[c], lg = ln_g[c], lb = ln_b[c];
    for (int u = bid; u < TG / 32; u += gridDim.x) {
        const int t0 = u * 32, seq = t0 / S, pos0 = t0 - seq * S;
        __syncthreads();
        const int cg8 = (tid & 63) * 8;
#pragma unroll
        for (int it = 0; it < 8; ++it) {
            const int tt = it * 8 + (tid >> 6);
            if (tt < 62) {
                const int pos = pos0 - 15 + tt;
                u32x4 o = {0u, 0u, 0u, 0u};
                if (pos >= 0 && pos < S) {
                    const bf16_t* pr = PROJ + (size_t)(seq * S + pos) * PC;
                    const u32x4 v = *(const u32x4*)(pr + cg8), gt = *(const u32x4*)(pr + 512 + cg8);
#pragma unroll
                    for (int q = 0; q < 4; ++q) o[q] = cvt_pk_bf16(bflo(v[q]) * sigmoidf_(bflo(gt[q])), bfhi(v[q]) * sigmoidf_(bfhi(gt[q])));
                }
                *(u32x4*)(us + tt * 512 + cg8) = o;
            }
        }
        __syncthreads();
        float acc[32];
#pragma unroll
        for (int seg = 0; seg < 4; ++seg) {
#pragma unroll
            for (int s = 0; s < 8; ++s) acc[seg * 8 + s] = bias;
#pragma unroll
            for (int kk = 0; kk < 38; ++kk) {
                const float uv = bf2f(us[(seg * 8 + kk) * 512 + c]);
#pragma unroll
                for (int s = 0; s < 8; ++s) { const int k = kk - s; if (k >= 0 && k < 31) acc[seg * 8 + s] += w[k] * uv; }
            }
        }
#pragma unroll
        for (int s = 0; s < 32; ++s) {
            const float s1 = wave_sum(acc[s]), s2 = wave_sum(acc[s] * acc[s]);
            if (lane == 0) { red[(wid * 32 + s) * 2] = s1; red[(wid * 32 + s) * 2 + 1] = s2; }
        }
        __syncthreads();
        if (tid < 32) {
            float s1 = 0.f, s2 = 0.f;
#pragma unroll
            for (int q = 0; q < 8; ++q) { s1 += red[(q * 32 + tid) * 2]; s2 += red[(q * 32 + tid) * 2 + 1]; }
            const float mean = s1 * (1.f / 512.f), var = fmaxf(s2 * (1.f / 512.f) - mean * mean, 0.f);
            stat[tid * 2] = mean; stat[tid * 2 + 1] = 1.0f / sqrtf(var + 1e-6f);
        }
        __syncthreads();
#pragma unroll
        for (int s = 0; s < 32; ++s) {
            const float y = (acc[s] - stat[s * 2]) * stat[s * 2 + 1] * lg + lb;
            CV[(size_t)(t0 + s) * 512 + c] = f2bf(siluf_(y));
        }
    }
}

template <int I> DEV float bfel(const u32x4& v) { return (I & 1) ? bfhi(v[I >> 1]) : bflo(v[I >> 1]); }

DEV void r1_phase(const bf16_t* __restrict__ PROJ, const float2* __restrict__ rot, float* __restrict__ KVST,
                  const float* __restrict__ dec_f, const float* __restrict__ dec_b, const int S) {
    bf16_t* vT = (bf16_t*)g_lds; bf16_t* kTf = vT + 64 * 136; bf16_t* kTb = kTf + 64 * 136;
    const int tid = TIDX, bid = BIDX, wid = tid >> 6, lane = tid & 63, fr = lane & 15, fq = lane >> 4;
    const int j = tid >> 2, dq = (tid & 3) * 8;
    for (int unit = bid; unit < (TG / 128) * 8; unit += gridDim.x) {
        const int cidx = unit >> 3, h = unit & 7, t0 = cidx * 128, seq = t0 / S, pos0 = t0 - seq * S;
        const float lgf2 = -expf(dec_f[h]) * 1.4426950408889634f, lgb2 = -expf(dec_b[h]) * 1.4426950408889634f;
        __syncthreads();
        const bf16_t* pr = PROJ + (size_t)(t0 + j) * PC;
        const u32x4 k1 = *(const u32x4*)(pr + C_K + h * 64 + dq), k2 = *(const u32x4*)(pr + C_K + h * 64 + 32 + dq);
        const float2* rp = rot + (size_t)(pos0 + j) * 32 + dq;
        const float df = exp2f(lgf2 * (float)(127 - j)), db = exp2f(lgb2 * (float)j);
#pragma unroll
        for (int i = 0; i < 8; ++i) {
            const float a = (i & 1) ? bfhi(k1[i >> 1]) : bflo(k1[i >> 1]), b = (i & 1) ? bfhi(k2[i >> 1]) : bflo(k2[i >> 1]);
            const float2 cs = rp[i];
            const float r1 = (a * cs.x - b * cs.y) * 0.125f, r2 = (a * cs.y + b * cs.x) * 0.125f;
            kTf[(dq + i) * 136 + j] = f2bf(r1 * df); kTf[(32 + dq + i) * 136 + j] = f2bf(r2 * df);
            kTb[(dq + i) * 136 + j] = f2bf(r1 * db); kTb[(32 + dq + i) * 136 + j] = f2bf(r2 * db);
        }
        {
            const int e0 = (tid & 3) * 16;
            const u32x4 v1 = *(const u32x4*)(pr + C_V + h * 64 + e0), v2 = *(const u32x4*)(pr + C_V + h * 64 + e0 + 8);
#pragma unroll
            for (int i = 0; i < 4; ++i) {
                vT[(e0 + 2 * i) * 136 + j] = (bf16_t)(v1[i] & 0xffffu); vT[(e0 + 2 * i + 1) * 136 + j] = (bf16_t)(v1[i] >> 16);
                vT[(e0 + 8 + 2 * i) * 136 + j] = (bf16_t)(v2[i] & 0xffffu); vT[(e0 + 8 + 2 * i + 1) * 136 + j] = (bf16_t)(v2[i] >> 16);
            }
        }
        __syncthreads();
        const int dir = wid >> 2, et = wid & 3;
        const bf16_t* kT = dir ? kTb : kTf;
        bf16x8 a[4];
#pragma unroll
        for (int ks = 0; ks < 4; ++ks) a[ks] = *(const bf16x8*)(vT + (et * 16 + fr) * 136 + ks * 32 + fq * 8);
        float* o = KVST + ((size_t)(cidx * 8 + h) * 2 + dir) * 4096;
#pragma unroll
        for (int dt = 0; dt < 4; ++dt) {
            f32x4 acc = {0.f, 0.f, 0.f, 0.f};
#pragma unroll
            for (int ks = 0; ks < 4; ++ks) {
                const bf16x8 b = *(const bf16x8*)(kT + (dt * 16 + fr) * 136 + ks * 32 + fq * 8);
                acc = __builtin_amdgcn_mfma_f32_16x16x32_bf16(a[ks], b, acc, 0, 0, 0);
            }
#pragma unroll
            for (int jj = 0; jj < 4; ++jj) o[(et * 16 + fq * 4 + jj) * 64 + dt * 16 + fr] = acc[jj];
        }
    }
}

DEV void r2_phase(const float* __restrict__ KVST, bf16_t* __restrict__ PREV, const float* __restrict__ dec_f, const float* __restrict__ dec_b, const int S) {
    const int NC = S / 128, nseq = TG / S, total = nseq * 8 * 2 * 4096;
    const int tid0 = TIDX, bid0 = BIDX;
    for (int idx = bid0 * NTHREADS + tid0; idx < total; idx += gridDim.x * NTHREADS) {
        const int elem = idx & 4095, dir = (idx >> 12) & 1, h = (idx >> 13) & 7, seq = idx >> 16;
        const float lg = -expf((dir ? dec_b : dec_f)[h]);
        const float cd = expf(lg * 128.f);
        float st = 0.f;
#pragma unroll 8
        for (int n = 0; n < NC; ++n) {
            const int nn = dir ? NC - 1 - n : n;
            const size_t o = ((size_t)((seq * NC + nn) * 8 + h) * 2 + dir) * 4096 + elem;
            PREV[o] = f2bf(st);
            st = st * cd + KVST[o];
        }
    }
}

DEV void r3_phase(const bf16_t* __restrict__ PROJ, const float2* __restrict__ rot, const bf16_t* __restrict__ PREV, bf16_t* __restrict__ RT,
                  const float* __restrict__ dec_f, const float* __restrict__ dec_b, const float* __restrict__ gn_g, const int S) {
    bf16_t* Qs = (bf16_t*)g_lds; bf16_t* Ks = Qs + 128 * 72; bf16_t* vT = Ks + 128 * 72;
    const int tid = TIDX, bid = BIDX, wid = tid >> 6, lane = tid & 63, fr = lane & 15, fq = lane >> 4;
    const int j = tid >> 2, dq = (tid & 3) * 8;
    for (int unit = bid; unit < (TG / 128) * 8; unit += gridDim.x) {
        const int cidx = unit >> 3, h = unit & 7, t0 = cidx * 128, seq = t0 / S, pos0 = t0 - seq * S;
        const float lgf2 = -expf(dec_f[h]) * 1.4426950408889634f, lgb2 = -expf(dec_b[h]) * 1.4426950408889634f;
        __syncthreads();
        {
            const bf16_t* pr = PROJ + (size_t)(t0 + j) * PC;
            const u32x4 q1 = *(const u32x4*)(pr + C_Q + h * 64 + dq), q2 = *(const u32x4*)(pr + C_Q + h * 64 + 32 + dq);
            const u32x4 k1 = *(const u32x4*)(pr + C_K + h * 64 + dq), k2 = *(const u32x4*)(pr + C_K + h * 64 + 32 + dq);
            const float2* rp = rot + (size_t)(pos0 + j) * 32 + dq;
            u32x4 oq1, oq2, ok1, ok2;
#pragma unroll
            for (int i = 0; i < 4; ++i) {
                const float2 c0 = rp[2 * i], c1 = rp[2 * i + 1];
                const float qa0 = bflo(q1[i]), qa1 = bfhi(q1[i]), qb0 = bflo(q2[i]), qb1 = bfhi(q2[i]);
                const float ka0 = bflo(k1[i]), ka1 = bfhi(k1[i]), kb0 = bflo(k2[i]), kb1 = bfhi(k2[i]);
                oq1[i] = cvt_pk_bf16(qa0 * c0.x - qb0 * c0.y, qa1 * c1.x - qb1 * c1.y);
                oq2[i] = cvt_pk_bf16(qa0 * c0.y + qb0 * c0.x, qa1 * c1.y + qb1 * c1.x);
                ok1[i] = cvt_pk_bf16((ka0 * c0.x - kb0 * c0.y) * 0.125f, (ka1 * c1.x - kb1 * c1.y) * 0.125f);
                ok2[i] = cvt_pk_bf16((ka0 * c0.y + kb0 * c0.x) * 0.125f, (ka1 * c1.y + kb1 * c1.x) * 0.125f);
            }
            *(u32x4*)(Qs + j * 72 + dq) = oq1; *(u32x4*)(Qs + j * 72 + 32 + dq) = oq2;
            *(u32x4*)(Ks + j * 72 + dq) = ok1; *(u32x4*)(Ks + j * 72 + 32 + dq) = ok2;
            const int e0 = (tid & 3) * 16;
            const u32x4 v1 = *(const u32x4*)(pr + C_V + h * 64 + e0), v2 = *(const u32x4*)(pr + C_V + h * 64 + e0 + 8);
#pragma unroll
            for (int i = 0; i < 4; ++i) {
                vT[(e0 + 2 * i) * 136 + j] = (bf16_t)(v1[i] & 0xffffu); vT[(e0 + 2 * i + 1) * 136 + j] = (bf16_t)(v1[i] >> 16);
                vT[(e0 + 8 + 2 * i) * 136 + j] = (bf16_t)(v2[i] & 0xffffu); vT[(e0 + 8 + 2 * i + 1) * 136 + j] = (bf16_t)(v2[i] >> 16);
            }
        }
        __syncthreads();
        const int i0 = wid * 16, ii = i0 + fr;
        bf16x8 bq[2];
#pragma unroll
        for (int ks = 0; ks < 2; ++ks) bq[ks] = *(const bf16x8*)(Qs + (i0 + fr) * 72 + ks * 32 + fq * 8);
        f32x4 s[8];
#pragma unroll
        for (int jt = 0; jt < 8; ++jt) {
            s[jt] = (f32x4){0.f, 0.f, 0.f, 0.f};
#pragma unroll
            for (int ks = 0; ks < 2; ++ks) {
                const bf16x8 a = *(const bf16x8*)(Ks + (jt * 16 + fr) * 72 + ks * 32 + fq * 8);
                s[jt] = __builtin_amdgcn_mfma_f32_16x16x32_bf16(a, bq[ks], s[jt], 0, 0, 0);
            }
#pragma unroll
            for (int jj = 0; jj < 4; ++jj) {
                const int delta = ii - (jt * 16 + fq * 4 + jj);
                const float fac = delta >= 0 ? exp2f(lgf2 * (float)delta) : exp2f(lgb2 * (float)(-delta));
                s[jt][jj] *= fac;
            }
        }
        bf16x8 bp[4];
#pragma unroll
        for (int k2 = 0; k2 < 4; ++k2) {
            u32x4 w; w[0] = cvt_pk_bf16(s[2 * k2][0], s[2 * k2][1]); w[1] = cvt_pk_bf16(s[2 * k2][2], s[2 * k2][3]);
            w[2] = cvt_pk_bf16(s[2 * k2 + 1][0], s[2 * k2 + 1][1]); w[3] = cvt_pk_bf16(s[2 * k2 + 1][2], s[2 * k2 + 1][3]);
            bp[k2] = __builtin_bit_cast(bf16x8, w);
        }
        const bf16_t* pf = PREV + ((size_t)(cidx * 8 + h) * 2) * 4096;
        const bf16_t* pb = pf + 4096;
        const float qf = exp2f(lgf2 * (float)(ii + 1)), qb = exp2f(lgb2 * (float)(128 - ii));
        f32x4 o[4];
#pragma unroll
        for (int et = 0; et < 4; ++et) {
            o[et] = (f32x4){0.f, 0.f, 0.f, 0.f};
#pragma unroll
            for (int k2 = 0; k2 < 4; ++k2) {
                const u32x2 lo = *(const u32x2*)(vT + (et * 16 + fr) * 136 + (2 * k2) * 16 + fq * 4);
                const u32x2 hi = *(const u32x2*)(vT + (et * 16 + fr) * 136 + (2 * k2 + 1) * 16 + fq * 4);
                u32x4 w; w[0] = lo[0]; w[1] = lo[1]; w[2] = hi[0]; w[3] = hi[1];
                o[et] = __builtin_amdgcn_mfma_f32_16x16x32_bf16(__builtin_bit_cast(bf16x8, w), bp[k2], o[et], 0, 0, 0);
            }
            f32x4 cf = {0.f, 0.f, 0.f, 0.f}, cb = {0.f, 0.f, 0.f, 0.f};
#pragma unroll
            for (int ks = 0; ks < 2; ++ks) {
                const bf16x8 af = *(const bf16x8*)(pf + (et * 16 + fr) * 64 + ks * 32 + fq * 8);
                const bf16x8 ab = *(const bf16x8*)(pb + (et * 16 + fr) * 64 + ks * 32 + fq * 8);
                cf = __builtin_amdgcn_mfma_f32_16x16x32_bf16(af, bq[ks], cf, 0, 0, 0);
                cb = __builtin_amdgcn_mfma_f32_16x16x32_bf16(ab, bq[ks], cb, 0, 0, 0);
            }
            o[et] += cf * qf + cb * qb;
        }
        float sum = 0.f;
#pragma unroll
        for (int et = 0; et < 4; ++et) sum += (o[et][0] + o[et][1]) + (o[et][2] + o[et][3]);
        sum += __shfl_xor(sum, 16); sum += __shfl_xor(sum, 32);
        const float mu = sum * (1.f / 64.f);
        float vs = 0.f;
#pragma unroll
        for (int et = 0; et < 4; ++et) { const f32x4 d = o[et] - mu; vs += (d[0] * d[0] + d[1] * d[1]) + (d[2] * d[2] + d[3] * d[3]); }
        vs += __shfl_xor(vs, 16); vs += __shfl_xor(vs, 32);
        const float rstd = 1.0f / sqrtf(vs * (1.f / 64.f) + 1e-6f);
        const size_t tok = (size_t)(t0 + ii);
#pragma unroll
        for (int et = 0; et < 4; ++et) {
            const int e = et * 16 + fq * 4;
            const u32x2 gg = *(const u32x2*)(PROJ + tok * PC + C_G + h * 64 + e);
            const f32x4 gn = *(const f32x4*)(gn_g + h * 64 + e);
            const f32x4 y = (o[et] - mu) * rstd * gn;
            u32x2 w; w[0] = cvt_pk_bf16(siluf_(bflo(gg[0])) * y[0], siluf_(bfhi(gg[0])) * y[1]); w[1] = cvt_pk_bf16(siluf_(bflo(gg[1])) * y[2], siluf_(bfhi(gg[1])) * y[3]);
            *(u32x2*)(RT + tok * 512 + h * 64 + e) = w;
        }
    }
}

DEV int att_sw(int key) { return (key & 3) | ((key >> 1) & 12); }
DEV void attn_phase(const bf16_t* __restrict__ Q, const bf16_t* __restrict__ Kmem, const bf16_t* __restrict__ VmemT, bf16_t* __restrict__ O, const int S, const int g) {
    LAS unsigned char* lds = (LAS unsigned char*)g_lds;
    const int tid = TIDX, bid = BIDX, wid = tid >> 6, lane = tid & 63, fr = lane & 15, fq = lane >> 4;
    for (int unit = bid; unit < (TG / 256) * 4; unit += gridDim.x) {
        const int qb = unit >> 2, h = unit & 3, t0 = qb * 256, seq = t0 / S, b = (g < 2) ? g * 4 + seq : 8;
        const bf16_t* kb = Kmem + (size_t)(b * 256) * 1024 + h * 256;
        const bf16_t* vb = VmemT + ((size_t)(b * 4 + h) * 256) * 256;
        const size_t tok0 = (size_t)(t0 + wid * 16 + fr), tok1 = tok0 + 128;
        f32x4 s[2][16];
#pragma unroll
        for (int mt = 0; mt < 16; ++mt) { s[0][mt] = (f32x4){0.f, 0.f, 0.f, 0.f}; s[1][mt] = (f32x4){0.f, 0.f, 0.f, 0.f}; }
#pragma unroll 1
        for (int half = 0; half < 2; ++half) {
            __syncthreads();
#pragma unroll
            for (int i = 0; i < 8; ++i) {
                const int idx = tid + 512 * i, key = idx >> 4, ch = idx & 15;
                const u32x4 v = *(const u32x4*)(kb + (size_t)key * 1024 + half * 128 + ch * 8);
                *(LAS u32x4*)(lds + key * 256 + ((ch ^ att_sw(key)) << 4)) = v;
            }
            bf16x8 bq[2][4];
#pragma unroll
            for (int ks = 0; ks < 4; ++ks) {
                bq[0][ks] = *(const bf16x8*)(Q + tok0 * 1024 + h * 256 + half * 128 + ks * 32 + fq * 8);
                bq[1][ks] = *(const bf16x8*)(Q + tok1 * 1024 + h * 256 + half * 128 + ks * 32 + fq * 8);
            }
            __syncthreads();
#pragma unroll
            for (int mt = 0; mt < 16; ++mt) {
                const int key = 32 * (mt >> 1) + (fr >> 2) * 8 + (mt & 1) * 4 + (fr & 3);
#pragma unroll
                for (int ks = 0; ks < 4; ++ks) {
                    const bf16x8 a = *(const LAS bf16x8*)(lds + key * 256 + (((ks * 4 + fq) ^ fr) << 4));
                    s[0][mt] = __builtin_amdgcn_mfma_f32_16x16x32_bf16(a, bq[0][ks], s[0][mt], 0, 0, 0);
                    s[1][mt] = __builtin_amdgcn_mfma_f32_16x16x32_bf16(a, bq[1][ks], s[1][mt], 0, 0, 0);
                }
            }
        }
        bf16x8 bp[2][8]; float il[2];
#pragma unroll
        for (int qs = 0; qs < 2; ++qs) {
            float mx = -3.0e38f;
#pragma unroll
            for (int mt = 0; mt < 16; ++mt) mx = fmaxf(mx, fmaxf(fmaxf(s[qs][mt][0], s[qs][mt][1]), fmaxf(s[qs][mt][2], s[qs][mt][3])));
            mx = fmaxf(mx, __shfl_xor(mx, 16)); mx = fmaxf(mx, __shfl_xor(mx, 32));
            float l = 0.f;
#pragma unroll
            for (int mt = 0; mt < 16; ++mt) {
#pragma unroll
                for (int jj = 0; jj < 4; ++jj) { const float pv = __expf(s[qs][mt][jj] - mx); s[qs][mt][jj] = pv; l += pv; }
            }
            l += __shfl_xor(l, 16); l += __shfl_xor(l, 32);
            il[qs] = 1.0f / l;
#pragma unroll
            for (int k2 = 0; k2 < 8; ++k2) {
                u32x4 w; w[0] = cvt_pk_bf16(s[qs][2 * k2][0], s[qs][2 * k2][1]); w[1] = cvt_pk_bf16(s[qs][2 * k2][2], s[qs][2 * k2][3]);
                w[2] = cvt_pk_bf16(s[qs][2 * k2 + 1][0], s[qs][2 * k2 + 1][1]); w[3] = cvt_pk_bf16(s[qs][2 * k2 + 1][2], s[qs][2 * k2 + 1][3]);
                bp[qs][k2] = __builtin_bit_cast(bf16x8, w);
            }
        }
#pragma unroll 1
        for (int half = 0; half < 2; ++half) {
            __syncthreads();
#pragma unroll
            for (int i = 0; i < 8; ++i) {
                const int idx = tid + 512 * i, dd = idx >> 5, ch = idx & 31;
                const u32x4 v = *(const u32x4*)(vb + (size_t)(half * 128 + dd) * 256 + ch * 8);
                *(LAS u32x4*)(lds + dd * 512 + ((ch ^ (dd & 15)) << 4)) = v;
            }
            __syncthreads();
#pragma unroll
            for (int dt = 0; dt < 8; ++dt) {
                f32x4 o0 = {0.f, 0.f, 0.f, 0.f}, o1 = {0.f, 0.f, 0.f, 0.f};
#pragma unroll
                for (int k2 = 0; k2 < 8; ++k2) {
                    const bf16x8 a = *(const LAS bf16x8*)(lds + (dt * 16 + fr) * 512 + (((k2 * 4 + fq) ^ fr) << 4));
                    o0 = __builtin_amdgcn_mfma_f32_16x16x32_bf16(a, bp[0][k2], o0, 0, 0, 0);
                    o1 = __builtin_amdgcn_mfma_f32_16x16x32_bf16(a, bp[1][k2], o1, 0, 0, 0);
                }
                const int dcol = h * 256 + half * 128 + dt * 16 + fq * 4;
                u32x2 w; w[0] = cvt_pk_bf16(o0[0] * il[0], o0[1] * il[0]); w[1] = cvt_pk_bf16(o0[2] * il[0], o0[3] * il[0]);
                *(u32x2*)(O + tok0 * 1024 + dcol) = w;
                w[0] = cvt_pk_bf16(o1[0] * il[1], o1[1] * il[1]); w[1] = cvt_pk_bf16(o1[2] * il[1], o1[3] * il[1]);
                *(u32x2*)(O + tok1 * 1024 + dcol) = w;
            }
        }
    }
}

#define XB_TMO      128
#define XB_XCNT(j)  (256  + 64 * (j))
#define XB_XSUB(j)  (1280 + 64 * (j))
#define XB_XGEN(j)  (2304 + 64 * (j))
#define XB_TOP      3328
#define XB_TOPGEN   3392
#define XCD_BAR_WORDS 3456
#define XB_SPIN_CAP (1u << 22)
DEV unsigned xb_ld(unsigned* p)              { return __hip_atomic_load(p, __ATOMIC_RELAXED, __HIP_MEMORY_SCOPE_AGENT); }
DEV unsigned xb_add(unsigned* p, unsigned v) { return __hip_atomic_fetch_add(p, v, __ATOMIC_RELAXED, __HIP_MEMORY_SCOPE_AGENT); }
DEV unsigned xb_xcc_id() { return (unsigned)__builtin_amdgcn_s_getreg((3 << 11) | 20) & 0xFu; }
#define XB_SPIN(cond, bar) do { unsigned _sp = 0; while (cond) { __builtin_amdgcn_s_sleep(1); \
    if ((++_sp & 255u) == 0u) { if (xb_ld(&(bar)[XB_TMO])) break; if (_sp > XB_SPIN_CAP) { atomicAdd(&(bar)[XB_TMO], 1u); break; } } } } while (0)
struct XcdBarrier { unsigned* bar; unsigned x; volatile LAS unsigned* st; };
DEV XcdBarrier xcd_barrier_post(unsigned* bar, volatile LAS unsigned* st) {
    XcdBarrier b; b.bar = bar; b.x = xb_xcc_id(); b.st = st;
    if (threadIdx.x == 0) (void)xb_add(&bar[XB_XCNT(b.x)], 1u);
    return b;
}
DEV void xcd_barrier_complete(unsigned* bar, unsigned x, unsigned& nloc, unsigned& nx) {
    const unsigned G = gridDim.x * gridDim.y * gridDim.z;
    unsigned sum, cnt, mine, sp = 0u;
    for (;;) {
        sum = 0u; cnt = 0u; mine = 0u;
#pragma unroll
        for (unsigned j = 0; j < 16; ++j) { const unsigned c = xb_ld(&bar[XB_XCNT(j)]); sum += c; cnt += (c > 0u) ? 1u : 0u; mine = (j == x) ? c : mine; }
        if (sum == G) break;
        __builtin_amdgcn_s_sleep(1);
        if ((++sp & 255u) == 0u) { if (xb_ld(&bar[XB_TMO])) break; if (sp > XB_SPIN_CAP) { atomicAdd(&bar[XB_TMO], 1u); break; } }
    }
    nloc = mine > 0u ? mine : 1u; nx = cnt > 0u ? cnt : 1u;
}
DEV void xcd_barrier(const XcdBarrier& b) {
    asm volatile("s_waitcnt vmcnt(0)" ::: "memory");
    __syncthreads();
    if (threadIdx.x == 0) {
        unsigned* bar = b.bar;
        __builtin_amdgcn_s_waitcnt(0);
        unsigned nloc = b.st[0], nx = b.st[1];
        if (nloc == 0u) { xcd_barrier_complete(bar, b.x, nloc, nx); b.st[0] = nloc; b.st[1] = nx; }
        const unsigned old = xb_add(&bar[XB_XSUB(b.x)], 1u);
        const unsigned gen = old / nloc;
        if (old + 1u == (gen + 1u) * nloc) {
            __builtin_amdgcn_fence(__ATOMIC_RELEASE, "agent");
            asm volatile("s_waitcnt vmcnt(0)" ::: "memory");
            const unsigned og = xb_add(&bar[XB_TOP], 1u);
            const unsigned tg = og / nx;
            if (og + 1u == (tg + 1u) * nx) xb_add(&bar[XB_TOPGEN], 1u);
            else XB_SPIN(xb_ld(&bar[XB_TOPGEN]) == tg, bar);
            __builtin_amdgcn_fence(__ATOMIC_ACQUIRE, "agent");
            xb_add(&bar[XB_XGEN(b.x)], 1u);
            asm volatile("s_waitcnt vmcnt(0)" ::: "memory");
        } else {
            XB_SPIN(xb_ld(&bar[XB_XGEN(b.x)]) == gen, bar);
            __builtin_amdgcn_fence(__ATOMIC_ACQUIRE, "agent");
            asm volatile("s_waitcnt vmcnt(0)" ::: "memory");
        }
    }
    __syncthreads();
}

constexpr int PH_PER_GROUP = 27, N_PHASES = 2 + NGRP * PH_PER_GROUP;

DEV void run_phase(const Params& p, const int ph) {
    unsigned char* ws = p.ws;
    if (ph == 0) {
#if PROBE == 9
        setup_phase(p);
#endif
        setup_phase(p); return; }
    bf16_t* H = (bf16_t*)(ws + WS_H); bf16_t* HID = (bf16_t*)(ws + WS_HID); bf16_t* PROJ = (bf16_t*)(ws + WS_PROJ);
    bf16_t* MIXB = (bf16_t*)(ws + WS_MIXB); bf16_t* QB = (bf16_t*)(ws + WS_QB); bf16_t* OB = (bf16_t*)(ws + WS_OB);
    bf16_t* CV = (bf16_t*)(ws + WS_CV); bf16_t* RT = (bf16_t*)(ws + WS_RT);
    float* KVST = (float*)(ws + WS_KVST); bf16_t* PREV = (bf16_t*)(ws + WS_PREV);
    const float2* rot = (const float2*)(ws + WS_ROT);
    GemmDesc gd{};
    int kind = 0;
    int g = 0, l = 0, s = 0;
    if (ph == 1) {
        gd.A = (const bf16_t*)(ws + WS_MEMN); gd.Bt = (const bf16_t*)(ws + WS_WT) + O_KV; gd.M = 2 * 2304; gd.N = 2048; gd.K = 1024; gd.epi = EPI_KV;
        gd.out = ws + WS_KMEM; gd.out2 = (bf16_t*)(ws + WS_VMEMT); gd.bt_layer_stride = WL;
    } else {
        const int idx = ph - 2; g = idx / PH_PER_GROUP; const int r = idx - g * PH_PER_GROUP;
        if (r < 14) { l = 0; s = r; } else { l = 1; s = r - 13; }
    }
    const int S = (g < 2) ? 4096 : 16384;
    const bf16_t* W = (const bf16_t*)(ws + WS_WT) + (size_t)l * WL;
    const float* ng = p.in[4] + (size_t)l * 8 * 1024;
    const float* xin = (g < 2) ? p.in[0] + (size_t)g * TG * 1024 : p.in[1];
    float* OUT = p.out + (size_t)g * TG * 1024;
    float* rowss = (float*)(ws + WS_ROWSS);
    int fk = -1;
    if (ph >= 2) {
        gd.M = TG; gd.XB = H; gd.xbuf = (float*)(ws + WS_XBUF); gd.cnt = (unsigned*)(ws + WS_CNT); gd.rowss = rowss; gd.rowss_out = rowss;
        switch (s) {
        case 0: kind = 1; break;
        case 1: gd.A = H; gd.Bt = W + O_GU1; gd.N = 5632; gd.K = 1024; gd.epi = EPI_SWIGLU; gd.out = HID; break;
        case 2: gd.A = HID; gd.Bt = W + O_D1; gd.N = 1024; gd.K = 2816; gd.epi = EPI_RES; fk = 0; gd.scale = 0.5f; gd.gpost = ng + 1 * 1024; break;
        case 3: gd.A = H; gd.Bt = W + O_IN; gd.N = PC; gd.K = 1024; gd.epi = EPI_PROJ; gd.out = PROJ; gd.gate_b = p.in[17] + (size_t)l * 2048; break;
        case 4: kind = 2; break;
        case 5: kind = 3; break;
        case 6: kind = 4; break;
        case 7: gd.A = CV; gd.Bt = W + O_PW; gd.N = 1024; gd.K = 512; gd.epi = EPI_MIX; gd.out = MIXB; gd.A2 = RT; gd.Bt2 = W + O_RO; gd.K2 = 512; gd.proj = PROJ; break;
        case 8: gd.A = MIXB; gd.Bt = W + O_MIX; gd.N = 1024; gd.K = 1024; gd.epi = EPI_RES; fk = 1; gd.scale = 1.f; gd.gpost = ng + 3 * 1024; break;
        case 9: gd.A = H; gd.Bt = W + O_Q; gd.N = 1024; gd.K = 1024; gd.epi = EPI_BF16; gd.out = QB; break;
        case 10: kind = 5; break;
        case 11: gd.A = OB; gd.Bt = W + O_O; gd.N = 1024; gd.K = 1024; gd.epi = EPI_RES; fk = 2; gd.scale = 1.f; gd.gpost = ng + 5 * 1024; break;
        case 12: gd.A = H; gd.Bt = W + O_GU2; gd.N = 5632; gd.K = 1024; gd.epi = EPI_SWIGLU; gd.out = HID; break;
        default: gd.A = HID; gd.Bt = W + O_D2; gd.N = 1024; gd.K = 2816; gd.epi = EPI_RES; fk = 3; gd.scale = 0.5f; gd.gpost = ng + 7 * 1024; gd.outf = (l == 1) ? OUT : nullptr; break;
        }
        gd.expect = 4u * (unsigned)(g * 8 + l * 4 + fk + 1);
    }
    if (kind == 0) {
        switch (gd.epi) {
        case EPI_RES: gemm_phase<EPI_RES>(gd); break;
        case EPI_BF16:
#if PROBE == 12
            gemm_phase<EPI_BF16>(gd);
#endif
            gemm_phase<EPI_BF16>(gd); break;
        case EPI_SWIGLU:
#if PROBE == 6
            for (int rep = 0; rep < 2; ++rep)
#endif
            gemm_phase<EPI_SWIGLU>(gd);
#if PROBE == 10
            gemm_phase<7>(gd);
#endif
            break;
        case EPI_PROJ:
#if PROBE == 7
            for (int rep = 0; rep < 2; ++rep)
#endif
            gemm_phase<EPI_PROJ>(gd); break;
        case EPI_MIX:
#if PROBE == 13
            gemm_phase<EPI_MIX>(gd);
#endif
            gemm_phase<EPI_MIX>(gd); break;
        default: gemm_phase<EPI_KV>(gd); break;
        }
    }
    else if (kind == 1) rw0_phase(xin, H, rowss);
    else if (kind == 2) {
        conv_phase(PROJ, CV, p.in[8] + (size_t)l * 31 * 512, p.in[9] + l * 512, p.in[10] + l * 512, p.in[11] + l * 512, S);
        r1_phase(PROJ, rot, KVST, p.in[13] + l * 8, p.in[14] + l * 8, S);
    } else if (kind == 3) {
#if PROBE == 11
        r2_phase(KVST, PREV, p.in[13] + l * 8, p.in[14] + l * 8, S);
#endif
        r2_phase(KVST, PREV, p.in[13] + l * 8, p.in[14] + l * 8, S);
    }
    else if (kind == 4) r3_phase(PROJ, rot, PREV, RT, p.in[13] + l * 8, p.in[14] + l * 8, p.in[15] + l * 512, S);
    else attn_phase(QB, (const bf16_t*)(ws + WS_KMEM) + (size_t)l * 2304 * 1024, (const bf16_t*)(ws + WS_VMEMT) + (size_t)l * 2304 * 1024, OB, S, g);
}

__global__ void __launch_bounds__(NTHREADS) mega(const Params p) {
#if SINGLE_LAUNCH
    volatile LAS unsigned* st = (volatile LAS unsigned*)((LAS unsigned char*)g_lds + 131072);
    if (threadIdx.x == 0) { st[0] = 0u; st[1] = 0u; }
    __syncthreads();
    const XcdBarrier xb = xcd_barrier_post((unsigned*)(p.ws + WS_BAR), st);
#endif
    for (int ph = p.ph_begin; ph < p.ph_end; ++ph) {
        run_phase(p, ph);
#if SINGLE_LAUNCH
        if (ph + 1 < p.ph_end) {
            if (ph == 0) cg::this_grid().sync();
            else {
                xcd_barrier(xb);
#if PROBE == 1
                xcd_barrier(xb); xcd_barrier(xb);
#endif
            }
        }
#endif
    }
}

extern "C" void kernel_launch(void* const* d_in, const int* in_sizes, int n_in, void* d_out, int out_size, void* d_ws, size_t ws_size, hipStream_t stream) {
    static int grid = 0;
    if (grid == 0) {
        if (n_in != 25 || ws_size < WS_END) { fprintf(stderr, "kernel_launch: need 25 inputs and >= %zu bytes of workspace (got %d, %zu)\n", (size_t)WS_END, n_in, ws_size); grid = -1; return; }
        int dev = 0, cus = 0, per_cu = 0;
        hipGetDevice(&dev);
        hipDeviceGetAttribute(&cus, hipDeviceAttributeMultiprocessorCount, dev);
        if (hipFuncSetAttribute((const void*)mega, hipFuncAttributeMaxDynamicSharedMemorySize, LDS_BYTES) != hipSuccess) { fprintf(stderr, "kernel_launch: hipFuncSetAttribute failed\n"); grid = -1; return; }
        hipOccupancyMaxActiveBlocksPerMultiprocessor(&per_cu, (const void*)mega, NTHREADS, LDS_BYTES);
        if (per_cu < 1) per_cu = 1;
        (void)hipGetLastError();
        grid = cus * 1;
    }
    if (grid < 0) return;
    Params p{};
    for (int i = 0; i < 25; ++i) p.in[i] = (const float*)d_in[i];
    p.out = (float*)d_out; p.ws = (unsigned char*)d_ws;
    for (int i = 0; i < 32; ++i) p.inv_freq[i] = (float)pow(10000.0, -(double)i / 32.0);
#if SINGLE_LAUNCH
    p.ph_begin = 0; p.ph_end = N_PHASES;
    hipMemsetAsync((unsigned char*)d_ws + WS_BAR, 0, 16384 + 32768, stream);
    void* args[] = {&p};
    hipError_t e = hipLaunchCooperativeKernel((const void*)mega, dim3(grid), dim3(NTHREADS), args, LDS_BYTES, stream);
    if (e != hipSuccess) fprintf(stderr, "cooperative launch failed: %s (grid %d)\n", hipGetErrorString(e), grid);
#else
    for (int ph = 0; ph < N_PHASES; ++ph) {
        p.ph_begin = ph; p.ph_end = ph + 1;
        hipLaunchKernelGGL(mega, dim3(grid), dim3(NTHREADS), LDS_BYTES, stream, p);
    }
#endif
}
```

```cpp
#include <hip/hip_runtime.h>
#include <hip/hip_bf16.h>
#include <hip/hip_cooperative_groups.h>
#include <cstdio>
#include <cmath>
namespace cg = cooperative_groups;

#ifndef PROBE
#define PROBE 0
#endif
#define PROBE_MASK 0
#ifndef SINGLE_LAUNCH
#define SINGLE_LAUNCH 1
#endif

#define DEV __device__ __forceinline__
typedef unsigned short bf16_t;
typedef short bf16x8 __attribute__((ext_vector_type(8)));
typedef short bf16x4 __attribute__((ext_vector_type(4)));
typedef float f32x4 __attribute__((ext_vector_type(4)));
typedef unsigned u32x4 __attribute__((ext_vector_type(4)));
typedef unsigned u32x2 __attribute__((ext_vector_type(2)));

constexpr int TG = 16384;
constexpr int NGRP = 3;
constexpr int PC = 3072;
constexpr int C_Q = 1024, C_K = 1536, C_V = 2048, C_G = 2560, C_GC = 3072, C_GR = 4096;
constexpr int NTHREADS = 512;
constexpr int LDS_BYTES = 131072 + 16;

constexpr size_t O_GU1 = 0, O_D1 = 5767168, O_IN = 8650752, O_PW = 13893632, O_RO = 14417920, O_MIX = 14942208,
                 O_Q = 15990784, O_KV = 17039360, O_O = 19136512, O_GU2 = 20185088, O_D2 = 25952256, WL = 28835840;
constexpr size_t WS_WT = 0;
constexpr size_t WS_ROT = WS_WT + 2 * WL * 2;
constexpr size_t WS_MEMN = WS_ROT + (size_t)16384 * 32 * 8;
constexpr size_t WS_KMEM = WS_MEMN + (size_t)2 * 2304 * 1024 * 2;
constexpr size_t WS_VMEMT = WS_KMEM + (size_t)2 * 2304 * 1024 * 2;
constexpr size_t WS_H = WS_VMEMT + (size_t)2 * 2304 * 1024 * 2;
constexpr size_t WS_HID = WS_H + (size_t)TG * 1024 * 2;
constexpr size_t WS_KVST = WS_HID;
constexpr size_t WS_PREV = WS_HID + 33554432;
constexpr size_t WS_MIXB = WS_HID + 50331648;
constexpr size_t WS_PROJ = WS_HID + (size_t)TG * 2816 * 2;
constexpr size_t WS_F = WS_PROJ;
constexpr size_t WS_QB = WS_PROJ + 67108864;
constexpr size_t WS_OB = WS_PROJ + 100663296;
constexpr size_t WS_GATES = WS_PROJ + (size_t)TG * 3072 * 2;
constexpr size_t WS_CV = WS_PROJ + (size_t)TG * 5120 * 2;
constexpr size_t WS_RT = WS_CV + (size_t)TG * 512 * 2;
constexpr size_t WS_BAR = WS_RT + (size_t)TG * 512 * 2;
constexpr size_t WS_CNT = WS_BAR + 16384;
constexpr size_t WS_XBUF = WS_CNT + 32768;
constexpr size_t WS_ROWSS = WS_XBUF + 2 * 262144;
constexpr size_t WS_END = WS_ROWSS + (size_t)TG * 16;

struct Params {
    const float* in[25];
    float* out;
    unsigned char* ws;
    float inv_freq[32];
    int ph_begin, ph_end;
};

extern __shared__ __attribute__((aligned(16))) unsigned char g_lds[];

DEV unsigned cvt_pk_bf16(float lo, float hi) { unsigned r; asm("v_cvt_pk_bf16_f32 %0, %1, %2" : "=v"(r) : "v"(lo), "v"(hi)); return r; }
DEV bf16_t f2bf(float v) { return (bf16_t)(cvt_pk_bf16(v, 0.f) & 0xffffu); }
DEV float bf2f(bf16_t v) { return __uint_as_float((unsigned)v << 16); }
DEV float bflo(unsigned v) { return __uint_as_float(v << 16); }
DEV float bfhi(unsigned v) { return __uint_as_float(v & 0xffff0000u); }
DEV float sigmoidf_(float x) { return __builtin_amdgcn_rcpf(1.f + __expf(-x)); }
DEV float siluf_(float x) { return x * __builtin_amdgcn_rcpf(1.f + __expf(-x)); }
DEV float wave_sum(float v) {
#pragma unroll
    for (int o = 32; o > 0; o >>= 1) v += __shfl_xor(v, o);
    return v;
}

DEV int launder_v(int v) { asm volatile("" : "+v"(v)); return v; }
DEV int launder_s(int v) { asm volatile("" : "+s"(v)); return v; }
#define TIDX launder_v((int)threadIdx.x)
#define BIDX launder_s((int)blockIdx.x)
constexpr int BM = 256, BK = 64, HALF = 128, HT = HALF * BK, NXCD = 8, WGM_BIG = 4, WGM_SMALL = 8;
DEV int lds_byte(int r, int c) {
    int st = (r >> 4) * 2 + (c >> 5), rr = r & 15, cc = c & 31, ob = rr * 64 + cc * 2;
    return st * 1024 + (ob ^ (((ob >> 9) & 1) << 5));
}
DEV void stage_rc(int b, int& R, int& C) {
    int st = b / 1024, sb = b % 1024, swz = sb ^ (((sb >> 9) & 1) << 5);
    R = (st >> 1) * 16 + swz / 64; C = (st & 1) * 32 + (swz % 64) / 2;
}

#define LAS __attribute__((address_space(3)))
enum { EPI_F32 = 0, EPI_BF16 = 1, EPI_SWIGLU = 2, EPI_PROJ = 3, EPI_MIX = 4, EPI_KV = 5, EPI_RES = 6 };

struct GemmDesc {
    const bf16_t* A; const bf16_t* Bt; int M, N, K, epi;
    void* out;
    const bf16_t* A2; const bf16_t* Bt2; int K2;
    bf16_t* gates;
    const float* gate_b;
    bf16_t* out2;
    size_t bt_layer_stride;
    bf16_t* XB; const float* gpost; float scale; float* xbuf; unsigned* cnt; unsigned expect;
    float* rowss_out;
    float* outf;
    const float* rowss;
};

template <int EPI> DEV void gemm_phase(const GemmDesc& g) {
    LAS unsigned char* lds = (LAS unsigned char*)g_lds;
    const int tid = TIDX, wid = __builtin_amdgcn_readfirstlane(tid >> 6), lane = tid & 63, wr = wid >> 2, wc = wid & 3, fr = lane & 15, fq = lane >> 4;
    const int K = g.K, nt = K / BK;
    const int nM = g.M / BM, nN = g.N / BM, nwg = nM * nN, G = gridDim.x, cblk = BIDX;
    const bool dual = (EPI == EPI_MIX);
    const bool hsplit = (EPI == EPI_SWIGLU) && (2 * (nwg % G) == G);
    unsigned voff[2];
#pragma unroll
    for (int i = 0; i < 2; ++i) { int R, C; stage_rc(tid * 16 + i * 8192, R, C); voff[i] = (unsigned)(R * K + C) * 2u; }
    const size_t kstep = (size_t)(BK * 2), hstep = (size_t)HALF * K * 2, tstep = 2 * hstep;
    const unsigned ldsw = (unsigned)wid * 1024u;
    const int aoff = lds_byte(wr * 64 + fr, fq * 8), boff = lds_byte(wc * 32 + fr, fq * 8);
#define PG_SA(b, h) (((b) * 2 + (h)) * (HT * 2))
#define PG_SB(b, h) ((4 + (b) * 2 + (h)) * (HT * 2))
#define PG_STAGE(bufoff, gbase) do { _Pragma("unroll") for (int _i = 0; _i < 2; ++_i) \
        __builtin_amdgcn_global_load_lds((const unsigned*)((const char*)(gbase) + voff[_i]), (LAS unsigned*)(lds + (bufoff) + ldsw + _i * 8192), 16, 0, 0); } while (0)
#define PG_LDA(dst, b, h) do { _Pragma("unroll") for (int m = 0; m < 4; ++m) _Pragma("unroll") for (int k = 0; k < 2; ++k) dst[m][k] = *(const LAS bf16x8*)(lds + PG_SA(b, h) + aoff + m * 2048 + k * 1024); } while (0)
#define PG_LDB(dst, b, h) do { _Pragma("unroll") for (int n = 0; n < 2; ++n) _Pragma("unroll") for (int k = 0; k < 2; ++k) dst[n][k] = *(const LAS bf16x8*)(lds + PG_SB(b, h) + boff + n * 2048 + k * 1024); } while (0)
#define PG_MMA(ai, bj, Af, Bf) do { __builtin_amdgcn_s_setprio(1); _Pragma("unroll") for (int m = 0; m < 4; ++m) _Pragma("unroll") for (int n = 0; n < 2; ++n) _Pragma("unroll") for (int k = 0; k < 2; ++k) \
        acc[ai][bj][m][n] = __builtin_amdgcn_mfma_f32_16x16x32_bf16(Bf[n][k], Af[m][k], acc[ai][bj][m][n], 0, 0, 0); __builtin_amdgcn_s_setprio(0); } while (0)
#define PG_WAIT_V(n) asm volatile("s_waitcnt vmcnt(" #n ")" ::: "memory")
#define PG_WAIT_L(n) asm volatile("s_waitcnt lgkmcnt(" #n ")" ::: "memory")
#define PG_BAR __builtin_amdgcn_s_barrier()
#define PG_SCHED __builtin_amdgcn_sched_barrier(0)
    const int WGMv = (nN > 4) ? WGM_BIG : WGM_SMALL, wsh = (WGMv == 8) ? 3 : ((WGMv == 4) ? 2 : ((WGMv == 2) ? 1 : 0));
    const int nig = WGMv * nN, nfull = nwg / G, xq = nwg / NXCD, xr = nwg % NXCD;
    const unsigned nig_magic = 0xFFFFFFFFu / (unsigned)nig + 1u;
#define PG_NEXT(i, pm_, pn_, seg_, ok_) do { const int _ti = dual ? ((i) >> 1) : (i); seg_ = dual ? ((i) & 1) : 0; int _L = _ti * G + cblk; ok_ = _L < nwg; \
        if (hsplit) { if (_ti == nfull) { _L = nfull * G + (cblk >> 1); seg_ = 1 + (cblk & 1); ok_ = _L < nwg; } else if (_ti > nfull) ok_ = false; } \
        if (ok_) { int wgid = _L; { const int xcd = wgid % NXCD, off = wgid / NXCD; wgid = (xcd < xr ? xcd * (xq + 1) : xr * (xq + 1) + (xcd - xr) * xq) + off; } \
          const int gid = (int)__umulhi((unsigned)wgid, nig_magic), rem = wgid - gid * nig, fm = gid * WGMv, gsz = (nM - fm) < WGMv ? (nM - fm) : WGMv; \
          if (gsz == WGMv) { pm_ = fm + (rem & (WGMv - 1)); pn_ = rem >> wsh; } else { pm_ = fm + (rem % gsz); pn_ = rem / gsz; } } } while (0)
#define PG_ABASE(pm_, seg_) ((EPI == EPI_SWIGLU) ? ((const char*)g.A + (size_t)(pm_) * tstep + ((seg_) == 2 ? hstep : (size_t)0)) : ((const char*)((seg_) ? g.A2 : g.A) + (size_t)(pm_) * tstep))
#define PG_BBASE(pm_, pn_, seg_) ((const char*)((EPI != EPI_SWIGLU && (seg_)) ? g.Bt2 : g.Bt) + ((EPI == EPI_KV && (pm_) >= 9) ? g.bt_layer_stride * 2 : (size_t)0) + (size_t)(pn_) * tstep)
    int pm = 0, pn = 0, seg = 0, npm = 0, npn = 0, nseg = 0, ui = 0; bool ok;
    PG_NEXT(0, pm, pn, seg, ok);
    if (!ok) return;
    f32x4 acc[2][2][4][2];
#pragma unroll
    for (int a = 0; a < 2; ++a)
#pragma unroll
        for (int b = 0; b < 2; ++b)
#pragma unroll
            for (int m = 0; m < 4; ++m)
#pragma unroll
                for (int n = 0; n < 2; ++n) acc[a][b][m][n] = (f32x4){0.f, 0.f, 0.f, 0.f};
    bf16x8 At[4][2], B0[2][2], B1[2][2];
    const char* cA = PG_ABASE(pm, seg); const char* cB = PG_BBASE(pm, pn, seg);
    asm volatile("s_waitcnt vmcnt(0) lgkmcnt(0)" ::: "memory"); PG_BAR; PG_SCHED;
    PG_STAGE(PG_SB(0, 0), cB); PG_STAGE(PG_SA(0, 0), cA); PG_STAGE(PG_SB(0, 1), cB + hstep); PG_STAGE(PG_SA(0, 1), cA + hstep);
    if (wr == 1) PG_BAR;
    PG_WAIT_V(4); PG_BAR;
    PG_STAGE(PG_SB(1, 0), cB + kstep); PG_STAGE(PG_SA(1, 0), cA + kstep); PG_STAGE(PG_SB(1, 1), cB + hstep + kstep);
    PG_WAIT_V(6); PG_BAR;
    for (;;) {
        bool has_next; PG_NEXT(ui + 1, npm, npn, nseg, has_next);
        const char* nA = has_next ? PG_ABASE(npm, nseg) : cA; const char* nB = has_next ? PG_BBASE(npm, npn, nseg) : cB;
        const bool halfu = (EPI == EPI_SWIGLU) && (seg != 0);
        for (int t = 0; t < nt; t += 2) {
            const bool last = (t == nt - 2);
            const char* a1 = cA + (size_t)(t + 1) * kstep;
            const char* a2 = last ? nA : cA + (size_t)(t + 2) * kstep; const char* b2 = last ? nB : cB + (size_t)(t + 2) * kstep;
            const char* a3 = a2 + kstep; const char* b3 = b2 + kstep;
            PG_LDB(B0, 0, 0); PG_SCHED; PG_LDA(At, 0, 0); PG_STAGE(PG_SA(1, 1), a1 + hstep);
            PG_WAIT_L(8); PG_BAR; PG_WAIT_L(0); PG_MMA(0, 0, At, B0); PG_BAR; PG_SCHED;
            PG_LDB(B1, 0, 1); PG_STAGE(PG_SB(0, 0), b2);
            PG_BAR; PG_WAIT_L(0); PG_MMA(0, 1, At, B1); PG_BAR;
            if (!halfu) PG_LDA(At, 0, 1); PG_STAGE(PG_SA(0, 0), a2);
            PG_BAR; PG_WAIT_L(0); if (!halfu) PG_MMA(1, 0, At, B0); PG_BAR; PG_SCHED;
            PG_STAGE(PG_SB(0, 1), b2 + hstep);
            PG_WAIT_V(6); PG_BAR; if (!halfu) PG_MMA(1, 1, At, B1); PG_BAR;
            PG_LDB(B0, 1, 0); PG_SCHED; PG_LDA(At, 1, 0); PG_STAGE(PG_SA(0, 1), a2 + hstep);
            PG_WAIT_L(8); PG_BAR; PG_WAIT_L(0); PG_MMA(0, 0, At, B0); PG_BAR; PG_SCHED;
            PG_LDB(B1, 1, 1); PG_STAGE(PG_SB(1, 0), b3);
            PG_BAR; PG_WAIT_L(0); PG_MMA(0, 1, At, B1); PG_BAR;
            if (!halfu) PG_LDA(At, 1, 1); PG_STAGE(PG_SA(1, 0), a3);
            PG_BAR; PG_WAIT_L(0); if (!halfu) PG_MMA(1, 0, At, B0); PG_BAR; PG_SCHED;
            PG_STAGE(PG_SB(1, 1), b3 + hstep);
            PG_WAIT_V(6); PG_BAR; if (!halfu) PG_MMA(1, 1, At, B1); PG_BAR;
        }
        const int brow = pm * BM + ((EPI == EPI_SWIGLU && seg == 2) ? HALF : 0), bcol = pn * BM;
        const int r0 = brow + wr * 64 + fr, c0 = bcol + wc * 32 + fq * 8;
        if (EPI == EPI_RES || EPI == 7) {
            if (EPI == 7) { float q = 0.f;
#pragma unroll
                for (int ai = 0; ai < 2; ++ai)
#pragma unroll
                    for (int bj = 0; bj < 2; ++bj)
#pragma unroll
                        for (int m = 0; m < 4; ++m)
#pragma unroll
                            for (int n = 0; n < 2; ++n) q += acc[ai][bj][m][n][0] + acc[ai][bj][m][n][1] + acc[ai][bj][m][n][2] + acc[ai][bj][m][n][3];
                if (q == 1.2345e-30f) ((float*)g.xbuf)[tid] = q; }
        } else if (EPI == EPI_MIX) {
          if (seg == 0) {
#pragma unroll
            for (int ai = 0; ai < 2; ++ai)
#pragma unroll
                for (int m = 0; m < 4; ++m)
#pragma unroll
                    for (int bj = 0; bj < 2; ++bj) {
                        const size_t gi = ((((size_t)(pm * 8 + 2 * pn + bj) * 8 + wid) * 8 + (ai * 4 + m)) * 64 + lane) * 8;
                        const u32x4 rt = *(const u32x4*)(g.gates + gi);
                        f32x4 v0 = acc[ai][bj][m][0], v1 = acc[ai][bj][m][1];
                        v0[0] *= bflo(rt[0]); v0[1] *= bfhi(rt[0]); v0[2] *= bflo(rt[1]); v0[3] *= bfhi(rt[1]);
                        v1[0] *= bflo(rt[2]); v1[1] *= bfhi(rt[2]); v1[2] *= bflo(rt[3]); v1[3] *= bfhi(rt[3]);
                        acc[ai][bj][m][0] = v0; acc[ai][bj][m][1] = v1;
                    }
          } else {
#pragma unroll
            for (int ai = 0; ai < 2; ++ai)
#pragma unroll
                for (int m = 0; m < 4; ++m) {
                    const size_t row = (size_t)(r0 + ai * 128 + m * 16);
                    bf16_t* o = (bf16_t*)g.out + row * 1024 + c0;
#pragma unroll
                    for (int bj = 0; bj < 2; ++bj) {
                        const size_t gi = ((((size_t)(pm * 8 + 2 * pn + bj) * 8 + wid) * 8 + (ai * 4 + m)) * 64 + lane) * 8;
                        const u32x4 gr = *(const u32x4*)(g.gates + (size_t)TG * 1024 + gi);
                        const f32x4 v0 = acc[ai][bj][m][0], v1 = acc[ai][bj][m][1];
                        u32x4 w; w[0] = cvt_pk_bf16(v0[0] * bflo(gr[0]), v0[1] * bfhi(gr[0])); w[1] = cvt_pk_bf16(v0[2] * bflo(gr[1]), v0[3] * bfhi(gr[1]));
                        w[2] = cvt_pk_bf16(v1[0] * bflo(gr[2]), v1[1] * bfhi(gr[2])); w[3] = cvt_pk_bf16(v1[2] * bflo(gr[3]), v1[3] * bfhi(gr[3]));
                        *(u32x4*)(o + bj * 128) = w;
                    }
                }
          }
        } else if (EPI == EPI_F32) {
#pragma unroll
            for (int ai = 0; ai < 2; ++ai)
#pragma unroll
                for (int m = 0; m < 4; ++m) {
                    float* o = (float*)g.out + (size_t)(r0 + ai * 128 + m * 16) * g.N + c0;
#pragma unroll
                    for (int bj = 0; bj < 2; ++bj)
#pragma unroll
                        for (int n = 0; n < 2; ++n) *(f32x4*)(o + bj * 128 + n * 4) = acc[ai][bj][m][n];
                }
        } else if (EPI == EPI_BF16 || EPI == EPI_PROJ) {
            const bool sg = (EPI == EPI_PROJ) && (bcol >= C_GC);
#pragma unroll
            for (int ai = 0; ai < 2; ++ai)
#pragma unroll
                for (int m = 0; m < 4; ++m) {
                    const f32x4 q = *(const f32x4*)(g.rowss + (size_t)(r0 + ai * 128 + m * 16) * 4);
                    const float rs = __builtin_amdgcn_rsqf(((q[0] + q[1]) + (q[2] + q[3])) * (1.f / 1024.f) + 1e-6f);
#pragma unroll
                    for (int bj = 0; bj < 2; ++bj) { acc[ai][bj][m][0] *= rs; acc[ai][bj][m][1] *= rs; }
                }
            if (sg) {
                const int t = (bcol - C_GC) >> 8, gcol = 128 * t + wc * 32 + fq * 8;
                const f32x4 bc0 = *(const f32x4*)(g.gate_b + gcol), bc1 = *(const f32x4*)(g.gate_b + gcol + 4);
                const f32x4 br0 = *(const f32x4*)(g.gate_b + 1024 + gcol), br1 = *(const f32x4*)(g.gate_b + 1024 + gcol + 4);
#pragma unroll
                for (int ai = 0; ai < 2; ++ai)
#pragma unroll
                    for (int m = 0; m < 4; ++m) {
                        const f32x4 c0v = acc[ai][0][m][0], c1v = acc[ai][0][m][1], r0v = acc[ai][1][m][0], r1v = acc[ai][1][m][1];
                        f32x4 gr0, gr1, rt0, rt1;
#pragma unroll
                        for (int j = 0; j < 4; ++j) {
                            gr0[j] = sigmoidf_(r0v[j] + br0[j]); gr1[j] = sigmoidf_(r1v[j] + br1[j]);
                            rt0[j] = sigmoidf_(c0v[j] + bc0[j]) * __builtin_amdgcn_rcpf(gr0[j]); rt1[j] = sigmoidf_(c1v[j] + bc1[j]) * __builtin_amdgcn_rcpf(gr1[j]);
                        }
                        const size_t gi = ((((size_t)(pm * 8 + t) * 8 + wid) * 8 + (ai * 4 + m)) * 64 + lane) * 8;
                        u32x4 w; w[0] = cvt_pk_bf16(rt0[0], rt0[1]); w[1] = cvt_pk_bf16(rt0[2], rt0[3]); w[2] = cvt_pk_bf16(rt1[0], rt1[1]); w[3] = cvt_pk_bf16(rt1[2], rt1[3]);
                        *(u32x4*)(g.gates + gi) = w;
                        w[0] = cvt_pk_bf16(gr0[0], gr0[1]); w[1] = cvt_pk_bf16(gr0[2], gr0[3]); w[2] = cvt_pk_bf16(gr1[0], gr1[1]); w[3] = cvt_pk_bf16(gr1[2], gr1[3]);
                        *(u32x4*)(g.gates + (size_t)TG * 1024 + gi) = w;
                    }
            } else {
                const int ldo = (EPI == EPI_PROJ) ? PC : g.N;
#pragma unroll
                for (int ai = 0; ai < 2; ++ai)
#pragma unroll
                    for (int m = 0; m < 4; ++m) {
                        bf16_t* o = (bf16_t*)g.out + (size_t)(r0 + ai * 128 + m * 16) * ldo + c0;
#pragma unroll
                        for (int bj = 0; bj < 2; ++bj) {
                            const f32x4 v0 = acc[ai][bj][m][0], v1 = acc[ai][bj][m][1];
                            u32x4 w; w[0] = cvt_pk_bf16(v0[0], v0[1]); w[1] = cvt_pk_bf16(v0[2], v0[3]); w[2] = cvt_pk_bf16(v1[0], v1[1]); w[3] = cvt_pk_bf16(v1[2], v1[3]);
                            *(u32x4*)(o + bj * 128) = w;
                        }
                    }
            }
        } else if (EPI == EPI_SWIGLU) {
            const int hc0 = (bcol >> 1) + wc * 32 + fq * 8;
#pragma unroll
            for (int ai = 0; ai < 2; ++ai)
#pragma unroll
                for (int m = 0; m < 4; ++m) {
                    if (halfu && ai == 1) continue;
                    const f32x4 q = *(const f32x4*)(g.rowss + (size_t)(r0 + ai * 128 + m * 16) * 4);
                    const float rs = __builtin_amdgcn_rsqf(((q[0] + q[1]) + (q[2] + q[3])) * (1.f / 1024.f) + 1e-6f);
#pragma unroll
                    for (int bj = 0; bj < 2; ++bj) { acc[ai][bj][m][0] *= rs; acc[ai][bj][m][1] *= rs; }
                }
#pragma unroll
            for (int ai = 0; ai < 2; ++ai)
#pragma unroll
                for (int m = 0; m < 4; ++m) {
                    if (halfu && ai == 1) continue;
                    bf16_t* o = (bf16_t*)g.out + (size_t)(r0 + ai * 128 + m * 16) * (g.N >> 1) + hc0;
                    const f32x4 g0 = acc[ai][0][m][0], g1 = acc[ai][0][m][1], u0 = acc[ai][1][m][0], u1 = acc[ai][1][m][1];
                    u32x4 w; w[0] = cvt_pk_bf16(siluf_(g0[0]) * u0[0], siluf_(g0[1]) * u0[1]); w[1] = cvt_pk_bf16(siluf_(g0[2]) * u0[2], siluf_(g0[3]) * u0[3]);
                    w[2] = cvt_pk_bf16(siluf_(g1[0]) * u1[0], siluf_(g1[1]) * u1[1]); w[3] = cvt_pk_bf16(siluf_(g1[2]) * u1[2], siluf_(g1[3]) * u1[3]);
                    *(u32x4*)o = w;
                }
        } else {
#pragma unroll
            for (int ai = 0; ai < 2; ++ai)
#pragma unroll
                for (int m = 0; m < 4; ++m) {
                    const int row = r0 + ai * 128 + m * 16;
#pragma unroll
                    for (int bj = 0; bj < 2; ++bj) {
                        const f32x4 v0 = acc[ai][bj][m][0], v1 = acc[ai][bj][m][1];
                        const int col = c0 + bj * 128;
                        if (bcol < 1024) {
                            u32x4 w; w[0] = cvt_pk_bf16(v0[0], v0[1]); w[1] = cvt_pk_bf16(v0[2], v0[3]); w[2] = cvt_pk_bf16(v1[0], v1[1]); w[3] = cvt_pk_bf16(v1[2], v1[3]);
                            *(u32x4*)((bf16_t*)g.out + (size_t)row * 1024 + col) = w;
                        } else {
                            const int hh = (col - 1024) >> 8, d = (col - 1024) & 255, lb = row >> 8, mm = row & 255;
                            bf16_t* o = g.out2 + ((size_t)(lb * 4 + hh) * 256 + d) * 256 + mm;
#pragma unroll
                            for (int j = 0; j < 4; ++j) { o[j * 256] = f2bf(v0[j]); o[(j + 4) * 256] = f2bf(v1[j]); }
                        }
                    }
                }
        }
        if (!has_next) break;
        if (!(dual && seg == 0)) {
#pragma unroll
            for (int a = 0; a < 2; ++a)
#pragma unroll
                for (int b = 0; b < 2; ++b)
#pragma unroll
                    for (int m = 0; m < 4; ++m)
#pragma unroll
                        for (int n = 0; n < 2; ++n) acc[a][b][m][n] = (f32x4){0.f, 0.f, 0.f, 0.f};
        }
        pm = npm; pn = npn; seg = nseg; cA = nA; cB = nB; ++ui;
    }
    PG_WAIT_V(0);
    if (wr == 0) PG_BAR;
    PG_BAR;
    if (EPI == EPI_RES) {
        LAS float* P = (LAS float*)lds;
        LAS float* Sr = (LAS float*)(lds + 4096);
        const int brow = pm * BM, bcol = pn * BM;
        const int r0 = brow + wr * 64 + fr, c0 = bcol + wc * 32 + fq * 8, lr0 = wr * 64 + fr;
#pragma unroll
        for (int ai = 0; ai < 2; ++ai)
#pragma unroll
            for (int m = 0; m < 4; ++m) {
                float q = 0.f;
#pragma unroll
                for (int bj = 0; bj < 2; ++bj)
#pragma unroll
                    for (int n = 0; n < 2; ++n) { const f32x4 v = acc[ai][bj][m][n]; q += (v[0] * v[0] + v[1] * v[1]) + (v[2] * v[2] + v[3] * v[3]); }
                q += __shfl_xor(q, 16); q += __shfl_xor(q, 32);
                if (fq == 0) P[(ai * 128 + lr0 + m * 16) * 4 + wc] = q;
            }
        __syncthreads();
        unsigned* xb = (unsigned*)g.xbuf + (size_t)pm * 1024;
        unsigned* cn = g.cnt + (size_t)pm * 64;
        if (tid < 256) {
            const float tot = (P[tid * 4] + P[tid * 4 + 1]) + (P[tid * 4 + 2] + P[tid * 4 + 3]);
            __hip_atomic_store(xb + tid * 4 + pn, __float_as_uint(tot), __ATOMIC_RELAXED, __HIP_MEMORY_SCOPE_AGENT);
        }
        asm volatile("s_waitcnt vmcnt(0)" ::: "memory");
        __syncthreads();
        if (tid == 0) {
            (void)__hip_atomic_fetch_add(cn, 1u, __ATOMIC_RELAXED, __HIP_MEMORY_SCOPE_AGENT);
            unsigned sp = 0;
            while (__hip_atomic_load(cn, __ATOMIC_RELAXED, __HIP_MEMORY_SCOPE_AGENT) < g.expect) { __builtin_amdgcn_s_sleep(1); if (++sp > (1u << 22)) break; }
        }
        __syncthreads();
        if (tid < 256) {
            unsigned* xu = xb + tid * 4;
            const float t0 = __uint_as_float(__hip_atomic_load(xu + 0, __ATOMIC_RELAXED, __HIP_MEMORY_SCOPE_AGENT)), t1 = __uint_as_float(__hip_atomic_load(xu + 1, __ATOMIC_RELAXED, __HIP_MEMORY_SCOPE_AGENT));
            const float t2 = __uint_as_float(__hip_atomic_load(xu + 2, __ATOMIC_RELAXED, __HIP_MEMORY_SCOPE_AGENT)), t3 = __uint_as_float(__hip_atomic_load(xu + 3, __ATOMIC_RELAXED, __HIP_MEMORY_SCOPE_AGENT));
            Sr[tid] = g.scale / sqrtf(((t0 + t1) + (t2 + t3)) * (1.f / 1024.f) + 1e-6f);
        }
        __syncthreads();
        f32x4 gp[2][2];
#pragma unroll
        for (int bj = 0; bj < 2; ++bj)
#pragma unroll
            for (int n = 0; n < 2; ++n) gp[bj][n] = *(const f32x4*)(g.gpost + c0 + bj * 128 + n * 4);
        const bool fin = (g.outf != nullptr);
#pragma unroll
        for (int ai = 0; ai < 2; ++ai)
#pragma unroll
            for (int m = 0; m < 4; ++m) {
                const float av = Sr[ai * 128 + lr0 + m * 16];
                bf16_t* xr = g.XB + (size_t)(r0 + ai * 128 + m * 16) * 1024 + c0;
                float q = 0.f;
#pragma unroll
                for (int bj = 0; bj < 2; ++bj) {
                    const u32x4 xw = *(const u32x4*)(xr + bj * 128);
                    f32x4 v0 = acc[ai][bj][m][0] * av * gp[bj][0], v1 = acc[ai][bj][m][1] * av * gp[bj][1];
                    v0[0] += bflo(xw[0]); v0[1] += bfhi(xw[0]); v0[2] += bflo(xw[1]); v0[3] += bfhi(xw[1]);
                    v1[0] += bflo(xw[2]); v1[1] += bfhi(xw[2]); v1[2] += bflo(xw[3]); v1[3] += bfhi(xw[3]);
                    q += ((v0[0] * v0[0] + v0[1] * v0[1]) + (v0[2] * v0[2] + v0[3] * v0[3])) + ((v1[0] * v1[0] + v1[1] * v1[1]) + (v1[2] * v1[2] + v1[3] * v1[3]));
                    if (fin) {
                        float* orow = g.outf + (size_t)(r0 + ai * 128 + m * 16) * 1024 + c0 + bj * 128;
                        *(f32x4*)orow = v0; *(f32x4*)(orow + 4) = v1;
                    } else {
                        u32x4 w; w[0] = cvt_pk_bf16(v0[0], v0[1]); w[1] = cvt_pk_bf16(v0[2], v0[3]); w[2] = cvt_pk_bf16(v1[0], v1[1]); w[3] = cvt_pk_bf16(v1[2], v1[3]);
                        *(u32x4*)(xr + bj * 128) = w;
                    }
                }
                q += __shfl_xor(q, 16); q += __shfl_xor(q, 32);
                if (fq == 0) P[(ai * 128 + lr0 + m * 16) * 4 + wc] = q;
            }
        __syncthreads();
        if (tid < 256) g.rowss_out[(size_t)(brow + tid) * 4 + pn] = (P[tid * 4] + P[tid * 4 + 1]) + (P[tid * 4 + 2] + P[tid * 4 + 3]);
    }
#undef PG_SA
#undef PG_SB
#undef PG_STAGE
#undef PG_LDA
#undef PG_LDB
#undef PG_MMA
#undef PG_NEXT
#undef PG_ABASE
#undef PG_BBASE
}

DEV void transpose_mat(const float* __restrict__ src, const int K, const int N, bf16_t* __restrict__ dst, const int perm, const float scale, const float* __restrict__ kscale) {
    float* tile = (float*)g_lds;
    const int nkt = K / 64, ntile = nkt * (N / 64), tid = TIDX, bid = BIDX;
    for (int t = bid; t < ntile; t += gridDim.x) {
        const int rt = t / nkt, kt = t - rt * nkt, rho0 = rt * 64;
        const int rg = rho0 - 3072;
        const int cbase = (perm == 1) ? (((rho0 & 255) >> 7) * 2816 + (rho0 >> 8) * 128 + (rho0 & 127)) : ((perm == 2 && rg >= 0) ? (3072 + ((rg & 255) >> 7) * 1024 + (rg >> 8) * 128 + (rg & 127)) : rho0);
        __syncthreads();
#pragma unroll
        for (int i = 0; i < 8; ++i) { const int kk = (tid >> 6) + 8 * i, cc = tid & 63; tile[kk * 65 + cc] = src[(size_t)(kt * 64 + kk) * N + cbase + cc] * (kscale ? kscale[kt * 64 + kk] : 1.0f); }
        __syncthreads();
#pragma unroll
        for (int i = 0; i < 4; ++i) {
            const int rr = (tid >> 5) + 16 * i, k2 = (tid & 31) * 2;
            const int r32 = rr & 31, cc = (rr & 32) + 8 * ((r32 & 15) >> 2) + 4 * (r32 >> 4) + (r32 & 3);
            *(unsigned*)(dst + (size_t)(rho0 + rr) * K + kt * 64 + k2) = cvt_pk_bf16(tile[k2 * 65 + cc] * scale, tile[(k2 + 1) * 65 + cc] * scale);
        }
    }
}

DEV void setup_phase(const Params& p) {
    bf16_t* wt = (bf16_t*)(p.ws + WS_WT);
    for (int l = 0; l < 2; ++l) {
        bf16_t* w = wt + (size_t)l * WL;
        const float* ngl = p.in[4] + (size_t)l * 8 * 1024;
        transpose_mat(p.in[5] + (size_t)l * 1024 * 5632, 1024, 5632, w + O_GU1, 1, 1.f, ngl + 0 * 1024);
        transpose_mat(p.in[6] + (size_t)l * 2816 * 1024, 2816, 1024, w + O_D1, 0, 1.f, nullptr);
        transpose_mat(p.in[7] + (size_t)l * 1024 * 5120, 1024, 5120, w + O_IN, 2, 1.f, ngl + 2 * 1024);
        transpose_mat(p.in[12] + (size_t)l * 512 * 1024, 512, 1024, w + O_PW, 0, 1.f, nullptr);
        transpose_mat(p.in[16] + (size_t)l * 512 * 1024, 512, 1024, w + O_RO, 0, 1.f, nullptr);
        transpose_mat(p.in[18] + (size_t)l * 1024 * 1024, 1024, 1024, w + O_MIX, 0, 1.f, nullptr);
        transpose_mat(p.in[20] + (size_t)l * 1024 * 1024, 1024, 1024, w + O_Q, 0, 0.0625f, ngl + 4 * 1024);
        transpose_mat(p.in[21] + (size_t)l * 1024 * 2048, 1024, 2048, w + O_KV, 0, 1.f, nullptr);
        transpose_mat(p.in[22] + (size_t)l * 1024 * 1024, 1024, 1024, w + O_O, 0, 1.f, nullptr);
        transpose_mat(p.in[23] + (size_t)l * 1024 * 5632, 1024, 5632, w + O_GU2, 1, 1.f, ngl + 6 * 1024);
        transpose_mat(p.in[24] + (size_t)l * 2816 * 1024, 2816, 1024, w + O_D2, 0, 1.f, nullptr);
    }
    float2* rot = (float2*)(p.ws + WS_ROT);
    const int tid0 = TIDX, bid0 = BIDX;
    for (int idx = bid0 * NTHREADS + tid0; idx < 16384 * 32; idx += gridDim.x * NTHREADS) {
        const int pos = idx >> 5, i = idx & 31;
        const float ang = (float)pos * p.inv_freq[i];
        double rev = (double)ang * 0.15915494309189535;
        rev -= floor(rev);
        const float fr = (float)rev;
        rot[idx] = make_float2(__builtin_amdgcn_cosf(fr), __builtin_amdgcn_sinf(fr));
    }
    bf16_t* memn = (bf16_t*)(p.ws + WS_MEMN);
    const int lane = tid0 & 63, gw = bid0 * 8 + (tid0 >> 6), nw = gridDim.x * 8;
    for (int rr = gw; rr < 2 * 2304; rr += nw) {
        const int l = rr / 2304, row = rr - l * 2304;
        const float* src = row < 2048 ? p.in[2] + (size_t)row * 1024 : p.in[3] + (size_t)(row - 2048) * 1024;
        const float* mg = p.in[19] + l * 1024;
        f32x4 x[4]; float ss = 0.f;
#pragma unroll
        for (int i = 0; i < 4; ++i) { x[i] = *(const f32x4*)(src + i * 256 + lane * 4); ss += x[i][0] * x[i][0] + x[i][1] * x[i][1] + x[i][2] * x[i][2] + x[i][3] * x[i][3]; }
        ss = wave_sum(ss);
        const float r = 1.0f / sqrtf(ss * (1.f / 1024.f) + 1e-6f);
#pragma unroll
        for (int i = 0; i < 4; ++i) {
            const f32x4 gg = *(const f32x4*)(mg + i * 256 + lane * 4);
            u32x2 w; w[0] = cvt_pk_bf16(x[i][0] * r * gg[0], x[i][1] * r * gg[1]); w[1] = cvt_pk_bf16(x[i][2] * r * gg[2], x[i][3] * r * gg[3]);
            *(u32x2*)(memn + (size_t)rr * 1024 + i * 256 + lane * 4) = w;
        }
    }
}

DEV void rw0_phase(const float* __restrict__ Xsrc, bf16_t* __restrict__ XB, float* __restrict__ rowss) {
    const int tid0 = TIDX, bid0 = BIDX;
    const int lane = tid0 & 63, gw = bid0 * 8 + (tid0 >> 6), nw = gridDim.x * 8;
    for (int row = gw; row < TG; row += nw) {
        f32x4 x[4]; float ss = 0.f;
#pragma unroll
        for (int i = 0; i < 4; ++i) { x[i] = *(const f32x4*)(Xsrc + (size_t)row * 1024 + i * 256 + lane * 4); ss += x[i][0] * x[i][0] + x[i][1] * x[i][1] + x[i][2] * x[i][2] + x[i][3] * x[i][3]; }
        ss = wave_sum(ss);
#pragma unroll
        for (int i = 0; i < 4; ++i) {
            u32x2 w; w[0] = cvt_pk_bf16(x[i][0], x[i][1]); w[1] = cvt_pk_bf16(x[i][2], x[i][3]);
            *(u32x2*)(XB + (size_t)row * 1024 + i * 256 + lane * 4) = w;
        }
        if (lane == 0) *(f32x4*)(rowss + (size_t)row * 4) = (f32x4){ss, 0.f, 0.f, 0.f};
    }
}

typedef float f32x2 __attribute__((ext_vector_type(2)));
DEV void conv_phase(const bf16_t* __restrict__ PROJ, bf16_t* __restrict__ CV, const float* __restrict__ dw_w, const float* __restrict__ dw_b,
                    const float* __restrict__ ln_g, const float* __restrict__ ln_b, const int S) {
    bf16_t* us = (bf16_t*)g_lds;
    float* red = (float*)(g_lds + 62 * 512 * 2);
    float* stat = red + 4 * 32 * 2;
    const int tid = TIDX, bid = BIDX, wid = tid >> 6, lane = tid & 63;
    const int c2 = (tid & 255) * 2, th = tid >> 8;
    f32x2 w2[31];
#pragma unroll
    for (int k = 0; k < 31; ++k) w2[k] = *(const f32x2*)(dw_w + k * 512 + c2);
    const f32x2 bias2 = *(const f32x2*)(dw_b + c2), lg2 = *(const f32x2*)(ln_g + c2), lb2 = *(const f32x2*)(ln_b + c2);
    for (int u = bid; u < TG / 32; u += gridDim.x) {
        const int t0 = u * 32, seq = t0 / S, pos0 = t0 - seq * S;
        __syncthreads();
        const int cg8 = (tid & 63) * 8;
#pragma unroll
        for (int it = 0; it < 8; ++it) {
            const int tt = it * 8 + (tid >> 6);
            if (tt < 62) {
                const int pos = pos0 - 15 + tt;
                u32x4 o = {0u, 0u, 0u, 0u};
                if (pos >= 0 && pos < S) {
                    const bf16_t* pr = PROJ + (size_t)(seq * S + pos) * PC;
                    const u32x4 v = *(const u32x4*)(pr + cg8), gt = *(const u32x4*)(pr + 512 + cg8);
#pragma unroll
                    for (int q = 0; q < 4; ++q) o[q] = cvt_pk_bf16(bflo(v[q]) * sigmoidf_(bflo(gt[q])), bfhi(v[q]) * sigmoidf_(bfhi(gt[q])));
                }
                *(u32x4*)(us + tt * 512 + cg8) = o;
            }
        }
        __syncthreads();
        f32x2 acc[16];
#pragma unroll
        for (int s2 = 0; s2 < 16; ++s2) acc[s2] = bias2;
#pragma unroll
        for (int kk = 0; kk < 46; ++kk) {
            const unsigned raw = *(const unsigned*)(us + (th * 16 + kk) * 512 + c2);
            const f32x2 uv = {bflo(raw), bfhi(raw)};
#pragma unroll
            for (int s2 = 0; s2 < 16; ++s2) { const int k = kk - s2; if (k >= 0 && k < 31) acc[s2] += w2[k] * uv; }
        }
#pragma unroll
        for (int s2 = 0; s2 < 16; ++s2) {
            const float s1 = wave_sum(acc[s2][0] + acc[s2][1]), sq = wave_sum(acc[s2][0] * acc[s2][0] + acc[s2][1] * acc[s2][1]);
            if (lane == 0) { red[((wid & 3) * 32 + th * 16 + s2) * 2] = s1; red[((wid & 3) * 32 + th * 16 + s2) * 2 + 1] = sq; }
        }
        __syncthreads();
        if (tid < 32) {
            float s1 = 0.f, sq = 0.f;
#pragma unroll
            for (int q = 0; q < 4; ++q) { s1 += red[(q * 32 + tid) * 2]; sq += red[(q * 32 + tid) * 2 + 1]; }
            const float mean = s1 * (1.f / 512.f), var = fmaxf(sq * (1.f / 512.f) - mean * mean, 0.f);
            stat[tid * 2] = mean; stat[tid * 2 + 1] = 1.0f / sqrtf(var + 1e-6f);
        }
        __syncthreads();
#pragma unroll
        for (int s2 = 0; s2 < 16; ++s2) {
            const float mean = stat[(th * 16 + s2) * 2], rstd = stat[(th * 16 + s2) * 2 + 1];
            const float y0 = (acc[s2][0] - mean) * rstd * lg2[0] + lb2[0], y1 = (acc[s2][1] - mean) * rstd * lg2[1] + lb2[1];
            *(unsigned*)(CV + (size_t)(t0 + th * 16 + s2) * 512 + c2) = cvt_pk_bf16(siluf_(y0), siluf_(y1));
        }
    }
}

template <int I> DEV float bfel(const u32x4& v) { return (I & 1) ? bfhi(v[I >> 1]) : bflo(v[I >> 1]); }

DEV void r1_phase(const bf16_t* __restrict__ PROJ, const float2* __restrict__ rot, float* __restrict__ KVST,
                  const float* __restrict__ dec_f, const float* __restrict__ dec_b, const int S) {
    bf16_t* vT = (bf16_t*)g_lds; bf16_t* kTf = vT + 64 * 136; bf16_t* kTb = kTf + 64 * 136;
    const int tid = TIDX, bid = BIDX, wid = tid >> 6, lane = tid & 63, fr = lane & 15, fq = lane >> 4;
    const int j = tid >> 2, js = j ^ ((tid & 3) << 4), dq = (tid & 3) * 8, e0 = (tid & 3) * 16;
    const int nunits = (TG / 128) * 8;
    u32x4 k1, k2, v1, v2; f32x4 rc[4];
    if (bid < nunits) {
        const int cidx = bid >> 3, h = bid & 7, t0 = cidx * 128, seq = t0 / S, pos0 = t0 - seq * S;
        const bf16_t* pr = PROJ + (size_t)(t0 + j) * PC;
        k1 = *(const u32x4*)(pr + C_K + h * 64 + dq); k2 = *(const u32x4*)(pr + C_K + h * 64 + 32 + dq);
        v1 = *(const u32x4*)(pr + C_V + h * 64 + e0); v2 = *(const u32x4*)(pr + C_V + h * 64 + e0 + 8);
        const f32x4* rp = (const f32x4*)(rot + (size_t)(pos0 + j) * 32 + dq);
#pragma unroll
        for (int i = 0; i < 4; ++i) rc[i] = rp[i];
    }
    for (int unit = bid; unit < nunits; unit += gridDim.x) {
        const int cidx = unit >> 3, h = unit & 7;
        const float lgf2 = -expf(dec_f[h]) * 1.4426950408889634f, lgb2 = -expf(dec_b[h]) * 1.4426950408889634f;
        __syncthreads();
        const float df = __builtin_amdgcn_exp2f(lgf2 * (float)(127 - j)), db = __builtin_amdgcn_exp2f(lgb2 * (float)j);
#pragma unroll
        for (int i = 0; i < 8; ++i) {
            const float a = (i & 1) ? bfhi(k1[i >> 1]) : bflo(k1[i >> 1]), b = (i & 1) ? bfhi(k2[i >> 1]) : bflo(k2[i >> 1]);
            const float cx = rc[i >> 1][(i & 1) * 2], cy = rc[i >> 1][(i & 1) * 2 + 1];
            const float r1 = (a * cx - b * cy) * 0.125f, r2 = (a * cy + b * cx) * 0.125f;
            kTf[(dq + i) * 136 + js] = f2bf(r1 * df); kTf[(32 + dq + i) * 136 + js] = f2bf(r2 * df);
            kTb[(dq + i) * 136 + js] = f2bf(r1 * db); kTb[(32 + dq + i) * 136 + js] = f2bf(r2 * db);
        }
#pragma unroll
        for (int i = 0; i < 4; ++i) {
            vT[(e0 + 2 * i) * 136 + js] = (bf16_t)(v1[i] & 0xffffu); vT[(e0 + 2 * i + 1) * 136 + js] = (bf16_t)(v1[i] >> 16);
            vT[(e0 + 8 + 2 * i) * 136 + js] = (bf16_t)(v2[i] & 0xffffu); vT[(e0 + 8 + 2 * i + 1) * 136 + js] = (bf16_t)(v2[i] >> 16);
        }
        {
            const int un = unit + gridDim.x;
            if (un < nunits) {
                const int cn = un >> 3, hn = un & 7, t0n = cn * 128, seqn = t0n / S, pos0n = t0n - seqn * S;
                const bf16_t* pr = PROJ + (size_t)(t0n + j) * PC;
                k1 = *(const u32x4*)(pr + C_K + hn * 64 + dq); k2 = *(const u32x4*)(pr + C_K + hn * 64 + 32 + dq);
                v1 = *(const u32x4*)(pr + C_V + hn * 64 + e0); v2 = *(const u32x4*)(pr + C_V + hn * 64 + e0 + 8);
                const f32x4* rp = (const f32x4*)(rot + (size_t)(pos0n + j) * 32 + dq);
#pragma unroll
                for (int i = 0; i < 4; ++i) rc[i] = rp[i];
            }
        }
        __syncthreads();
        const int dir = wid >> 2, et = wid & 3;
        const bf16_t* kT = dir ? kTb : kTf;
        bf16x8 a[4];
#pragma unroll
        for (int ks = 0; ks < 4; ++ks) a[ks] = *(const bf16x8*)(vT + (et * 16 + fr) * 136 + ((ks * 32 + fq * 8) ^ (et << 4)));
        float* o = KVST + ((size_t)(cidx * 8 + h) * 2 + dir) * 4096;
#pragma unroll
        for (int dt = 0; dt < 4; ++dt) {
            f32x4 acc = {0.f, 0.f, 0.f, 0.f};
#pragma unroll
            for (int ks = 0; ks < 4; ++ks) {
                const bf16x8 b = *(const bf16x8*)(kT + (dt * 16 + fr) * 136 + ((ks * 32 + fq * 8) ^ ((((dt * 16 + fr) >> 3) & 3) << 4)));
                acc = __builtin_amdgcn_mfma_f32_16x16x32_bf16(a[ks], b, acc, 0, 0, 0);
            }
#pragma unroll
            for (int jj = 0; jj < 4; ++jj) o[(et * 16 + fq * 4 + jj) * 64 + dt * 16 + fr] = acc[jj];
        }
    }
}

DEV void r2_phase(const float* __restrict__ KVST, bf16_t* __restrict__ PREV, const float* __restrict__ dec_f, const float* __restrict__ dec_b, const int S) {
    const int NC = S / 128, nseq = TG / S, total = nseq * 8 * 2 * 4096;
    const int tid0 = TIDX, bid0 = BIDX;
    for (int idx = bid0 * NTHREADS + tid0; idx < total; idx += gridDim.x * NTHREADS) {
        const int elem = idx & 4095, dir = (idx >> 12) & 1, h = (idx >> 13) & 7, seq = idx >> 16;
        const float lg = -expf((dir ? dec_b : dec_f)[h]);
        const float cd = expf(lg * 128.f);
        float st = 0.f;
        const size_t cstride = (size_t)8 * 2 * 4096;
        const size_t base = ((size_t)(seq * NC) * 8 + h) * 2 * 4096 + (size_t)dir * 4096 + elem;
#pragma unroll 1
        for (int n0 = 0; n0 < NC; n0 += 32) {
            float kv[32];
#pragma unroll
            for (int i = 0; i < 32; ++i) { const int nn = dir ? NC - 1 - (n0 + i) : n0 + i; kv[i] = KVST[base + (size_t)nn * cstride]; }
#pragma unroll
            for (int i = 0; i < 32; ++i) { const int nn = dir ? NC - 1 - (n0 + i) : n0 + i; PREV[base + (size_t)nn * cstride] = f2bf(st); st = st * cd + kv[i]; }
        }
    }
}

DEV void r3_phase(const bf16_t* __restrict__ PROJ, const float2* __restrict__ rot, const bf16_t* __restrict__ PREV, bf16_t* __restrict__ RT,
                  const float* __restrict__ dec_f, const float* __restrict__ dec_b, const float* __restrict__ gn_g, const int S) {
    bf16_t* Qs = (bf16_t*)g_lds; bf16_t* Ks = Qs + 128 * 72; bf16_t* vT = Ks + 128 * 72;
    const int tid = TIDX, bid = BIDX, wid = tid >> 6, lane = tid & 63, fr = lane & 15, fq = lane >> 4;
    const int j = tid >> 2, js = j ^ ((tid & 3) << 4), dq = (tid & 3) * 8;
    for (int unit = bid; unit < (TG / 128) * 8; unit += gridDim.x) {
        const int cidx = unit >> 3, h = unit & 7, t0 = cidx * 128, seq = t0 / S, pos0 = t0 - seq * S;
        const float lgf2 = -expf(dec_f[h]) * 1.4426950408889634f, lgb2 = -expf(dec_b[h]) * 1.4426950408889634f;
        const bf16_t* pf = PREV + ((size_t)(cidx * 8 + h) * 2) * 4096;
        const bf16_t* pb = pf + 4096;
        bf16x8 paf[4][2], pab[4][2]; u32x2 ggv[4];
#pragma unroll
        for (int et = 0; et < 4; ++et) {
#pragma unroll
            for (int ks = 0; ks < 2; ++ks) {
                paf[et][ks] = *(const bf16x8*)(pf + (et * 16 + fr) * 64 + ks * 32 + fq * 8);
                pab[et][ks] = *(const bf16x8*)(pb + (et * 16 + fr) * 64 + ks * 32 + fq * 8);
            }
            ggv[et] = *(const u32x2*)(PROJ + (size_t)(t0 + wid * 16 + fr) * PC + C_G + h * 64 + et * 16 + fq * 4);
        }
        __syncthreads();
        {
            const bf16_t* pr = PROJ + (size_t)(t0 + j) * PC;
            const u32x4 q1 = *(const u32x4*)(pr + C_Q + h * 64 + dq), q2 = *(const u32x4*)(pr + C_Q + h * 64 + 32 + dq);
            const u32x4 k1 = *(const u32x4*)(pr + C_K + h * 64 + dq), k2 = *(const u32x4*)(pr + C_K + h * 64 + 32 + dq);
            const float2* rp = rot + (size_t)(pos0 + j) * 32 + dq;
            u32x4 oq1, oq2, ok1, ok2;
#pragma unroll
            for (int i = 0; i < 4; ++i) {
                const float2 c0 = rp[2 * i], c1 = rp[2 * i + 1];
                const float qa0 = bflo(q1[i]), qa1 = bfhi(q1[i]), qb0 = bflo(q2[i]), qb1 = bfhi(q2[i]);
                const float ka0 = bflo(k1[i]), ka1 = bfhi(k1[i]), kb0 = bflo(k2[i]), kb1 = bfhi(k2[i]);
                oq1[i] = cvt_pk_bf16(qa0 * c0.x - qb0 * c0.y, qa1 * c1.x - qb1 * c1.y);
                oq2[i] = cvt_pk_bf16(qa0 * c0.y + qb0 * c0.x, qa1 * c1.y + qb1 * c1.x);
                ok1[i] = cvt_pk_bf16((ka0 * c0.x - kb0 * c0.y) * 0.125f, (ka1 * c1.x - kb1 * c1.y) * 0.125f);
                ok2[i] = cvt_pk_bf16((ka0 * c0.y + kb0 * c0.x) * 0.125f, (ka1 * c1.y + kb1 * c1.x) * 0.125f);
            }
            *(u32x4*)(Qs + j * 72 + dq) = oq1; *(u32x4*)(Qs + j * 72 + 32 + dq) = oq2;
            *(u32x4*)(Ks + j * 72 + dq) = ok1; *(u32x4*)(Ks + j * 72 + 32 + dq) = ok2;
            const int e0 = (tid & 3) * 16;
            const u32x4 v1 = *(const u32x4*)(pr + C_V + h * 64 + e0), v2 = *(const u32x4*)(pr + C_V + h * 64 + e0 + 8);
#pragma unroll
            for (int i = 0; i < 4; ++i) {
                vT[(e0 + 2 * i) * 136 + js] = (bf16_t)(v1[i] & 0xffffu); vT[(e0 + 2 * i + 1) * 136 + js] = (bf16_t)(v1[i] >> 16);
                vT[(e0 + 8 + 2 * i) * 136 + js] = (bf16_t)(v2[i] & 0xffffu); vT[(e0 + 8 + 2 * i + 1) * 136 + js] = (bf16_t)(v2[i] >> 16);
            }
        }
        __syncthreads();
        const int i0 = wid * 16, ii = i0 + fr;
        bf16x8 bq[2];
#pragma unroll
        for (int ks = 0; ks < 2; ++ks) bq[ks] = *(const bf16x8*)(Qs + (i0 + fr) * 72 + ks * 32 + fq * 8);
        f32x4 s[8];
#pragma unroll
        for (int jt = 0; jt < 8; ++jt) {
            s[jt] = (f32x4){0.f, 0.f, 0.f, 0.f};
#pragma unroll
            for (int ks = 0; ks < 2; ++ks) {
                const bf16x8 a = *(const bf16x8*)(Ks + (jt * 16 + fr) * 72 + ks * 32 + fq * 8);
                s[jt] = __builtin_amdgcn_mfma_f32_16x16x32_bf16(a, bq[ks], s[jt], 0, 0, 0);
            }
#pragma unroll
            for (int jj = 0; jj < 4; ++jj) {
                const int delta = ii - (jt * 16 + fq * 4 + jj);
                const float fac = __builtin_amdgcn_exp2f(delta >= 0 ? lgf2 * (float)delta : lgb2 * (float)(-delta));
                s[jt][jj] *= fac;
            }
        }
        bf16x8 bp[4];
#pragma unroll
        for (int k2 = 0; k2 < 4; ++k2) {
            u32x4 w; w[0] = cvt_pk_bf16(s[2 * k2][0], s[2 * k2][1]); w[1] = cvt_pk_bf16(s[2 * k2][2], s[2 * k2][3]);
            w[2] = cvt_pk_bf16(s[2 * k2 + 1][0], s[2 * k2 + 1][1]); w[3] = cvt_pk_bf16(s[2 * k2 + 1][2], s[2 * k2 + 1][3]);
            bp[k2] = __builtin_bit_cast(bf16x8, w);
        }
        const float qf = __builtin_amdgcn_exp2f(lgf2 * (float)(ii + 1)), qb = __builtin_amdgcn_exp2f(lgb2 * (float)(128 - ii));
        f32x4 o[4];
#pragma unroll
        for (int et = 0; et < 4; ++et) {
            o[et] = (f32x4){0.f, 0.f, 0.f, 0.f};
#pragma unroll
            for (int k2 = 0; k2 < 4; ++k2) {
                const u32x2 lo = *(const u32x2*)(vT + (et * 16 + fr) * 136 + (((2 * k2) * 16 + fq * 4) ^ (et << 4)));
                const u32x2 hi = *(const u32x2*)(vT + (et * 16 + fr) * 136 + (((2 * k2 + 1) * 16 + fq * 4) ^ (et << 4)));
                u32x4 w; w[0] = lo[0]; w[1] = lo[1]; w[2] = hi[0]; w[3] = hi[1];
                o[et] = __builtin_amdgcn_mfma_f32_16x16x32_bf16(__builtin_bit_cast(bf16x8, w), bp[k2], o[et], 0, 0, 0);
            }
            f32x4 cf = {0.f, 0.f, 0.f, 0.f}, cb = {0.f, 0.f, 0.f, 0.f};
#pragma unroll
            for (int ks = 0; ks < 2; ++ks) {
                cf = __builtin_amdgcn_mfma_f32_16x16x32_bf16(paf[et][ks], bq[ks], cf, 0, 0, 0);
                cb = __builtin_amdgcn_mfma_f32_16x16x32_bf16(pab[et][ks], bq[ks], cb, 0, 0, 0);
            }
            o[et] += cf * qf + cb * qb;
        }
        float sum = 0.f;
#pragma unroll
        for (int et = 0; et < 4; ++et) sum += (o[et][0] + o[et][1]) + (o[et][2] + o[et][3]);
        sum += __shfl_xor(sum, 16); sum += __shfl_xor(sum, 32);
        const float mu = sum * (1.f / 64.f);
        float vs = 0.f;
#pragma unroll
        for (int et = 0; et < 4; ++et) { const f32x4 d = o[et] - mu; vs += (d[0] * d[0] + d[1] * d[1]) + (d[2] * d[2] + d[3] * d[3]); }
        vs += __shfl_xor(vs, 16); vs += __shfl_xor(vs, 32);
        const float rstd = __builtin_amdgcn_rsqf(vs * (1.f / 64.f) + 1e-6f);
        const size_t tok = (size_t)(t0 + ii);
#pragma unroll
        for (int et = 0; et < 4; ++et) {
            const int e = et * 16 + fq * 4;
            const u32x2 gg = ggv[et];
            const f32x4 gn = *(const f32x4*)(gn_g + h * 64 + e);
            const f32x4 y = (o[et] - mu) * rstd * gn;
            u32x2 w; w[0] = cvt_pk_bf16(siluf_(bflo(gg[0])) * y[0], siluf_(bfhi(gg[0])) * y[1]); w[1] = cvt_pk_bf16(siluf_(bflo(gg[1])) * y[2], siluf_(bfhi(gg[1])) * y[3]);
            *(u32x2*)(RT + tok * 512 + h * 64 + e) = w;
        }
    }
}

DEV int att_sw(int key) { return (key & 3) | ((key >> 1) & 12); }
DEV void attn_phase(const bf16_t* __restrict__ Q, const bf16_t* __restrict__ Kmem, const bf16_t* __restrict__ VmemT, bf16_t* __restrict__ O, const int S, const int g, const int nM, const int nN) {
    LAS unsigned char* lds = (LAS unsigned char*)g_lds;
    const int tid = TIDX, bid = BIDX, wid = tid >> 6, lane = tid & 63, fr = lane & 15, fq = lane >> 4;
    const int wu = __builtin_amdgcn_readfirstlane(wid);
    const int nwg = nM * nN;
    for (int L = bid; L < nwg; L += gridDim.x) {
        int wgid = L; { const int q = nwg / NXCD, r = nwg % NXCD, xcd = wgid % NXCD, off = wgid / NXCD; wgid = (xcd < r ? xcd * (q + 1) : r * (q + 1) + (xcd - r) * q) + off; }
        const int WGM = (nN > 4) ? WGM_BIG : WGM_SMALL, nig = WGM * nN, gid = wgid / nig, fm = gid * WGM, gsz = (nM - fm) < WGM ? (nM - fm) : WGM;
        const int qb = fm + ((wgid % nig) % gsz), h = (wgid % nig) / gsz;
        const int t0 = qb * 256, seq = t0 / S, b = (g < 2) ? g * 4 + seq : 8;
        const bf16_t* kb = Kmem + (size_t)(b * 256) * 1024 + h * 256;
        const bf16_t* vb = VmemT + ((size_t)(b * 4 + h) * 256) * 256;
        const size_t tok0 = (size_t)(t0 + wid * 16 + fr), tok1 = tok0 + 128;
        f32x4 s[2][16];
#pragma unroll
        for (int mt = 0; mt < 16; ++mt) { s[0][mt] = (f32x4){0.f, 0.f, 0.f, 0.f}; s[1][mt] = (f32x4){0.f, 0.f, 0.f, 0.f}; }
        __syncthreads();
        {
            const bf16_t* src = kb + (size_t)(tid >> 4) * 1024 + (((tid & 15) ^ att_sw(tid >> 4)) * 8);
#pragma unroll 1
            for (int i = 0; i < 16; ++i)
                __builtin_amdgcn_global_load_lds((const unsigned*)(src + (size_t)(i & 7) * 32768 + (i >> 3) * 128), (LAS unsigned*)(lds + (i >> 3) * 65536 + wu * 1024 + (i & 7) * 8192), 16, 0, 0);
        }
#pragma unroll 1
        for (int half = 0; half < 2; ++half) {
            bf16x8 bq[2][4];
#pragma unroll
            for (int ks = 0; ks < 4; ++ks) {
                bq[0][ks] = *(const bf16x8*)(Q + tok0 * 1024 + h * 256 + half * 128 + ks * 32 + fq * 8);
                bq[1][ks] = *(const bf16x8*)(Q + tok1 * 1024 + h * 256 + half * 128 + ks * 32 + fq * 8);
            }
            if (half == 0) { asm volatile("s_waitcnt vmcnt(0)" ::: "memory"); __syncthreads(); }
            LAS unsigned char* kbuf = lds + half * 65536;
#pragma unroll
            for (int mt = 0; mt < 16; ++mt) {
                const int key = 32 * (mt >> 1) + (fr >> 2) * 8 + (mt & 1) * 4 + (fr & 3);
#pragma unroll
                for (int ks = 0; ks < 4; ++ks) {
                    const bf16x8 a = *(const LAS bf16x8*)(kbuf + key * 256 + (((ks * 4 + fq) ^ fr) << 4));
                    s[0][mt] = __builtin_amdgcn_mfma_f32_16x16x32_bf16(a, bq[0][ks], s[0][mt], 0, 0, 0);
                    s[1][mt] = __builtin_amdgcn_mfma_f32_16x16x32_bf16(a, bq[1][ks], s[1][mt], 0, 0, 0);
                }
            }
        }
        __syncthreads();
        {
            const bf16_t* src = vb + (size_t)(tid >> 5) * 256 + (((tid & 31) ^ ((tid >> 5) & 15)) * 8);
#pragma unroll 1
            for (int i = 0; i < 16; ++i)
                __builtin_amdgcn_global_load_lds((const unsigned*)(src + (size_t)(i & 7) * 4096 + (size_t)(i >> 3) * 32768), (LAS unsigned*)(lds + (i >> 3) * 65536 + wu * 1024 + (i & 7) * 8192), 16, 0, 0);
        }
        bf16x8 bp[2][8]; float il[2];
#pragma unroll
        for (int qs = 0; qs < 2; ++qs) {
            float mx = -3.0e38f;
#pragma unroll
            for (int mt = 0; mt < 16; ++mt) mx = fmaxf(mx, fmaxf(fmaxf(s[qs][mt][0], s[qs][mt][1]), fmaxf(s[qs][mt][2], s[qs][mt][3])));
            mx = fmaxf(mx, __shfl_xor(mx, 16)); mx = fmaxf(mx, __shfl_xor(mx, 32));
            float l = 0.f;
#pragma unroll
            for (int mt = 0; mt < 16; ++mt) {
#pragma unroll
                for (int jj = 0; jj < 4; ++jj) { const float pv = __expf(s[qs][mt][jj] - mx); s[qs][mt][jj] = pv; l += pv; }
            }
            l += __shfl_xor(l, 16); l += __shfl_xor(l, 32);
            il[qs] = 1.0f / l;
#pragma unroll
            for (int k2 = 0; k2 < 8; ++k2) {
                u32x4 w; w[0] = cvt_pk_bf16(s[qs][2 * k2][0], s[qs][2 * k2][1]); w[1] = cvt_pk_bf16(s[qs][2 * k2][2], s[qs][2 * k2][3]);
                w[2] = cvt_pk_bf16(s[qs][2 * k2 + 1][0], s[qs][2 * k2 + 1][1]); w[3] = cvt_pk_bf16(s[qs][2 * k2 + 1][2], s[qs][2 * k2 + 1][3]);
                bp[qs][k2] = __builtin_bit_cast(bf16x8, w);
            }
        }
        asm volatile("s_waitcnt vmcnt(0)" ::: "memory");
        __syncthreads();
#pragma unroll 1
        for (int half = 0; half < 2; ++half) {
            LAS unsigned char* vbuf = lds + half * 65536;
#pragma unroll
            for (int dt = 0; dt < 8; ++dt) {
                f32x4 o0 = {0.f, 0.f, 0.f, 0.f}, o1 = {0.f, 0.f, 0.f, 0.f};
#pragma unroll
                for (int k2 = 0; k2 < 8; ++k2) {
                    const bf16x8 a = *(const LAS bf16x8*)(vbuf + (dt * 16 + fr) * 512 + (((k2 * 4 + fq) ^ fr) << 4));
                    o0 = __builtin_amdgcn_mfma_f32_16x16x32_bf16(a, bp[0][k2], o0, 0, 0, 0);
                    o1 = __builtin_amdgcn_mfma_f32_16x16x32_bf16(a, bp[1][k2], o1, 0, 0, 0);
                }
                const int dcol = h * 256 + half * 128 + dt * 16 + fq * 4;
                u32x2 w; w[0] = cvt_pk_bf16(o0[0] * il[0], o0[1] * il[0]); w[1] = cvt_pk_bf16(o0[2] * il[0], o0[3] * il[0]);
                *(u32x2*)(O + tok0 * 1024 + dcol) = w;
                w[0] = cvt_pk_bf16(o1[0] * il[1], o1[1] * il[1]); w[1] = cvt_pk_bf16(o1[2] * il[1], o1[3] * il[1]);
                *(u32x2*)(O + tok1 * 1024 + dcol) = w;
            }
        }
    }
}

#define XB_TMO      128
#define XB_XCNT(j)  (256  + 64 * (j))
#define XB_XSUB(j)  (1280 + 64 * (j))
#define XB_XGEN(j)  (2304 + 64 * (j))
#define XB_TOP      3328
#define XB_TOPGEN   3392
#define XCD_BAR_WORDS 3456
#define XB_SPIN_CAP (1u << 22)
DEV unsigned xb_ld(unsigned* p)              { return __hip_atomic_load(p, __ATOMIC_RELAXED, __HIP_MEMORY_SCOPE_AGENT); }
DEV unsigned xb_add(unsigned* p, unsigned v) { return __hip_atomic_fetch_add(p, v, __ATOMIC_RELAXED, __HIP_MEMORY_SCOPE_AGENT); }
DEV unsigned xb_xcc_id() { return (unsigned)__builtin_amdgcn_s_getreg((3 << 11) | 20) & 0xFu; }
#define XB_SPIN(cond, bar) do { unsigned _sp = 0; while (cond) { __builtin_amdgcn_s_sleep(1); \
    if ((++_sp & 255u) == 0u) { if (xb_ld(&(bar)[XB_TMO])) break; if (_sp > XB_SPIN_CAP) { atomicAdd(&(bar)[XB_TMO], 1u); break; } } } } while (0)
struct XcdBarrier { unsigned* bar; unsigned x; volatile LAS unsigned* st; };
DEV XcdBarrier xcd_barrier_post(unsigned* bar, volatile LAS unsigned* st) {
    XcdBarrier b; b.bar = bar; b.x = xb_xcc_id(); b.st = st;
    if (threadIdx.x == 0) (void)xb_add(&bar[XB_XCNT(b.x)], 1u);
    return b;
}
DEV void xcd_barrier_complete(unsigned* bar, unsigned x, unsigned& nloc, unsigned& nx) {
    const unsigned G = gridDim.x * gridDim.y * gridDim.z;
    unsigned sum, cnt, mine, sp = 0u;
    for (;;) {
        sum = 0u; cnt = 0u; mine = 0u;
#pragma unroll
        for (unsigned j = 0; j < 16; ++j) { const unsigned c = xb_ld(&bar[XB_XCNT(j)]); sum += c; cnt += (c > 0u) ? 1u : 0u; mine = (j == x) ? c : mine; }
        if (sum == G) break;
        __builtin_amdgcn_s_sleep(1);
        if ((++sp & 255u) == 0u) { if (xb_ld(&bar[XB_TMO])) break; if (sp > XB_SPIN_CAP) { atomicAdd(&bar[XB_TMO], 1u); break; } }
    }
    nloc = mine > 0u ? mine : 1u; nx = cnt > 0u ? cnt : 1u;
}
DEV void xcd_barrier(const XcdBarrier& b) {
    asm volatile("s_waitcnt vmcnt(0)" ::: "memory");
    __syncthreads();
    if (threadIdx.x == 0) {
        unsigned* bar = b.bar;
        __builtin_amdgcn_s_waitcnt(0);
        unsigned nloc = b.st[0], nx = b.st[1];
        if (nloc == 0u) { xcd_barrier_complete(bar, b.x, nloc, nx); b.st[0] = nloc; b.st[1] = nx; }
        const unsigned old = xb_add(&bar[XB_XSUB(b.x)], 1u);
        const unsigned gen = old / nloc;
        if (old + 1u == (gen + 1u) * nloc) {
            __builtin_amdgcn_fence(__ATOMIC_RELEASE, "agent");
            asm volatile("s_waitcnt vmcnt(0)" ::: "memory");
            const unsigned og = xb_add(&bar[XB_TOP], 1u);
            const unsigned tg = og / nx;
            if (og + 1u == (tg + 1u) * nx) xb_add(&bar[XB_TOPGEN], 1u);
            else XB_SPIN(xb_ld(&bar[XB_TOPGEN]) == tg, bar);
            __builtin_amdgcn_fence(__ATOMIC_ACQUIRE, "agent");
            xb_add(&bar[XB_XGEN(b.x)], 1u);
            asm volatile("s_waitcnt vmcnt(0)" ::: "memory");
        } else {
            XB_SPIN(xb_ld(&bar[XB_XGEN(b.x)]) == gen, bar);
            __builtin_amdgcn_fence(__ATOMIC_ACQUIRE, "agent");
            asm volatile("s_waitcnt vmcnt(0)" ::: "memory");
        }
    }
    __syncthreads();
}

constexpr int PH_PER_GROUP = 25, N_PHASES = 2 + NGRP * PH_PER_GROUP;

DEV void run_phase(const Params& p, const int ph) {
    unsigned char* ws = p.ws;
    if (ph == 0) {
#if PROBE == 9
        setup_phase(p);
#endif
        setup_phase(p); return; }
    bf16_t* H = (bf16_t*)(ws + WS_H); bf16_t* HID = (bf16_t*)(ws + WS_HID); bf16_t* PROJ = (bf16_t*)(ws + WS_PROJ);
    bf16_t* MIXB = (bf16_t*)(ws + WS_MIXB); bf16_t* QB = (bf16_t*)(ws + WS_QB); bf16_t* OB = (bf16_t*)(ws + WS_OB);
    bf16_t* CV = (bf16_t*)(ws + WS_CV); bf16_t* RT = (bf16_t*)(ws + WS_RT);
    float* KVST = (float*)(ws + WS_KVST); bf16_t* PREV = (bf16_t*)(ws + WS_PREV);
    const float2* rot = (const float2*)(ws + WS_ROT);
    GemmDesc gd{};
    int kind = 0;
    int g = 0, l = 0, s = 0;
    if (ph == 1) {
        gd.A = (const bf16_t*)(ws + WS_MEMN); gd.Bt = (const bf16_t*)(ws + WS_WT) + O_KV; gd.M = 2 * 2304; gd.N = 2048; gd.K = 1024; gd.epi = EPI_KV;
        gd.out = ws + WS_KMEM; gd.out2 = (bf16_t*)(ws + WS_VMEMT); gd.bt_layer_stride = WL;
    } else {
        const int idx = ph - 2; g = idx / PH_PER_GROUP; const int r = idx - g * PH_PER_GROUP;
        if (r < 13) { l = 0; s = r; } else { l = 1; s = r - 12; }
    }
    const int S = (g < 2) ? 4096 : 16384;
    const bf16_t* W = (const bf16_t*)(ws + WS_WT) + (size_t)l * WL;
    const float* ng = p.in[4] + (size_t)l * 8 * 1024;
    const float* xin = (g < 2) ? p.in[0] + (size_t)g * TG * 1024 : p.in[1];
    float* OUT = p.out + (size_t)g * TG * 1024;
    float* rowss = (float*)(ws + WS_ROWSS);
    int fk = -1;
    if (ph >= 2) {
        gd.M = TG; gd.XB = H; gd.xbuf = (float*)(ws + WS_XBUF); gd.cnt = (unsigned*)(ws + WS_CNT); gd.rowss = rowss; gd.rowss_out = rowss;
        switch (s) {
        case 0: kind = 1; break;
        case 1: gd.A = H; gd.Bt = W + O_GU1; gd.N = 5632; gd.K = 1024; gd.epi = EPI_SWIGLU; gd.out = HID; break;
        case 2: gd.A = HID; gd.Bt = W + O_D1; gd.N = 1024; gd.K = 2816; gd.epi = EPI_RES; fk = 0; gd.scale = 0.5f; gd.gpost = ng + 1 * 1024; break;
        case 3: gd.A = H; gd.Bt = W + O_IN; gd.N = 5120; gd.K = 1024; gd.epi = EPI_PROJ; gd.out = PROJ; gd.gate_b = p.in[17] + (size_t)l * 2048; gd.gates = (bf16_t*)(ws + WS_GATES); break;
        case 4: kind = 2; break;
        case 5: kind = 3; break;
        case 6: kind = 4; break;
        case 7: gd.A = CV; gd.Bt = W + O_PW; gd.N = 1024; gd.K = 512; gd.epi = EPI_MIX; gd.out = MIXB; gd.A2 = RT; gd.Bt2 = W + O_RO; gd.K2 = 512; gd.gates = (bf16_t*)(ws + WS_GATES); break;
        case 8: gd.A = MIXB; gd.Bt = W + O_MIX; gd.N = 1024; gd.K = 1024; gd.epi = EPI_RES; fk = 1; gd.scale = 1.f; gd.gpost = ng + 3 * 1024; break;
        case 9: gd.A = H; gd.Bt = W + O_Q; gd.N = 1024; gd.K = 1024; gd.epi = EPI_BF16; gd.out = QB; break;
        case 10: gd.A = OB; gd.Bt = W + O_O; gd.N = 1024; gd.K = 1024; gd.epi = EPI_RES; fk = 2; gd.scale = 1.f; gd.gpost = ng + 5 * 1024; break;
        case 11: gd.A = H; gd.Bt = W + O_GU2; gd.N = 5632; gd.K = 1024; gd.epi = EPI_SWIGLU; gd.out = HID; break;
        default: gd.A = HID; gd.Bt = W + O_D2; gd.N = 1024; gd.K = 2816; gd.epi = EPI_RES; fk = 3; gd.scale = 0.5f; gd.gpost = ng + 7 * 1024; gd.outf = (l == 1) ? OUT : nullptr; break;
        }
        gd.expect = 4u * (unsigned)(g * 8 + l * 4 + fk + 1);
    }
    if (kind == 0) {
        switch (gd.epi) {
        case EPI_RES: gemm_phase<EPI_RES>(gd); break;
        case EPI_BF16:
#if PROBE == 12
            gemm_phase<EPI_BF16>(gd);
#endif
            gemm_phase<EPI_BF16>(gd);
            asm volatile("s_waitcnt vmcnt(0)" ::: "memory");
            __syncthreads();
            __builtin_amdgcn_fence(__ATOMIC_ACQUIRE, "agent");
            asm volatile("s_waitcnt vmcnt(0)" ::: "memory");
            attn_phase(QB, (const bf16_t*)(ws + WS_KMEM) + (size_t)l * 2304 * 1024, (const bf16_t*)(ws + WS_VMEMT) + (size_t)l * 2304 * 1024, OB, S, g, TG / 256, 4);
            break;
        case EPI_SWIGLU:
#if PROBE == 6
            for (int rep = 0; rep < 2; ++rep)
#endif
            gemm_phase<EPI_SWIGLU>(gd);
#if PROBE == 10
            gemm_phase<7>(gd);
#endif
            break;
        case EPI_PROJ:
#if PROBE == 7
            for (int rep = 0; rep < 2; ++rep)
#endif
            gemm_phase<EPI_PROJ>(gd); break;
        case EPI_MIX:
#if PROBE == 13
            gemm_phase<EPI_MIX>(gd);
#endif
            gemm_phase<EPI_MIX>(gd); break;
        default: gemm_phase<EPI_KV>(gd); break;
        }
        if (ph == 1) rw0_phase(p.in[0], H, rowss);
    }
    else if (kind == 1) { if (g > 0) rw0_phase(xin, H, rowss); }
    else if (kind == 2) {
        conv_phase(PROJ, CV, p.in[8] + (size_t)l * 31 * 512, p.in[9] + l * 512, p.in[10] + l * 512, p.in[11] + l * 512, S);
        r1_phase(PROJ, rot, KVST, p.in[13] + l * 8, p.in[14] + l * 8, S);
    } else if (kind == 3) {
#if PROBE == 11
        r2_phase(KVST, PREV, p.in[13] + l * 8, p.in[14] + l * 8, S);
#endif
        r2_phase(KVST, PREV, p.in[13] + l * 8, p.in[14] + l * 8, S);
    }
    else r3_phase(PROJ, rot, PREV, RT, p.in[13] + l * 8, p.in[14] + l * 8, p.in[15] + l * 512, S);
}

#ifndef PROBE_MASK
#define PROBE_MASK 0
#endif
__global__ void __launch_bounds__(NTHREADS) mega(const Params p) {
#if SINGLE_LAUNCH
    volatile LAS unsigned* st = (volatile LAS unsigned*)((LAS unsigned char*)g_lds + 131072);
    if (threadIdx.x == 0) { st[0] = 0u; st[1] = 0u; }
    __syncthreads();
    const XcdBarrier xb = xcd_barrier_post((unsigned*)(p.ws + WS_BAR), st);
#endif
#if PROBE_MASK
    unsigned long long t_prev = __builtin_amdgcn_s_memrealtime(), t_acc = 0ull;
#endif
    for (int ph = p.ph_begin; ph < p.ph_end; ++ph) {
        run_phase(p, ph);
#if SINGLE_LAUNCH
        if (ph + 1 < p.ph_end) {
            if (p.ph_begin > p.ph_end) cg::this_grid().sync();
            xcd_barrier(xb);
        }
#endif
#if PROBE_MASK
        {
            const unsigned long long t_now = __builtin_amdgcn_s_memrealtime();
            int slot;
            if (ph < 2) slot = 14 + ph; else { const int r = (ph - 2) % PH_PER_GROUP; slot = (r < 13) ? r : r - 12; }
            if ((PROBE_MASK >> slot) & 1) t_acc += t_now - t_prev;
            t_prev = t_now;
        }
#endif
    }
#if PROBE_MASK
    if (blockIdx.x == 0 && threadIdx.x == 0) {
        const unsigned long long t0 = __builtin_amdgcn_s_memrealtime();
        while (__builtin_amdgcn_s_memrealtime() - t0 < t_acc) __builtin_amdgcn_s_sleep(8);
    }
#endif
}

extern "C" void kernel_launch(void* const* d_in, const int* in_sizes, int n_in, void* d_out, int out_size, void* d_ws, size_t ws_size, hipStream_t stream) {
    static int grid = 0;
    if (grid == 0) {
        if (n_in != 25 || ws_size < WS_END) { fprintf(stderr, "kernel_launch: need 25 inputs and >= %zu bytes of workspace (got %d, %zu)\n", (size_t)WS_END, n_in, ws_size); grid = -1; return; }
        int dev = 0, cus = 0, per_cu = 0;
        hipGetDevice(&dev);
        hipDeviceGetAttribute(&cus, hipDeviceAttributeMultiprocessorCount, dev);
        if (hipFuncSetAttribute((const void*)mega, hipFuncAttributeMaxDynamicSharedMemorySize, LDS_BYTES) != hipSuccess) { fprintf(stderr, "kernel_launch: hipFuncSetAttribute failed\n"); grid = -1; return; }
        hipOccupancyMaxActiveBlocksPerMultiprocessor(&per_cu, (const void*)mega, NTHREADS, LDS_BYTES);
        if (per_cu < 1) per_cu = 1;
        (void)hipGetLastError();
        grid = cus * 1;
    }
    if (grid < 0) return;
    Params p{};
    for (int i = 0; i < 25; ++i) p.in[i] = (const float*)d_in[i];
    p.out = (float*)d_out; p.ws = (unsigned char*)d_ws;
    for (int i = 0; i < 32; ++i) p.inv_freq[i] = (float)pow(10000.0, -(double)i / 32.0);
#if SINGLE_LAUNCH
    p.ph_begin = 0; p.ph_end = N_PHASES;
    hipMemsetAsync((unsigned char*)d_ws + WS_BAR, 0, 16384 + 32768, stream);
    void* args[] = {&p};
    hipError_t e = hipLaunchCooperativeKernel((const void*)mega, dim3(grid), dim3(NTHREADS), args, LDS_BYTES, stream);
    if (e != hipSuccess) fprintf(stderr, "cooperative launch failed: %s (grid %d)\n", hipGetErrorString(e), grid);
#else
    for (int ph = 0; ph < N_PHASES; ++ph) {
        p.ph_begin = ph; p.ph_end = ph + 1;
        hipLaunchKernelGGL(mega, dim3(grid), dim3(NTHREADS), LDS_BYTES, stream, p);
    }
#endif
}
```

```cpp
#include <hip/hip_runtime.h>
#include <hip/hip_bf16.h>
#include <hip/hip_cooperative_groups.h>
#include <cstdio>
#include <cmath>
namespace cg = cooperative_groups;

#ifndef PROBE
#define PROBE 0
#endif
#define PROBE_MASK 0
#ifndef SINGLE_LAUNCH
#define SINGLE_LAUNCH 1
#endif

#define DEV __device__ __forceinline__
typedef unsigned short bf16_t;
typedef short bf16x8 __attribute__((ext_vector_type(8)));
typedef short bf16x4 __attribute__((ext_vector_type(4)));
typedef float f32x4 __attribute__((ext_vector_type(4)));
typedef unsigned u32x4 __attribute__((ext_vector_type(4)));
typedef unsigned u32x2 __attribute__((ext_vector_type(2)));

constexpr int TG = 16384;
constexpr int NGRP = 3;
constexpr int PC = 3072;
constexpr int C_Q = 1024, C_K = 1536, C_V = 2048, C_G = 2560, C_GC = 3072, C_GR = 4096;
constexpr int NTHREADS = 512;
constexpr int LDS_BYTES = 131072 + 16;

constexpr size_t O_GU1 = 0, O_D1 = 5767168, O_IN = 8650752, O_PW = 13893632, O_RO = 14417920, O_MIX = 14942208,
                 O_Q = 15990784, O_KV = 17039360, O_O = 19136512, O_GU2 = 20185088, O_D2 = 25952256, WL = 28835840;
constexpr size_t WS_WT = 0;
constexpr size_t WS_ROT = WS_WT + 2 * WL * 2;
constexpr size_t WS_MEMN = WS_ROT + (size_t)16384 * 32 * 8;
constexpr size_t WS_KMEM = WS_MEMN + (size_t)2 * 2304 * 1024 * 2;
constexpr size_t WS_VMEMT = WS_KMEM + (size_t)2 * 2304 * 1024 * 2;
constexpr size_t WS_H = WS_VMEMT + (size_t)2 * 2304 * 1024 * 2;
constexpr size_t WS_HID = WS_H + (size_t)TG * 1024 * 2;
constexpr size_t WS_KVST = WS_HID;
constexpr size_t WS_PREV = WS_HID + 33554432;
constexpr size_t WS_MIXB = WS_HID + 50331648;
constexpr size_t WS_PROJ = WS_HID + (size_t)TG * 2816 * 2;
constexpr size_t WS_F = WS_PROJ;
constexpr size_t WS_QB = WS_PROJ + 67108864;
constexpr size_t WS_OB = WS_PROJ + 100663296;
constexpr size_t WS_GATES = WS_PROJ + (size_t)TG * 3072 * 2;
constexpr size_t WS_CV = WS_PROJ + (size_t)TG * 5120 * 2;
constexpr size_t WS_RT = WS_CV + (size_t)TG * 512 * 2;
constexpr size_t WS_BAR = WS_RT + (size_t)TG * 512 * 2;
constexpr size_t WS_CNT = WS_BAR + 16384;
constexpr size_t WS_XBUF = WS_CNT + 32768;
constexpr size_t WS_ROWSS = WS_XBUF + 2 * 262144;
constexpr size_t WS_END = WS_ROWSS + (size_t)TG * 16;

struct Params {
    const float* in[25];
    float* out;
    unsigned char* ws;
    float inv_freq[32];
    int ph_begin, ph_end;
};

extern __shared__ __attribute__((aligned(16))) unsigned char g_lds[];

DEV unsigned cvt_pk_bf16(float lo, float hi) { unsigned r; asm("v_cvt_pk_bf16_f32 %0, %1, %2" : "=v"(r) : "v"(lo), "v"(hi)); return r; }
DEV bf16_t f2bf(float v) { return (bf16_t)(cvt_pk_bf16(v, 0.f) & 0xffffu); }
DEV float bf2f(bf16_t v) { return __uint_as_float((unsigned)v << 16); }
DEV float bflo(unsigned v) { return __uint_as_float(v << 16); }
DEV float bfhi(unsigned v) { return __uint_as_float(v & 0xffff0000u); }
DEV float sigmoidf_(float x) { return __builtin_amdgcn_rcpf(1.f + __expf(-x)); }
DEV float siluf_(float x) { return x * __builtin_amdgcn_rcpf(1.f + __expf(-x)); }
DEV float wave_sum(float v) {
#pragma unroll
    for (int o = 32; o > 0; o >>= 1) v += __shfl_xor(v, o);
    return v;
}

DEV int launder_v(int v) { asm volatile("" : "+v"(v)); return v; }
DEV int launder_s(int v) { asm volatile("" : "+s"(v)); return v; }
#define TIDX launder_v((int)threadIdx.x)
#define BIDX launder_s((int)blockIdx.x)
constexpr int BM = 256, BK = 64, HALF = 128, HT = HALF * BK, NXCD = 8, WGM_BIG = 4, WGM_SMALL = 8;
DEV int lds_byte(int r, int c) {
    int st = (r >> 4) * 2 + (c >> 5), rr = r & 15, cc = c & 31, ob = rr * 64 + cc * 2;
    return st * 1024 + (ob ^ (((ob >> 9) & 1) << 5));
}
DEV void stage_rc(int b, int& R, int& C) {
    int st = b / 1024, sb = b % 1024, swz = sb ^ (((sb >> 9) & 1) << 5);
    R = (st >> 1) * 16 + swz / 64; C = (st & 1) * 32 + (swz % 64) / 2;
}

#define LAS __attribute__((address_space(3)))
enum { EPI_F32 = 0, EPI_BF16 = 1, EPI_SWIGLU = 2, EPI_PROJ = 3, EPI_MIX = 4, EPI_KV = 5, EPI_RES = 6 };

struct GemmDesc {
    const bf16_t* A; const bf16_t* Bt; int M, N, K, epi;
    void* out;
    const bf16_t* A2; const bf16_t* Bt2; int K2;
    bf16_t* gates;
    const float* gate_b;
    bf16_t* out2;
    size_t bt_layer_stride;
    bf16_t* XB; const float* gpost; float scale; float* xbuf; unsigned* cnt; unsigned expect;
    float* rowss_out;
    float* outf;
    const float* rowss;
};

template <int EPI> DEV void gemm_phase(const GemmDesc& g) {
    LAS unsigned char* lds = (LAS unsigned char*)g_lds;
    const int tid = TIDX, wid = __builtin_amdgcn_readfirstlane(tid >> 6), lane = tid & 63, wr = wid >> 2, wc = wid & 3, fr = lane & 15, fq = lane >> 4;
    const int K = g.K, nt = K / BK;
    const int nM = g.M / BM, nN = g.N / BM, nwg = nM * nN, G = gridDim.x, cblk = BIDX;
    const bool dual = (EPI == EPI_MIX);
    const bool hsplit = (EPI == EPI_SWIGLU) && (2 * (nwg % G) == G);
    unsigned voff[2];
#pragma unroll
    for (int i = 0; i < 2; ++i) { int R, C; stage_rc(tid * 16 + i * 8192, R, C); voff[i] = (unsigned)(R * K + C) * 2u; }
    const size_t kstep = (size_t)(BK * 2), hstep = (size_t)HALF * K * 2, tstep = 2 * hstep;
    const unsigned ldsw = (unsigned)wid * 1024u;
    const int aoff = lds_byte(wr * 64 + fr, fq * 8), boff = lds_byte(wc * 32 + fr, fq * 8);
#define PG_SA(b, h) (((b) * 2 + (h)) * (HT * 2))
#define PG_SB(b, h) ((4 + (b) * 2 + (h)) * (HT * 2))
#define PG_STAGE(bufoff, gbase) do { _Pragma("unroll") for (int _i = 0; _i < 2; ++_i) \
        __builtin_amdgcn_global_load_lds((const unsigned*)((const char*)(gbase) + voff[_i]), (LAS unsigned*)(lds + (bufoff) + ldsw + _i * 8192), 16, 0, 0); } while (0)
#define PG_LDA(dst, b, h) do { _Pragma("unroll") for (int m = 0; m < 4; ++m) _Pragma("unroll") for (int k = 0; k < 2; ++k) dst[m][k] = *(const LAS bf16x8*)(lds + PG_SA(b, h) + aoff + m * 2048 + k * 1024); } while (0)
#define PG_LDB(dst, b, h) do { _Pragma("unroll") for (int n = 0; n < 2; ++n) _Pragma("unroll") for (int k = 0; k < 2; ++k) dst[n][k] = *(const LAS bf16x8*)(lds + PG_SB(b, h) + boff + n * 2048 + k * 1024); } while (0)
#define PG_MMA(ai, bj, Af, Bf) do { __builtin_amdgcn_s_setprio(1); _Pragma("unroll") for (int m = 0; m < 4; ++m) _Pragma("unroll") for (int n = 0; n < 2; ++n) _Pragma("unroll") for (int k = 0; k < 2; ++k) \
        acc[ai][bj][m][n] = __builtin_amdgcn_mfma_f32_16x16x32_bf16(Bf[n][k], Af[m][k], acc[ai][bj][m][n], 0, 0, 0); __builtin_amdgcn_s_setprio(0); } while (0)
#define PG_WAIT_V(n) asm volatile("s_waitcnt vmcnt(" #n ")" ::: "memory")
#define PG_WAIT_L(n) asm volatile("s_waitcnt lgkmcnt(" #n ")" ::: "memory")
#define PG_BAR __builtin_amdgcn_s_barrier()
#define PG_SCHED __builtin_amdgcn_sched_barrier(0)
#define PG_NEXT(i, pm_, pn_, seg_, ok_) do { const int _ti = dual ? ((i) >> 1) : (i); seg_ = dual ? ((i) & 1) : 0; int _L = _ti * G + cblk; ok_ = _L < nwg; \
        if (hsplit) { const int _nf = nwg / G; if (_ti == _nf) { _L = _nf * G + (cblk >> 1); seg_ = 1 + (cblk & 1); ok_ = _L < nwg; } else if (_ti > _nf) ok_ = false; } \
        if (ok_) { int wgid = _L; { const int q = nwg / NXCD, r = nwg % NXCD, xcd = wgid % NXCD, off = wgid / NXCD; wgid = (xcd < r ? xcd * (q + 1) : r * (q + 1) + (xcd - r) * q) + off; } \
          const int WGM = (nN > 4) ? WGM_BIG : WGM_SMALL, nig = WGM * nN, gid = wgid / nig, fm = gid * WGM, gsz = (nM - fm) < WGM ? (nM - fm) : WGM; pm_ = fm + ((wgid % nig) % gsz); pn_ = (wgid % nig) / gsz; } } while (0)
#define PG_ABASE(pm_, seg_) ((EPI == EPI_SWIGLU) ? ((const char*)g.A + (size_t)(pm_) * tstep + ((seg_) == 2 ? hstep : (size_t)0)) : ((const char*)((seg_) ? g.A2 : g.A) + (size_t)(pm_) * tstep))
#define PG_BBASE(pm_, pn_, seg_) ((const char*)((EPI != EPI_SWIGLU && (seg_)) ? g.Bt2 : g.Bt) + ((EPI == EPI_KV && (pm_) >= 9) ? g.bt_layer_stride * 2 : (size_t)0) + (size_t)(pn_) * tstep)
    int pm = 0, pn = 0, seg = 0, npm = 0, npn = 0, nseg = 0, ui = 0; bool ok;
    PG_NEXT(0, pm, pn, seg, ok);
    if (!ok) return;
    f32x4 acc[2][2][4][2];
#pragma unroll
    for (int a = 0; a < 2; ++a)
#pragma unroll
        for (int b = 0; b < 2; ++b)
#pragma unroll
            for (int m = 0; m < 4; ++m)
#pragma unroll
                for (int n = 0; n < 2; ++n) acc[a][b][m][n] = (f32x4){0.f, 0.f, 0.f, 0.f};
    bf16x8 At[4][2], B0[2][2], B1[2][2];
    const char* cA = PG_ABASE(pm, seg); const char* cB = PG_BBASE(pm, pn, seg);
    asm volatile("s_waitcnt vmcnt(0) lgkmcnt(0)" ::: "memory"); PG_BAR; PG_SCHED;
    PG_STAGE(PG_SB(0, 0), cB); PG_STAGE(PG_SA(0, 0), cA); PG_STAGE(PG_SB(0, 1), cB + hstep); PG_STAGE(PG_SA(0, 1), cA + hstep);
    if (wr == 1) PG_BAR;
    PG_WAIT_V(4); PG_BAR;
    PG_STAGE(PG_SB(1, 0), cB + kstep); PG_STAGE(PG_SA(1, 0), cA + kstep); PG_STAGE(PG_SB(1, 1), cB + hstep + kstep);
    PG_WAIT_V(6); PG_BAR;
    for (;;) {
        bool has_next; PG_NEXT(ui + 1, npm, npn, nseg, has_next);
        const char* nA = has_next ? PG_ABASE(npm, nseg) : cA; const char* nB = has_next ? PG_BBASE(npm, npn, nseg) : cB;
        const bool halfu = (EPI == EPI_SWIGLU) && (seg != 0);
        for (int t = 0; t < nt; t += 2) {
            const bool last = (t == nt - 2);
            const char* a1 = cA + (size_t)(t + 1) * kstep;
            const char* a2 = last ? nA : cA + (size_t)(t + 2) * kstep; const char* b2 = last ? nB : cB + (size_t)(t + 2) * kstep;
            const char* a3 = a2 + kstep; const char* b3 = b2 + kstep;
            PG_LDB(B0, 0, 0); PG_SCHED; PG_LDA(At, 0, 0); PG_STAGE(PG_SA(1, 1), a1 + hstep);
            PG_WAIT_L(8); PG_BAR; PG_WAIT_L(0); PG_MMA(0, 0, At, B0); PG_BAR; PG_SCHED;
            PG_LDB(B1, 0, 1); PG_STAGE(PG_SB(0, 0), b2);
            PG_BAR; PG_WAIT_L(0); PG_MMA(0, 1, At, B1); PG_BAR;
            if (!halfu) PG_LDA(At, 0, 1); PG_STAGE(PG_SA(0, 0), a2);
            PG_BAR; PG_WAIT_L(0); if (!halfu) PG_MMA(1, 0, At, B0); PG_BAR; PG_SCHED;
            PG_STAGE(PG_SB(0, 1), b2 + hstep);
            PG_WAIT_V(6); PG_BAR; if (!halfu) PG_MMA(1, 1, At, B1); PG_BAR;
            PG_LDB(B0, 1, 0); PG_SCHED; PG_LDA(At, 1, 0); PG_STAGE(PG_SA(0, 1), a2 + hstep);
            PG_WAIT_L(8); PG_BAR; PG_WAIT_L(0); PG_MMA(0, 0, At, B0); PG_BAR; PG_SCHED;
            PG_LDB(B1, 1, 1); PG_STAGE(PG_SB(1, 0), b3);
            PG_BAR; PG_WAIT_L(0); PG_MMA(0, 1, At, B1); PG_BAR;
            if (!halfu) PG_LDA(At, 1, 1); PG_STAGE(PG_SA(1, 0), a3);
            PG_BAR; PG_WAIT_L(0); if (!halfu) PG_MMA(1, 0, At, B0); PG_BAR; PG_SCHED;
            PG_STAGE(PG_SB(1, 1), b3 + hstep);
            PG_WAIT_V(6); PG_BAR; if (!halfu) PG_MMA(1, 1, At, B1); PG_BAR;
        }
        const int brow = pm * BM + ((EPI == EPI_SWIGLU && seg == 2) ? HALF : 0), bcol = pn * BM;
        const int r0 = brow + wr * 64 + fr, c0 = bcol + wc * 32 + fq * 8;
        if (EPI == EPI_RES || EPI == 7) {
            if (EPI == 7) { float q = 0.f;
#pragma unroll
                for (int ai = 0; ai < 2; ++ai)
#pragma unroll
                    for (int bj = 0; bj < 2; ++bj)
#pragma unroll
                        for (int m = 0; m < 4; ++m)
#pragma unroll
                            for (int n = 0; n < 2; ++n) q += acc[ai][bj][m][n][0] + acc[ai][bj][m][n][1] + acc[ai][bj][m][n][2] + acc[ai][bj][m][n][3];
                if (q == 1.2345e-30f) ((float*)g.xbuf)[tid] = q; }
        } else if (EPI == EPI_MIX) {
          if (seg == 0) {
#pragma unroll
            for (int ai = 0; ai < 2; ++ai)
#pragma unroll
                for (int m = 0; m < 4; ++m)
#pragma unroll
                    for (int bj = 0; bj < 2; ++bj) {
                        const size_t gi = ((((size_t)(pm * 8 + 2 * pn + bj) * 8 + wid) * 8 + (ai * 4 + m)) * 64 + lane) * 8;
                        const u32x4 rt = *(const u32x4*)(g.gates + gi);
                        f32x4 v0 = acc[ai][bj][m][0], v1 = acc[ai][bj][m][1];
                        v0[0] *= bflo(rt[0]); v0[1] *= bfhi(rt[0]); v0[2] *= bflo(rt[1]); v0[3] *= bfhi(rt[1]);
                        v1[0] *= bflo(rt[2]); v1[1] *= bfhi(rt[2]); v1[2] *= bflo(rt[3]); v1[3] *= bfhi(rt[3]);
                        acc[ai][bj][m][0] = v0; acc[ai][bj][m][1] = v1;
                    }
          } else {
#pragma unroll
            for (int ai = 0; ai < 2; ++ai) {
              u32x4 grv[4][2];
#pragma unroll
              for (int m = 0; m < 4; ++m)
#pragma unroll
                  for (int bj = 0; bj < 2; ++bj) grv[m][bj] = *(const u32x4*)(g.gates + (size_t)TG * 1024 + ((((size_t)(pm * 8 + 2 * pn + bj) * 8 + wid) * 8 + (ai * 4 + m)) * 64 + lane) * 8);
#pragma unroll
                for (int m = 0; m < 4; ++m) {
                    const size_t row = (size_t)(r0 + ai * 128 + m * 16);
                    bf16_t* o = (bf16_t*)g.out + row * 1024 + c0;
#pragma unroll
                    for (int bj = 0; bj < 2; ++bj) {
                        const u32x4 gr = grv[m][bj];
                        const f32x4 v0 = acc[ai][bj][m][0], v1 = acc[ai][bj][m][1];
                        u32x4 w; w[0] = cvt_pk_bf16(v0[0] * bflo(gr[0]), v0[1] * bfhi(gr[0])); w[1] = cvt_pk_bf16(v0[2] * bflo(gr[1]), v0[3] * bfhi(gr[1]));
                        w[2] = cvt_pk_bf16(v1[0] * bflo(gr[2]), v1[1] * bfhi(gr[2])); w[3] = cvt_pk_bf16(v1[2] * bflo(gr[3]), v1[3] * bfhi(gr[3]));
                        *(u32x4*)(o + bj * 128) = w;
                    }
                }
            }
          }
        } else if (EPI == EPI_F32) {
#pragma unroll
            for (int ai = 0; ai < 2; ++ai)
#pragma unroll
                for (int m = 0; m < 4; ++m) {
                    float* o = (float*)g.out + (size_t)(r0 + ai * 128 + m * 16) * g.N + c0;
#pragma unroll
                    for (int bj = 0; bj < 2; ++bj)
#pragma unroll
                        for (int n = 0; n < 2; ++n) *(f32x4*)(o + bj * 128 + n * 4) = acc[ai][bj][m][n];
                }
        } else if (EPI == EPI_BF16 || EPI == EPI_PROJ) {
            const bool sg = (EPI == EPI_PROJ) && (bcol >= C_GC);
#pragma unroll
            for (int ai = 0; ai < 2; ++ai)
#pragma unroll
                for (int m = 0; m < 4; ++m) {
                    const f32x4 q = *(const f32x4*)(g.rowss + (size_t)(r0 + ai * 128 + m * 16) * 4);
                    const float rs = __builtin_amdgcn_rsqf(((q[0] + q[1]) + (q[2] + q[3])) * (1.f / 1024.f) + 1e-6f);
#pragma unroll
                    for (int bj = 0; bj < 2; ++bj) { acc[ai][bj][m][0] *= rs; acc[ai][bj][m][1] *= rs; }
                }
            if (sg) {
                const int t = (bcol - C_GC) >> 8, gcol = 128 * t + wc * 32 + fq * 8;
                const f32x4 bc0 = *(const f32x4*)(g.gate_b + gcol), bc1 = *(const f32x4*)(g.gate_b + gcol + 4);
                const f32x4 br0 = *(const f32x4*)(g.gate_b + 1024 + gcol), br1 = *(const f32x4*)(g.gate_b + 1024 + gcol + 4);
#pragma unroll
                for (int ai = 0; ai < 2; ++ai)
#pragma unroll
                    for (int m = 0; m < 4; ++m) {
                        const f32x4 c0v = acc[ai][0][m][0], c1v = acc[ai][0][m][1], r0v = acc[ai][1][m][0], r1v = acc[ai][1][m][1];
                        f32x4 gr0, gr1, rt0, rt1;
#pragma unroll
                        for (int j = 0; j < 4; ++j) {
                            gr0[j] = sigmoidf_(r0v[j] + br0[j]); gr1[j] = sigmoidf_(r1v[j] + br1[j]);
                            rt0[j] = sigmoidf_(c0v[j] + bc0[j]) * __builtin_amdgcn_rcpf(gr0[j]); rt1[j] = sigmoidf_(c1v[j] + bc1[j]) * __builtin_amdgcn_rcpf(gr1[j]);
                        }
                        const size_t gi = ((((size_t)(pm * 8 + t) * 8 + wid) * 8 + (ai * 4 + m)) * 64 + lane) * 8;
                        u32x4 w; w[0] = cvt_pk_bf16(rt0[0], rt0[1]); w[1] = cvt_pk_bf16(rt0[2], rt0[3]); w[2] = cvt_pk_bf16(rt1[0], rt1[1]); w[3] = cvt_pk_bf16(rt1[2], rt1[3]);
                        *(u32x4*)(g.gates + gi) = w;
                        w[0] = cvt_pk_bf16(gr0[0], gr0[1]); w[1] = cvt_pk_bf16(gr0[2], gr0[3]); w[2] = cvt_pk_bf16(gr1[0], gr1[1]); w[3] = cvt_pk_bf16(gr1[2], gr1[3]);
                        *(u32x4*)(g.gates + (size_t)TG * 1024 + gi) = w;
                    }
            } else {
                const int ldo = (EPI == EPI_PROJ) ? PC : g.N;
#pragma unroll
                for (int ai = 0; ai < 2; ++ai)
#pragma unroll
                    for (int m = 0; m < 4; ++m) {
                        bf16_t* o = (bf16_t*)g.out + (size_t)(r0 + ai * 128 + m * 16) * ldo + c0;
#pragma unroll
                        for (int bj = 0; bj < 2; ++bj) {
                            const f32x4 v0 = acc[ai][bj][m][0], v1 = acc[ai][bj][m][1];
                            u32x4 w; w[0] = cvt_pk_bf16(v0[0], v0[1]); w[1] = cvt_pk_bf16(v0[2], v0[3]); w[2] = cvt_pk_bf16(v1[0], v1[1]); w[3] = cvt_pk_bf16(v1[2], v1[3]);
                            *(u32x4*)(o + bj * 128) = w;
                        }
                    }
            }
        } else if (EPI == EPI_SWIGLU) {
            const int hc0 = (bcol >> 1) + wc * 32 + fq * 8;
            float rsv[8];
#pragma unroll
            for (int ai = 0; ai < 2; ++ai)
#pragma unroll
                for (int m = 0; m < 4; ++m) {
                    const f32x4 q = (halfu && ai == 1) ? (f32x4){1024.f, 0.f, 0.f, 0.f} : *(const f32x4*)(g.rowss + (size_t)(r0 + ai * 128 + m * 16) * 4);
                    rsv[ai * 4 + m] = __builtin_amdgcn_rsqf(((q[0] + q[1]) + (q[2] + q[3])) * (1.f / 1024.f) + 1e-6f);
                }
#pragma unroll
            for (int ai = 0; ai < 2; ++ai)
#pragma unroll
                for (int m = 0; m < 4; ++m) {
                    if (halfu && ai == 1) continue;
                    const float rs = rsv[ai * 4 + m], k1 = -1.4426950408889634f * rs, rs2 = rs * rs;
                    bf16_t* o = (bf16_t*)g.out + (size_t)(r0 + ai * 128 + m * 16) * (g.N >> 1) + hc0;
                    const f32x4 g0 = acc[ai][0][m][0], g1 = acc[ai][0][m][1], u0 = acc[ai][1][m][0], u1 = acc[ai][1][m][1];
                    f32x4 h0, h1;
#pragma unroll
                    for (int j = 0; j < 4; ++j) {
                        h0[j] = (g0[j] * u0[j]) * (rs2 * __builtin_amdgcn_rcpf(1.f + __builtin_amdgcn_exp2f(g0[j] * k1)));
                        h1[j] = (g1[j] * u1[j]) * (rs2 * __builtin_amdgcn_rcpf(1.f + __builtin_amdgcn_exp2f(g1[j] * k1)));
                    }
                    u32x4 w; w[0] = cvt_pk_bf16(h0[0], h0[1]); w[1] = cvt_pk_bf16(h0[2], h0[3]); w[2] = cvt_pk_bf16(h1[0], h1[1]); w[3] = cvt_pk_bf16(h1[2], h1[3]);
                    *(u32x4*)o = w;
                }
        } else {
#pragma unroll
            for (int ai = 0; ai < 2; ++ai)
#pragma unroll
                for (int m = 0; m < 4; ++m) {
                    const int row = r0 + ai * 128 + m * 16;
#pragma unroll
                    for (int bj = 0; bj < 2; ++bj) {
                        const f32x4 v0 = acc[ai][bj][m][0], v1 = acc[ai][bj][m][1];
                        const int col = c0 + bj * 128;
                        if (bcol < 1024) {
                            u32x4 w; w[0] = cvt_pk_bf16(v0[0], v0[1]); w[1] = cvt_pk_bf16(v0[2], v0[3]); w[2] = cvt_pk_bf16(v1[0], v1[1]); w[3] = cvt_pk_bf16(v1[2], v1[3]);
                            *(u32x4*)((bf16_t*)g.out + (size_t)row * 1024 + col) = w;
                        } else {
                            const int hh = (col - 1024) >> 8, d = (col - 1024) & 255, lb = row >> 8, mm = row & 255;
                            bf16_t* o = g.out2 + ((size_t)(lb * 4 + hh) * 256 + d) * 256 + mm;
#pragma unroll
                            for (int j = 0; j < 4; ++j) { o[j * 256] = f2bf(v0[j]); o[(j + 4) * 256] = f2bf(v1[j]); }
                        }
                    }
                }
        }
        if (!has_next) break;
        if (!(dual && seg == 0)) {
#pragma unroll
            for (int a = 0; a < 2; ++a)
#pragma unroll
                for (int b = 0; b < 2; ++b)
#pragma unroll
                    for (int m = 0; m < 4; ++m)
#pragma unroll
                        for (int n = 0; n < 2; ++n) acc[a][b][m][n] = (f32x4){0.f, 0.f, 0.f, 0.f};
        }
        pm = npm; pn = npn; seg = nseg; cA = nA; cB = nB; ++ui;
    }
    PG_WAIT_V(0);
    if (wr == 0) PG_BAR;
    PG_BAR;
    if (EPI == EPI_RES) {
        LAS float* P = (LAS float*)lds;
        LAS float* Sr = (LAS float*)(lds + 4096);
        const int brow = pm * BM, bcol = pn * BM;
        const int r0 = brow + wr * 64 + fr, c0 = bcol + wc * 32 + fq * 8, lr0 = wr * 64 + fr;
#pragma unroll
        for (int ai = 0; ai < 2; ++ai)
#pragma unroll
            for (int m = 0; m < 4; ++m) {
                float q = 0.f;
#pragma unroll
                for (int bj = 0; bj < 2; ++bj)
#pragma unroll
                    for (int n = 0; n < 2; ++n) { const f32x4 v = acc[ai][bj][m][n]; q += (v[0] * v[0] + v[1] * v[1]) + (v[2] * v[2] + v[3] * v[3]); }
                q += __shfl_xor(q, 16); q += __shfl_xor(q, 32);
                if (fq == 0) P[(ai * 128 + lr0 + m * 16) * 4 + wc] = q;
            }
        __syncthreads();
        unsigned* xb = (unsigned*)g.xbuf + (size_t)pm * 1024;
        unsigned* cn = g.cnt + (size_t)pm * 64;
        if (tid < 256) {
            const float tot = (P[tid * 4] + P[tid * 4 + 1]) + (P[tid * 4 + 2] + P[tid * 4 + 3]);
            __hip_atomic_store(xb + tid * 4 + pn, __float_as_uint(tot), __ATOMIC_RELAXED, __HIP_MEMORY_SCOPE_AGENT);
        }
        asm volatile("s_waitcnt vmcnt(0)" ::: "memory");
        __syncthreads();
        if (tid == 0) {
            (void)__hip_atomic_fetch_add(cn, 1u, __ATOMIC_RELAXED, __HIP_MEMORY_SCOPE_AGENT);
            unsigned sp = 0;
            while (__hip_atomic_load(cn, __ATOMIC_RELAXED, __HIP_MEMORY_SCOPE_AGENT) < g.expect) { __builtin_amdgcn_s_sleep(1); if (++sp > (1u << 22)) break; }
        }
        __syncthreads();
        if (tid < 256) {
            unsigned* xu = xb + tid * 4;
            const float t0 = __uint_as_float(__hip_atomic_load(xu + 0, __ATOMIC_RELAXED, __HIP_MEMORY_SCOPE_AGENT)), t1 = __uint_as_float(__hip_atomic_load(xu + 1, __ATOMIC_RELAXED, __HIP_MEMORY_SCOPE_AGENT));
            const float t2 = __uint_as_float(__hip_atomic_load(xu + 2, __ATOMIC_RELAXED, __HIP_MEMORY_SCOPE_AGENT)), t3 = __uint_as_float(__hip_atomic_load(xu + 3, __ATOMIC_RELAXED, __HIP_MEMORY_SCOPE_AGENT));
            Sr[tid] = g.scale / sqrtf(((t0 + t1) + (t2 + t3)) * (1.f / 1024.f) + 1e-6f);
        }
        __syncthreads();
        f32x4 gp[2][2];
#pragma unroll
        for (int bj = 0; bj < 2; ++bj)
#pragma unroll
            for (int n = 0; n < 2; ++n) gp[bj][n] = *(const f32x4*)(g.gpost + c0 + bj * 128 + n * 4);
        const bool fin = (g.outf != nullptr);
#pragma unroll
        for (int ai = 0; ai < 2; ++ai) {
            u32x4 xwv[4][2];
#pragma unroll
            for (int m = 0; m < 4; ++m)
#pragma unroll
                for (int bj = 0; bj < 2; ++bj) xwv[m][bj] = *(const u32x4*)(g.XB + (size_t)(r0 + ai * 128 + m * 16) * 1024 + c0 + bj * 128);
#pragma unroll
            for (int m = 0; m < 4; ++m) {
                const float av = Sr[ai * 128 + lr0 + m * 16];
                bf16_t* xr = g.XB + (size_t)(r0 + ai * 128 + m * 16) * 1024 + c0;
                float q = 0.f;
#pragma unroll
                for (int bj = 0; bj < 2; ++bj) {
                    const u32x4 xw = xwv[m][bj];
                    f32x4 v0 = acc[ai][bj][m][0] * av * gp[bj][0], v1 = acc[ai][bj][m][1] * av * gp[bj][1];
                    v0[0] += bflo(xw[0]); v0[1] += bfhi(xw[0]); v0[2] += bflo(xw[1]); v0[3] += bfhi(xw[1]);
                    v1[0] += bflo(xw[2]); v1[1] += bfhi(xw[2]); v1[2] += bflo(xw[3]); v1[3] += bfhi(xw[3]);
                    q += ((v0[0] * v0[0] + v0[1] * v0[1]) + (v0[2] * v0[2] + v0[3] * v0[3])) + ((v1[0] * v1[0] + v1[1] * v1[1]) + (v1[2] * v1[2] + v1[3] * v1[3]));
                    if (fin) {
                        float* orow = g.outf + (size_t)(r0 + ai * 128 + m * 16) * 1024 + c0 + bj * 128;
                        *(f32x4*)orow = v0; *(f32x4*)(orow + 4) = v1;
                    } else {
                        u32x4 w; w[0] = cvt_pk_bf16(v0[0], v0[1]); w[1] = cvt_pk_bf16(v0[2], v0[3]); w[2] = cvt_pk_bf16(v1[0], v1[1]); w[3] = cvt_pk_bf16(v1[2], v1[3]);
                        *(u32x4*)(xr + bj * 128) = w;
                    }
                }
                q += __shfl_xor(q, 16); q += __shfl_xor(q, 32);
                if (fq == 0) P[(ai * 128 + lr0 + m * 16) * 4 + wc] = q;
            }
        }
        __syncthreads();
        if (tid < 256) g.rowss_out[(size_t)(brow + tid) * 4 + pn] = (P[tid * 4] + P[tid * 4 + 1]) + (P[tid * 4 + 2] + P[tid * 4 + 3]);
    }
#undef PG_SA
#undef PG_SB
#undef PG_STAGE
#undef PG_LDA
#undef PG_LDB
#undef PG_MMA
#undef PG_NEXT
#undef PG_ABASE
#undef PG_BBASE
}

DEV void transpose_mat(const float* __restrict__ src, const int K, const int N, bf16_t* __restrict__ dst, const int perm, const float scale, const float* __restrict__ kscale) {
    float* tile = (float*)g_lds;
    const int nkt = K / 64, ntile = nkt * (N / 64), tid = TIDX, bid = BIDX;
    for (int t = bid; t < ntile; t += gridDim.x) {
        const int rt = t / nkt, kt = t - rt * nkt, rho0 = rt * 64;
        const int rg = rho0 - 3072;
        const int cbase = (perm == 1) ? (((rho0 & 255) >> 7) * 2816 + (rho0 >> 8) * 128 + (rho0 & 127)) : ((perm == 2 && rg >= 0) ? (3072 + ((rg & 255) >> 7) * 1024 + (rg >> 8) * 128 + (rg & 127)) : rho0);
        __syncthreads();
#pragma unroll
        for (int i = 0; i < 8; ++i) { const int kk = (tid >> 6) + 8 * i, cc = tid & 63; tile[kk * 65 + cc] = src[(size_t)(kt * 64 + kk) * N + cbase + cc] * (kscale ? kscale[kt * 64 + kk] : 1.0f); }
        __syncthreads();
#pragma unroll
        for (int i = 0; i < 4; ++i) {
            const int rr = (tid >> 5) + 16 * i, k2 = (tid & 31) * 2;
            const int r32 = rr & 31, cc = (rr & 32) + 8 * ((r32 & 15) >> 2) + 4 * (r32 >> 4) + (r32 & 3);
            *(unsigned*)(dst + (size_t)(rho0 + rr) * K + kt * 64 + k2) = cvt_pk_bf16(tile[k2 * 65 + cc] * scale, tile[(k2 + 1) * 65 + cc] * scale);
        }
    }
}

DEV void setup_phase(const Params& p) {
    bf16_t* wt = (bf16_t*)(p.ws + WS_WT);
    for (int l = 0; l < 2; ++l) {
        bf16_t* w = wt + (size_t)l * WL;
        const float* ngl = p.in[4] + (size_t)l * 8 * 1024;
        transpose_mat(p.in[5] + (size_t)l * 1024 * 5632, 1024, 5632, w + O_GU1, 1, 1.f, ngl + 0 * 1024);
        transpose_mat(p.in[6] + (size_t)l * 2816 * 1024, 2816, 1024, w + O_D1, 0, 1.f, nullptr);
        transpose_mat(p.in[7] + (size_t)l * 1024 * 5120, 1024, 5120, w + O_IN, 2, 1.f, ngl + 2 * 1024);
        transpose_mat(p.in[12] + (size_t)l * 512 * 1024, 512, 1024, w + O_PW, 0, 1.f, nullptr);
        transpose_mat(p.in[16] + (size_t)l * 512 * 1024, 512, 1024, w + O_RO, 0, 1.f, nullptr);
        transpose_mat(p.in[18] + (size_t)l * 1024 * 1024, 1024, 1024, w + O_MIX, 0, 1.f, nullptr);
        transpose_mat(p.in[20] + (size_t)l * 1024 * 1024, 1024, 1024, w + O_Q, 0, 0.0625f, ngl + 4 * 1024);
        transpose_mat(p.in[21] + (size_t)l * 1024 * 2048, 1024, 2048, w + O_KV, 0, 1.f, nullptr);
        transpose_mat(p.in[22] + (size_t)l * 1024 * 1024, 1024, 1024, w + O_O, 0, 1.f, nullptr);
        transpose_mat(p.in[23] + (size_t)l * 1024 * 5632, 1024, 5632, w + O_GU2, 1, 1.f, ngl + 6 * 1024);
        transpose_mat(p.in[24] + (size_t)l * 2816 * 1024, 2816, 1024, w + O_D2, 0, 1.f, nullptr);
    }
    float2* rot = (float2*)(p.ws + WS_ROT);
    const int tid0 = TIDX, bid0 = BIDX;
    for (int idx = bid0 * NTHREADS + tid0; idx < 16384 * 32; idx += gridDim.x * NTHREADS) {
        const int pos = idx >> 5, i = idx & 31;
        const float ang = (float)pos * p.inv_freq[i];
        double rev = (double)ang * 0.15915494309189535;
        rev -= floor(rev);
        const float fr = (float)rev;
        rot[idx] = make_float2(__builtin_amdgcn_cosf(fr), __builtin_amdgcn_sinf(fr));
    }
    bf16_t* memn = (bf16_t*)(p.ws + WS_MEMN);
    const int lane = tid0 & 63, gw = bid0 * 8 + (tid0 >> 6), nw = gridDim.x * 8;
    for (int rr = gw; rr < 2 * 2304; rr += nw) {
        const int l = rr / 2304, row = rr - l * 2304;
        const float* src = row < 2048 ? p.in[2] + (size_t)row * 1024 : p.in[3] + (size_t)(row - 2048) * 1024;
        const float* mg = p.in[19] + l * 1024;
        f32x4 x[4]; float ss = 0.f;
#pragma unroll
        for (int i = 0; i < 4; ++i) { x[i] = *(const f32x4*)(src + i * 256 + lane * 4); ss += x[i][0] * x[i][0] + x[i][1] * x[i][1] + x[i][2] * x[i][2] + x[i][3] * x[i][3]; }
        ss = wave_sum(ss);
        const float r = 1.0f / sqrtf(ss * (1.f / 1024.f) + 1e-6f);
#pragma unroll
        for (int i = 0; i < 4; ++i) {
            const f32x4 gg = *(const f32x4*)(mg + i * 256 + lane * 4);
            u32x2 w; w[0] = cvt_pk_bf16(x[i][0] * r * gg[0], x[i][1] * r * gg[1]); w[1] = cvt_pk_bf16(x[i][2] * r * gg[2], x[i][3] * r * gg[3]);
            *(u32x2*)(memn + (size_t)rr * 1024 + i * 256 + lane * 4) = w;
        }
    }
}

DEV void rw0_phase(const float* __restrict__ Xsrc, bf16_t* __restrict__ XB, float* __restrict__ rowss) {
    const int tid0 = TIDX, bid0 = BIDX;
    const int lane = tid0 & 63, gw = bid0 * 8 + (tid0 >> 6), nw = gridDim.x * 8;
    for (int row = gw; row < TG; row += nw) {
        f32x4 x[4]; float ss = 0.f;
#pragma unroll
        for (int i = 0; i < 4; ++i) { x[i] = *(const f32x4*)(Xsrc + (size_t)row * 1024 + i * 256 + lane * 4); ss += x[i][0] * x[i][0] + x[i][1] * x[i][1] + x[i][2] * x[i][2] + x[i][3] * x[i][3]; }
        ss = wave_sum(ss);
#pragma unroll
        for (int i = 0; i < 4; ++i) {
            u32x2 w; w[0] = cvt_pk_bf16(x[i][0], x[i][1]); w[1] = cvt_pk_bf16(x[i][2], x[i][3]);
            *(u32x2*)(XB + (size_t)row * 1024 + i * 256 + lane * 4) = w;
        }
        if (lane == 0) *(f32x4*)(rowss + (size_t)row * 4) = (f32x4){ss, 0.f, 0.f, 0.f};
    }
}

typedef float f32x2 __attribute__((ext_vector_type(2)));
DEV void conv_phase(const bf16_t* __restrict__ PROJ, bf16_t* __restrict__ CV, const float* __restrict__ dw_w, const float* __restrict__ dw_b,
                    const float* __restrict__ ln_g, const float* __restrict__ ln_b, const int S) {
    bf16_t* us = (bf16_t*)g_lds;
    float* red = (float*)(g_lds + 62 * 512 * 2);
    float* stat = red + 4 * 32 * 2;
    const int tid = TIDX, bid = BIDX, wid = tid >> 6, lane = tid & 63;
    const int c2 = (tid & 255) * 2, th = tid >> 8;
    f32x2 w2[31];
#pragma unroll
    for (int k = 0; k < 31; ++k) w2[k] = *(const f32x2*)(dw_w + k * 512 + c2);
    const f32x2 bias2 = *(const f32x2*)(dw_b + c2), lg2 = *(const f32x2*)(ln_g + c2), lb2 = *(const f32x2*)(ln_b + c2);
    for (int u = bid; u < TG / 32; u += gridDim.x) {
        const int t0 = u * 32, seq = t0 / S, pos0 = t0 - seq * S;
        __syncthreads();
        const int cg8 = (tid & 63) * 8;
#pragma unroll
        for (int it = 0; it < 8; ++it) {
            const int tt = it * 8 + (tid >> 6);
            if (tt < 62) {
                const int pos = pos0 - 15 + tt;
                u32x4 o = {0u, 0u, 0u, 0u};
                if (pos >= 0 && pos < S) {
                    const bf16_t* pr = PROJ + (size_t)(seq * S + pos) * PC;
                    const u32x4 v = *(const u32x4*)(pr + cg8), gt = *(const u32x4*)(pr + 512 + cg8);
#pragma unroll
                    for (int q = 0; q < 4; ++q) o[q] = cvt_pk_bf16(bflo(v[q]) * sigmoidf_(bflo(gt[q])), bfhi(v[q]) * sigmoidf_(bfhi(gt[q])));
                }
                *(u32x4*)(us + tt * 512 + cg8) = o;
            }
        }
        __syncthreads();
        f32x2 acc[16];
#pragma unroll
        for (int s2 = 0; s2 < 16; ++s2) acc[s2] = bias2;
#pragma unroll
        for (int kk = 0; kk < 46; ++kk) {
            const unsigned raw = *(const unsigned*)(us + (th * 16 + kk) * 512 + c2);
            const f32x2 uv = {bflo(raw), bfhi(raw)};
#pragma unroll
            for (int s2 = 0; s2 < 16; ++s2) { const int k = kk - s2; if (k >= 0 && k < 31) acc[s2] += w2[k] * uv; }
        }
#pragma unroll
        for (int s2 = 0; s2 < 16; ++s2) {
            const float s1 = wave_sum(acc[s2][0] + acc[s2][1]), sq = wave_sum(acc[s2][0] * acc[s2][0] + acc[s2][1] * acc[s2][1]);
            if (lane == 0) { red[((wid & 3) * 32 + th * 16 + s2) * 2] = s1; red[((wid & 3) * 32 + th * 16 + s2) * 2 + 1] = sq; }
        }
        __syncthreads();
        if (tid < 32) {
            float s1 = 0.f, sq = 0.f;
#pragma unroll
            for (int q = 0; q < 4; ++q) { s1 += red[(q * 32 + tid) * 2]; sq += red[(q * 32 + tid) * 2 + 1]; }
            const float mean = s1 * (1.f / 512.f), var = fmaxf(sq * (1.f / 512.f) - mean * mean, 0.f);
            stat[tid * 2] = mean; stat[tid * 2 + 1] = 1.0f / sqrtf(var + 1e-6f);
        }
        __syncthreads();
#pragma unroll
        for (int s2 = 0; s2 < 16; ++s2) {
            const float mean = stat[(th * 16 + s2) * 2], rstd = stat[(th * 16 + s2) * 2 + 1];
            const float y0 = (acc[s2][0] - mean) * rstd * lg2[0] + lb2[0], y1 = (acc[s2][1] - mean) * rstd * lg2[1] + lb2[1];
            *(unsigned*)(CV + (size_t)(t0 + th * 16 + s2) * 512 + c2) = cvt_pk_bf16(siluf_(y0), siluf_(y1));
        }
    }
}

template <int I> DEV float bfel(const u32x4& v) { return (I & 1) ? bfhi(v[I >> 1]) : bflo(v[I >> 1]); }

DEV void r1_phase(const bf16_t* __restrict__ PROJ, const float2* __restrict__ rot, float* __restrict__ KVST,
                  const float* __restrict__ dec_f, const float* __restrict__ dec_b, const int S) {
    bf16_t* vT = (bf16_t*)g_lds; bf16_t* kTf = vT + 64 * 136; bf16_t* kTb = kTf + 64 * 136;
    const int tid = TIDX, bid = BIDX, wid = tid >> 6, lane = tid & 63, fr = lane & 15, fq = lane >> 4;
    const int j = tid >> 2, js = j ^ ((tid & 3) << 4), dq = (tid & 3) * 8, e0 = (tid & 3) * 16;
    const int nunits = (TG / 128) * 8;
    u32x4 k1, k2, v1, v2; f32x4 rc[4];
    if (bid < nunits) {
        const int cidx = bid >> 3, h = bid & 7, t0 = cidx * 128, seq = t0 / S, pos0 = t0 - seq * S;
        const bf16_t* pr = PROJ + (size_t)(t0 + j) * PC;
        k1 = *(const u32x4*)(pr + C_K + h * 64 + dq); k2 = *(const u32x4*)(pr + C_K + h * 64 + 32 + dq);
        v1 = *(const u32x4*)(pr + C_V + h * 64 + e0); v2 = *(const u32x4*)(pr + C_V + h * 64 + e0 + 8);
        const f32x4* rp = (const f32x4*)(rot + (size_t)(pos0 + j) * 32 + dq);
#pragma unroll
        for (int i = 0; i < 4; ++i) rc[i] = rp[i];
    }
    for (int unit = bid; unit < nunits; unit += gridDim.x) {
        const int cidx = unit >> 3, h = unit & 7;
        const float lgf2 = -expf(dec_f[h]) * 1.4426950408889634f, lgb2 = -expf(dec_b[h]) * 1.4426950408889634f;
        __syncthreads();
        const float df = __builtin_amdgcn_exp2f(lgf2 * (float)(127 - j)), db = __builtin_amdgcn_exp2f(lgb2 * (float)j);
#pragma unroll
        for (int i = 0; i < 8; ++i) {
            const float a = (i & 1) ? bfhi(k1[i >> 1]) : bflo(k1[i >> 1]), b = (i & 1) ? bfhi(k2[i >> 1]) : bflo(k2[i >> 1]);
            const float cx = rc[i >> 1][(i & 1) * 2], cy = rc[i >> 1][(i & 1) * 2 + 1];
            const float r1 = (a * cx - b * cy) * 0.125f, r2 = (a * cy + b * cx) * 0.125f;
            kTf[(dq + i) * 136 + js] = f2bf(r1 * df); kTf[(32 + dq + i) * 136 + js] = f2bf(r2 * df);
            kTb[(dq + i) * 136 + js] = f2bf(r1 * db); kTb[(32 + dq + i) * 136 + js] = f2bf(r2 * db);
        }
#pragma unroll
        for (int i = 0; i < 4; ++i) {
            vT[(e0 + 2 * i) * 136 + js] = (bf16_t)(v1[i] & 0xffffu); vT[(e0 + 2 * i + 1) * 136 + js] = (bf16_t)(v1[i] >> 16);
            vT[(e0 + 8 + 2 * i) * 136 + js] = (bf16_t)(v2[i] & 0xffffu); vT[(e0 + 8 + 2 * i + 1) * 136 + js] = (bf16_t)(v2[i] >> 16);
        }
        {
            const int un = unit + gridDim.x;
            if (un < nunits) {
                const int cn = un >> 3, hn = un & 7, t0n = cn * 128, seqn = t0n / S, pos0n = t0n - seqn * S;
                const bf16_t* pr = PROJ + (size_t)(t0n + j) * PC;
                k1 = *(const u32x4*)(pr + C_K + hn * 64 + dq); k2 = *(const u32x4*)(pr + C_K + hn * 64 + 32 + dq);
                v1 = *(const u32x4*)(pr + C_V + hn * 64 + e0); v2 = *(const u32x4*)(pr + C_V + hn * 64 + e0 + 8);
                const f32x4* rp = (const f32x4*)(rot + (size_t)(pos0n + j) * 32 + dq);
#pragma unroll
                for (int i = 0; i < 4; ++i) rc[i] = rp[i];
            }
        }
        __syncthreads();
        const int dir = wid >> 2, et = wid & 3;
        const bf16_t* kT = dir ? kTb : kTf;
        bf16x8 a[4];
#pragma unroll
        for (int ks = 0; ks < 4; ++ks) a[ks] = *(const bf16x8*)(vT + (et * 16 + fr) * 136 + ((ks * 32 + fq * 8) ^ (et << 4)));
        float* o = KVST + ((size_t)(cidx * 8 + h) * 2 + dir) * 4096;
#pragma unroll
        for (int dt = 0; dt < 4; ++dt) {
            f32x4 acc = {0.f, 0.f, 0.f, 0.f};
#pragma unroll
            for (int ks = 0; ks < 4; ++ks) {
                const bf16x8 b = *(const bf16x8*)(kT + (dt * 16 + fr) * 136 + ((ks * 32 + fq * 8) ^ ((((dt * 16 + fr) >> 3) & 3) << 4)));
                acc = __builtin_amdgcn_mfma_f32_16x16x32_bf16(a[ks], b, acc, 0, 0, 0);
            }
#pragma unroll
            for (int jj = 0; jj < 4; ++jj) o[(et * 16 + fq * 4 + jj) * 64 + dt * 16 + fr] = acc[jj];
        }
    }
}

DEV void r2_phase(const float* __restrict__ KVST, bf16_t* __restrict__ PREV, const float* __restrict__ dec_f, const float* __restrict__ dec_b, const int S) {
    const int NC = S / 128, nseq = TG / S, total = nseq * 8 * 2 * 4096;
    const int tid0 = TIDX, bid0 = BIDX;
    for (int idx = bid0 * NTHREADS + tid0; idx < total; idx += gridDim.x * NTHREADS) {
        const int elem = idx & 4095, dir = (idx >> 12) & 1, h = (idx >> 13) & 7, seq = idx >> 16;
        const float lg = -expf((dir ? dec_b : dec_f)[h]);
        const float cd = expf(lg * 128.f);
        float st = 0.f;
        const size_t cstride = (size_t)8 * 2 * 4096;
        const size_t base = ((size_t)(seq * NC) * 8 + h) * 2 * 4096 + (size_t)dir * 4096 + elem;
#pragma unroll 1
        for (int n0 = 0; n0 < NC; n0 += 32) {
            float kv[32];
#pragma unroll
            for (int i = 0; i < 32; ++i) { const int nn = dir ? NC - 1 - (n0 + i) : n0 + i; kv[i] = KVST[base + (size_t)nn * cstride]; }
#pragma unroll
            for (int i = 0; i < 32; ++i) { const int nn = dir ? NC - 1 - (n0 + i) : n0 + i; PREV[base + (size_t)nn * cstride] = f2bf(st); st = st * cd + kv[i]; }
        }
    }
}

DEV void r3_phase(const bf16_t* __restrict__ PROJ, const float2* __restrict__ rot, const bf16_t* __restrict__ PREV, bf16_t* __restrict__ RT,
                  const float* __restrict__ dec_f, const float* __restrict__ dec_b, const float* __restrict__ gn_g, const int S) {
    bf16_t* Qs = (bf16_t*)g_lds; bf16_t* Ks = Qs + 128 * 72; bf16_t* vT = Ks + 128 * 72;
    const int tid = TIDX, bid = BIDX, wid = tid >> 6, lane = tid & 63, fr = lane & 15, fq = lane >> 4;
    const int j = tid >> 2, js = j ^ ((tid & 3) << 4), dq = (tid & 3) * 8;
    for (int unit = bid; unit < (TG / 128) * 8; unit += gridDim.x) {
        const int cidx = unit >> 3, h = unit & 7, t0 = cidx * 128, seq = t0 / S, pos0 = t0 - seq * S;
        const float lgf2 = -expf(dec_f[h]) * 1.4426950408889634f, lgb2 = -expf(dec_b[h]) * 1.4426950408889634f;
        const bf16_t* pf = PREV + ((size_t)(cidx * 8 + h) * 2) * 4096;
        const bf16_t* pb = pf + 4096;
        bf16x8 paf[4][2], pab[4][2]; u32x2 ggv[4];
#pragma unroll
        for (int et = 0; et < 4; ++et) {
#pragma unroll
            for (int ks = 0; ks < 2; ++ks) {
                paf[et][ks] = *(const bf16x8*)(pf + (et * 16 + fr) * 64 + ks * 32 + fq * 8);
                pab[et][ks] = *(const bf16x8*)(pb + (et * 16 + fr) * 64 + ks * 32 + fq * 8);
            }
            ggv[et] = *(const u32x2*)(PROJ + (size_t)(t0 + wid * 16 + fr) * PC + C_G + h * 64 + et * 16 + fq * 4);
        }
        __syncthreads();
        {
            const bf16_t* pr = PROJ + (size_t)(t0 + j) * PC;
            const u32x4 q1 = *(const u32x4*)(pr + C_Q + h * 64 + dq), q2 = *(const u32x4*)(pr + C_Q + h * 64 + 32 + dq);
            const u32x4 k1 = *(const u32x4*)(pr + C_K + h * 64 + dq), k2 = *(const u32x4*)(pr + C_K + h * 64 + 32 + dq);
            const float2* rp = rot + (size_t)(pos0 + j) * 32 + dq;
            u32x4 oq1, oq2, ok1, ok2;
#pragma unroll
            for (int i = 0; i < 4; ++i) {
                const float2 c0 = rp[2 * i], c1 = rp[2 * i + 1];
                const float qa0 = bflo(q1[i]), qa1 = bfhi(q1[i]), qb0 = bflo(q2[i]), qb1 = bfhi(q2[i]);
                const float ka0 = bflo(k1[i]), ka1 = bfhi(k1[i]), kb0 = bflo(k2[i]), kb1 = bfhi(k2[i]);
                oq1[i] = cvt_pk_bf16(qa0 * c0.x - qb0 * c0.y, qa1 * c1.x - qb1 * c1.y);
                oq2[i] = cvt_pk_bf16(qa0 * c0.y + qb0 * c0.x, qa1 * c1.y + qb1 * c1.x);
                ok1[i] = cvt_pk_bf16((ka0 * c0.x - kb0 * c0.y) * 0.125f, (ka1 * c1.x - kb1 * c1.y) * 0.125f);
                ok2[i] = cvt_pk_bf16((ka0 * c0.y + kb0 * c0.x) * 0.125f, (ka1 * c1.y + kb1 * c1.x) * 0.125f);
            }
            *(u32x4*)(Qs + j * 72 + dq) = oq1; *(u32x4*)(Qs + j * 72 + 32 + dq) = oq2;
            *(u32x4*)(Ks + j * 72 + dq) = ok1; *(u32x4*)(Ks + j * 72 + 32 + dq) = ok2;
            const int e0 = (tid & 3) * 16;
            const u32x4 v1 = *(const u32x4*)(pr + C_V + h * 64 + e0), v2 = *(const u32x4*)(pr + C_V + h * 64 + e0 + 8);
#pragma unroll
            for (int i = 0; i < 4; ++i) {
                vT[(e0 + 2 * i) * 136 + js] = (bf16_t)(v1[i] & 0xffffu); vT[(e0 + 2 * i + 1) * 136 + js] = (bf16_t)(v1[i] >> 16);
                vT[(e0 + 8 + 2 * i) * 136 + js] = (bf16_t)(v2[i] & 0xffffu); vT[(e0 + 8 + 2 * i + 1) * 136 + js] = (bf16_t)(v2[i] >> 16);
            }
        }
        __syncthreads();
        const int i0 = wid * 16, ii = i0 + fr;
        bf16x8 bq[2];
#pragma unroll
        for (int ks = 0; ks < 2; ++ks) bq[ks] = *(const bf16x8*)(Qs + (i0 + fr) * 72 + ks * 32 + fq * 8);
        f32x4 s[8];
#pragma unroll
        for (int jt = 0; jt < 8; ++jt) {
            s[jt] = (f32x4){0.f, 0.f, 0.f, 0.f};
#pragma unroll
            for (int ks = 0; ks < 2; ++ks) {
                const bf16x8 a = *(const bf16x8*)(Ks + (jt * 16 + fr) * 72 + ks * 32 + fq * 8);
                s[jt] = __builtin_amdgcn_mfma_f32_16x16x32_bf16(a, bq[ks], s[jt], 0, 0, 0);
            }
#pragma unroll
            for (int jj = 0; jj < 4; ++jj) {
                const int delta = ii - (jt * 16 + fq * 4 + jj);
                const float fac = __builtin_amdgcn_exp2f(delta >= 0 ? lgf2 * (float)delta : lgb2 * (float)(-delta));
                s[jt][jj] *= fac;
            }
        }
        bf16x8 bp[4];
#pragma unroll
        for (int k2 = 0; k2 < 4; ++k2) {
            u32x4 w; w[0] = cvt_pk_bf16(s[2 * k2][0], s[2 * k2][1]); w[1] = cvt_pk_bf16(s[2 * k2][2], s[2 * k2][3]);
            w[2] = cvt_pk_bf16(s[2 * k2 + 1][0], s[2 * k2 + 1][1]); w[3] = cvt_pk_bf16(s[2 * k2 + 1][2], s[2 * k2 + 1][3]);
            bp[k2] = __builtin_bit_cast(bf16x8, w);
        }
        const float qf = __builtin_amdgcn_exp2f(lgf2 * (float)(ii + 1)), qb = __builtin_amdgcn_exp2f(lgb2 * (float)(128 - ii));
        f32x4 o[4];
#pragma unroll
        for (int et = 0; et < 4; ++et) {
            o[et] = (f32x4){0.f, 0.f, 0.f, 0.f};
#pragma unroll
            for (int k2 = 0; k2 < 4; ++k2) {
                const u32x2 lo = *(const u32x2*)(vT + (et * 16 + fr) * 136 + (((2 * k2) * 16 + fq * 4) ^ (et << 4)));
                const u32x2 hi = *(const u32x2*)(vT + (et * 16 + fr) * 136 + (((2 * k2 + 1) * 16 + fq * 4) ^ (et << 4)));
                u32x4 w; w[0] = lo[0]; w[1] = lo[1]; w[2] = hi[0]; w[3] = hi[1];
                o[et] = __builtin_amdgcn_mfma_f32_16x16x32_bf16(__builtin_bit_cast(bf16x8, w), bp[k2], o[et], 0, 0, 0);
            }
            f32x4 cf = {0.f, 0.f, 0.f, 0.f}, cb = {0.f, 0.f, 0.f, 0.f};
#pragma unroll
            for (int ks = 0; ks < 2; ++ks) {
                cf = __builtin_amdgcn_mfma_f32_16x16x32_bf16(paf[et][ks], bq[ks], cf, 0, 0, 0);
                cb = __builtin_amdgcn_mfma_f32_16x16x32_bf16(pab[et][ks], bq[ks], cb, 0, 0, 0);
            }
            o[et] += cf * qf + cb * qb;
        }
        float sum = 0.f;
#pragma unroll
        for (int et = 0; et < 4; ++et) sum += (o[et][0] + o[et][1]) + (o[et][2] + o[et][3]);
        sum += __shfl_xor(sum, 16); sum += __shfl_xor(sum, 32);
        const float mu = sum * (1.f / 64.f);
        float vs = 0.f;
#pragma unroll
        for (int et = 0; et < 4; ++et) { const f32x4 d = o[et] - mu; vs += (d[0] * d[0] + d[1] * d[1]) + (d[2] * d[2] + d[3] * d[3]); }
        vs += __shfl_xor(vs, 16); vs += __shfl_xor(vs, 32);
        const float rstd = __builtin_amdgcn_rsqf(vs * (1.f / 64.f) + 1e-6f);
        const size_t tok = (size_t)(t0 + ii);
#pragma unroll
        for (int et = 0; et < 4; ++et) {
            const int e = et * 16 + fq * 4;
            const u32x2 gg = ggv[et];
            const f32x4 gn = *(const f32x4*)(gn_g + h * 64 + e);
            const f32x4 y = (o[et] - mu) * rstd * gn;
            u32x2 w; w[0] = cvt_pk_bf16(siluf_(bflo(gg[0])) * y[0], siluf_(bfhi(gg[0])) * y[1]); w[1] = cvt_pk_bf16(siluf_(bflo(gg[1])) * y[2], siluf_(bfhi(gg[1])) * y[3]);
            *(u32x2*)(RT + tok * 512 + h * 64 + e) = w;
        }
    }
}

DEV int att_sw(int key) { return (key & 3) | ((key >> 1) & 12); }
DEV void attn_phase(const bf16_t* __restrict__ Q, const bf16_t* __restrict__ Kmem, const bf16_t* __restrict__ VmemT, bf16_t* __restrict__ O, const int S, const int g, const int nM, const int nN) {
    LAS unsigned char* lds = (LAS unsigned char*)g_lds;
    const int tid = TIDX, bid = BIDX, wid = tid >> 6, lane = tid & 63, fr = lane & 15, fq = lane >> 4;
    const int wu = __builtin_amdgcn_readfirstlane(wid);
    const int nwg = nM * nN;
    for (int L = bid; L < nwg; L += gridDim.x) {
        int wgid = L; { const int q = nwg / NXCD, r = nwg % NXCD, xcd = wgid % NXCD, off = wgid / NXCD; wgid = (xcd < r ? xcd * (q + 1) : r * (q + 1) + (xcd - r) * q) + off; }
        const int WGM = (nN > 4) ? WGM_BIG : WGM_SMALL, nig = WGM * nN, gid = wgid / nig, fm = gid * WGM, gsz = (nM - fm) < WGM ? (nM - fm) : WGM;
        const int qb = fm + ((wgid % nig) % gsz), h = (wgid % nig) / gsz;
        const int t0 = qb * 256, seq = t0 / S, b = (g < 2) ? g * 4 + seq : 8;
        const bf16_t* kb = Kmem + (size_t)(b * 256) * 1024 + h * 256;
        const bf16_t* vb = VmemT + ((size_t)(b * 4 + h) * 256) * 256;
        const size_t tok0 = (size_t)(t0 + wid * 16 + fr), tok1 = tok0 + 128;
        f32x4 s[2][16];
#pragma unroll
        for (int mt = 0; mt < 16; ++mt) { s[0][mt] = (f32x4){0.f, 0.f, 0.f, 0.f}; s[1][mt] = (f32x4){0.f, 0.f, 0.f, 0.f}; }
        __syncthreads();
        {
            const bf16_t* src = kb + (size_t)(tid >> 4) * 1024 + (((tid & 15) ^ att_sw(tid >> 4)) * 8);
#pragma unroll 1
            for (int i = 0; i < 16; ++i)
                __builtin_amdgcn_global_load_lds((const unsigned*)(src + (size_t)(i & 7) * 32768 + (i >> 3) * 128), (LAS unsigned*)(lds + (i >> 3) * 65536 + wu * 1024 + (i & 7) * 8192), 16, 0, 0);
        }
#pragma unroll 1
        for (int half = 0; half < 2; ++half) {
            bf16x8 bq[2][4];
#pragma unroll
            for (int ks = 0; ks < 4; ++ks) {
                bq[0][ks] = *(const bf16x8*)(Q + tok0 * 1024 + h * 256 + half * 128 + ks * 32 + fq * 8);
                bq[1][ks] = *(const bf16x8*)(Q + tok1 * 1024 + h * 256 + half * 128 + ks * 32 + fq * 8);
            }
            if (half == 0) { asm volatile("s_waitcnt vmcnt(0)" ::: "memory"); __syncthreads(); }
            LAS unsigned char* kbuf = lds + half * 65536;
#pragma unroll
            for (int mt = 0; mt < 16; ++mt) {
                const int key = 32 * (mt >> 1) + (fr >> 2) * 8 + (mt & 1) * 4 + (fr & 3);
#pragma unroll
                for (int ks = 0; ks < 4; ++ks) {
                    const bf16x8 a = *(const LAS bf16x8*)(kbuf + key * 256 + (((ks * 4 + fq) ^ fr) << 4));
                    s[0][mt] = __builtin_amdgcn_mfma_f32_16x16x32_bf16(a, bq[0][ks], s[0][mt], 0, 0, 0);
                    s[1][mt] = __builtin_amdgcn_mfma_f32_16x16x32_bf16(a, bq[1][ks], s[1][mt], 0, 0, 0);
                }
            }
        }
        __syncthreads();
        {
            const bf16_t* src = vb + (size_t)(tid >> 5) * 256 + (((tid & 31) ^ ((tid >> 5) & 15)) * 8);
#pragma unroll 1
            for (int i = 0; i < 16; ++i)
                __builtin_amdgcn_global_load_lds((const unsigned*)(src + (size_t)(i & 7) * 4096 + (size_t)(i >> 3) * 32768), (LAS unsigned*)(lds + (i >> 3) * 65536 + wu * 1024 + (i & 7) * 8192), 16, 0, 0);
        }
        bf16x8 bp[2][8]; float il[2];
#pragma unroll
        for (int qs = 0; qs < 2; ++qs) {
            float mx = -3.0e38f;
#pragma unroll
            for (int mt = 0; mt < 16; ++mt) mx = fmaxf(mx, fmaxf(fmaxf(s[qs][mt][0], s[qs][mt][1]), fmaxf(s[qs][mt][2], s[qs][mt][3])));
            mx = fmaxf(mx, __shfl_xor(mx, 16)); mx = fmaxf(mx, __shfl_xor(mx, 32));
            float l = 0.f;
#pragma unroll
            for (int mt = 0; mt < 16; ++mt) {
#pragma unroll
                for (int jj = 0; jj < 4; ++jj) { const float pv = __expf(s[qs][mt][jj] - mx); s[qs][mt][jj] = pv; l += pv; }
            }
            l += __shfl_xor(l, 16); l += __shfl_xor(l, 32);
            il[qs] = 1.0f / l;
#pragma unroll
            for (int k2 = 0; k2 < 8; ++k2) {
                u32x4 w; w[0] = cvt_pk_bf16(s[qs][2 * k2][0], s[qs][2 * k2][1]); w[1] = cvt_pk_bf16(s[qs][2 * k2][2], s[qs][2 * k2][3]);
                w[2] = cvt_pk_bf16(s[qs][2 * k2 + 1][0], s[qs][2 * k2 + 1][1]); w[3] = cvt_pk_bf16(s[qs][2 * k2 + 1][2], s[qs][2 * k2 + 1][3]);
                bp[qs][k2] = __builtin_bit_cast(bf16x8, w);
            }
        }
        asm volatile("s_waitcnt vmcnt(0)" ::: "memory");
        __syncthreads();
#pragma unroll 1
        for (int half = 0; half < 2; ++half) {
            LAS unsigned char* vbuf = lds + half * 65536;
#pragma unroll
            for (int dt = 0; dt < 8; ++dt) {
                f32x4 o0 = {0.f, 0.f, 0.f, 0.f}, o1 = {0.f, 0.f, 0.f, 0.f};
#pragma unroll
                for (int k2 = 0; k2 < 8; ++k2) {
                    const bf16x8 a = *(const LAS bf16x8*)(vbuf + (dt * 16 + fr) * 512 + (((k2 * 4 + fq) ^ fr) << 4));
                    o0 = __builtin_amdgcn_mfma_f32_16x16x32_bf16(a, bp[0][k2], o0, 0, 0, 0);
                    o1 = __builtin_amdgcn_mfma_f32_16x16x32_bf16(a, bp[1][k2], o1, 0, 0, 0);
                }
                const int dcol = h * 256 + half * 128 + dt * 16 + fq * 4;
                u32x2 w; w[0] = cvt_pk_bf16(o0[0] * il[0], o0[1] * il[0]); w[1] = cvt_pk_bf16(o0[2] * il[0], o0[3] * il[0]);
                *(u32x2*)(O + tok0 * 1024 + dcol) = w;
                w[0] = cvt_pk_bf16(o1[0] * il[1], o1[1] * il[1]); w[1] = cvt_pk_bf16(o1[2] * il[1], o1[3] * il[1]);
                *(u32x2*)(O + tok1 * 1024 + dcol) = w;
            }
        }
    }
}

#define XB_TMO      128
#define XB_XCNT(j)  (256  + 64 * (j))
#define XB_XSUB(j)  (1280 + 64 * (j))
#define XB_XGEN(j)  (2304 + 64 * (j))
#define XB_TOP      3328
#define XB_TOPGEN   3392
#define XCD_BAR_WORDS 3456
#define XB_SPIN_CAP (1u << 22)
DEV unsigned xb_ld(unsigned* p)              { return __hip_atomic_load(p, __ATOMIC_RELAXED, __HIP_MEMORY_SCOPE_AGENT); }
DEV unsigned xb_add(unsigned* p, unsigned v) { return __hip_atomic_fetch_add(p, v, __ATOMIC_RELAXED, __HIP_MEMORY_SCOPE_AGENT); }
DEV unsigned xb_xcc_id() { return (unsigned)__builtin_amdgcn_s_getreg((3 << 11) | 20) & 0xFu; }
#define XB_SPIN(cond, bar) do { unsigned _sp = 0; while (cond) { __builtin_amdgcn_s_sleep(1); \
    if ((++_sp & 255u) == 0u) { if (xb_ld(&(bar)[XB_TMO])) break; if (_sp > XB_SPIN_CAP) { atomicAdd(&(bar)[XB_TMO], 1u); break; } } } } while (0)
struct XcdBarrier { unsigned* bar; unsigned x; volatile LAS unsigned* st; };
DEV XcdBarrier xcd_barrier_post(unsigned* bar, volatile LAS unsigned* st) {
    XcdBarrier b; b.bar = bar; b.x = xb_xcc_id(); b.st = st;
    if (threadIdx.x == 0) (void)xb_add(&bar[XB_XCNT(b.x)], 1u);
    return b;
}
DEV void xcd_barrier_complete(unsigned* bar, unsigned x, unsigned& nloc, unsigned& nx) {
    const unsigned G = gridDim.x * gridDim.y * gridDim.z;
    unsigned sum, cnt, mine, sp = 0u;
    for (;;) {
        sum = 0u; cnt = 0u; mine = 0u;
#pragma unroll
        for (unsigned j = 0; j < 16; ++j) { const unsigned c = xb_ld(&bar[XB_XCNT(j)]); sum += c; cnt += (c > 0u) ? 1u : 0u; mine = (j == x) ? c : mine; }
        if (sum == G) break;
        __builtin_amdgcn_s_sleep(1);
        if ((++sp & 255u) == 0u) { if (xb_ld(&bar[XB_TMO])) break; if (sp > XB_SPIN_CAP) { atomicAdd(&bar[XB_TMO], 1u); break; } }
    }
    nloc = mine > 0u ? mine : 1u; nx = cnt > 0u ? cnt : 1u;
}
DEV void xcd_barrier(const XcdBarrier& b) {
    asm volatile("s_waitcnt vmcnt(0)" ::: "memory");
    __syncthreads();
    if (threadIdx.x == 0) {
        unsigned* bar = b.bar;
        __builtin_amdgcn_s_waitcnt(0);
        unsigned nloc = b.st[0], nx = b.st[1];
        if (nloc == 0u) { xcd_barrier_complete(bar, b.x, nloc, nx); b.st[0] = nloc; b.st[1] = nx; }
        const unsigned old = xb_add(&bar[XB_XSUB(b.x)], 1u);
        const unsigned gen = old / nloc;
        if (old + 1u == (gen + 1u) * nloc) {
            __builtin_amdgcn_fence(__ATOMIC_RELEASE, "agent");
            asm volatile("s_waitcnt vmcnt(0)" ::: "memory");
            const unsigned og = xb_add(&bar[XB_TOP], 1u);
            const unsigned tg = og / nx;
            if (og + 1u == (tg + 1u) * nx) xb_add(&bar[XB_TOPGEN], 1u);
            else XB_SPIN(xb_ld(&bar[XB_TOPGEN]) == tg, bar);
            __builtin_amdgcn_fence(__ATOMIC_ACQUIRE, "agent");
            xb_add(&bar[XB_XGEN(b.x)], 1u);
            asm volatile("s_waitcnt vmcnt(0)" ::: "memory");
        } else {
            XB_SPIN(xb_ld(&bar[XB_XGEN(b.x)]) == gen, bar);
            __builtin_amdgcn_fence(__ATOMIC_ACQUIRE, "agent");
            asm volatile("s_waitcnt vmcnt(0)" ::: "memory");
        }
    }
    __syncthreads();
}

constexpr int PH_PER_GROUP = 25, N_PHASES = 2 + NGRP * PH_PER_GROUP;

DEV void run_phase(const Params& p, const int ph) {
    unsigned char* ws = p.ws;
    if (ph == 0) {
#if PROBE == 9
        setup_phase(p);
#endif
        setup_phase(p); return; }
    bf16_t* H = (bf16_t*)(ws + WS_H); bf16_t* HID = (bf16_t*)(ws + WS_HID); bf16_t* PROJ = (bf16_t*)(ws + WS_PROJ);
    bf16_t* MIXB = (bf16_t*)(ws + WS_MIXB); bf16_t* QB = (bf16_t*)(ws + WS_QB); bf16_t* OB = (bf16_t*)(ws + WS_OB);
    bf16_t* CV = (bf16_t*)(ws + WS_CV); bf16_t* RT = (bf16_t*)(ws + WS_RT);
    float* KVST = (float*)(ws + WS_KVST); bf16_t* PREV = (bf16_t*)(ws + WS_PREV);
    const float2* rot = (const float2*)(ws + WS_ROT);
    GemmDesc gd{};
    int kind = 0;
    int g = 0, l = 0, s = 0;
    if (ph == 1) {
        gd.A = (const bf16_t*)(ws + WS_MEMN); gd.Bt = (const bf16_t*)(ws + WS_WT) + O_KV; gd.M = 2 * 2304; gd.N = 2048; gd.K = 1024; gd.epi = EPI_KV;
        gd.out = ws + WS_KMEM; gd.out2 = (bf16_t*)(ws + WS_VMEMT); gd.bt_layer_stride = WL;
    } else {
        const int idx = ph - 2; g = idx / PH_PER_GROUP; const int r = idx - g * PH_PER_GROUP;
        if (r < 13) { l = 0; s = r; } else { l = 1; s = r - 12; }
    }
    const int S = (g < 2) ? 4096 : 16384;
    const bf16_t* W = (const bf16_t*)(ws + WS_WT) + (size_t)l * WL;
    const float* ng = p.in[4] + (size_t)l * 8 * 1024;
    const float* xin = (g < 2) ? p.in[0] + (size_t)g * TG * 1024 : p.in[1];
    float* OUT = p.out + (size_t)g * TG * 1024;
    float* rowss = (float*)(ws + WS_ROWSS);
    int fk = -1;
    if (ph >= 2) {
        gd.M = TG; gd.XB = H; gd.xbuf = (float*)(ws + WS_XBUF); gd.cnt = (unsigned*)(ws + WS_CNT); gd.rowss = rowss; gd.rowss_out = rowss;
        switch (s) {
        case 0: kind = 1; break;
        case 1: gd.A = H; gd.Bt = W + O_GU1; gd.N = 5632; gd.K = 1024; gd.epi = EPI_SWIGLU; gd.out = HID; break;
        case 2: gd.A = HID; gd.Bt = W + O_D1; gd.N = 1024; gd.K = 2816; gd.epi = EPI_RES; fk = 0; gd.scale = 0.5f; gd.gpost = ng + 1 * 1024; break;
        case 3: gd.A = H; gd.Bt = W + O_IN; gd.N = 5120; gd.K = 1024; gd.epi = EPI_PROJ; gd.out = PROJ; gd.gate_b = p.in[17] + (size_t)l * 2048; gd.gates = (bf16_t*)(ws + WS_GATES); break;
        case 4: kind = 2; break;
        case 5: kind = 3; break;
        case 6: kind = 4; break;
        case 7: gd.A = CV; gd.Bt = W + O_PW; gd.N = 1024; gd.K = 512; gd.epi = EPI_MIX; gd.out = MIXB; gd.A2 = RT; gd.Bt2 = W + O_RO; gd.K2 = 512; gd.gates = (bf16_t*)(ws + WS_GATES); break;
        case 8: gd.A = MIXB; gd.Bt = W + O_MIX; gd.N = 1024; gd.K = 1024; gd.epi = EPI_RES; fk = 1; gd.scale = 1.f; gd.gpost = ng + 3 * 1024; break;
        case 9: gd.A = H; gd.Bt = W + O_Q; gd.N = 1024; gd.K = 1024; gd.epi = EPI_BF16; gd.out = QB; break;
        case 10: gd.A = OB; gd.Bt = W + O_O; gd.N = 1024; gd.K = 1024; gd.epi = EPI_RES; fk = 2; gd.scale = 1.f; gd.gpost = ng + 5 * 1024; break;
        case 11: gd.A = H; gd.Bt = W + O_GU2; gd.N = 5632; gd.K = 1024; gd.epi = EPI_SWIGLU; gd.out = HID; break;
        default: gd.A = HID; gd.Bt = W + O_D2; gd.N = 1024; gd.K = 2816; gd.epi = EPI_RES; fk = 3; gd.scale = 0.5f; gd.gpost = ng + 7 * 1024; gd.outf = (l == 1) ? OUT : nullptr; break;
        }
        gd.expect = 4u * (unsigned)(g * 8 + l * 4 + fk + 1);
    }
    if (kind == 0) {
        switch (gd.epi) {
        case EPI_RES: gemm_phase<EPI_RES>(gd); break;
        case EPI_BF16:
#if PROBE == 12
            gemm_phase<EPI_BF16>(gd);
#endif
            gemm_phase<EPI_BF16>(gd);
            asm volatile("s_waitcnt vmcnt(0)" ::: "memory");
            __syncthreads();
            __builtin_amdgcn_fence(__ATOMIC_ACQUIRE, "agent");
            asm volatile("s_waitcnt vmcnt(0)" ::: "memory");
            attn_phase(QB, (const bf16_t*)(ws + WS_KMEM) + (size_t)l * 2304 * 1024, (const bf16_t*)(ws + WS_VMEMT) + (size_t)l * 2304 * 1024, OB, S, g, TG / 256, 4);
            break;
        case EPI_SWIGLU:
#if PROBE == 6
            for (int rep = 0; rep < 2; ++rep)
#endif
            gemm_phase<EPI_SWIGLU>(gd);
#if PROBE == 10
            gemm_phase<7>(gd);
#endif
            break;
        case EPI_PROJ:
#if PROBE == 7
            for (int rep = 0; rep < 2; ++rep)
#endif
            gemm_phase<EPI_PROJ>(gd); break;
        case EPI_MIX:
#if PROBE == 13
            gemm_phase<EPI_MIX>(gd);
#endif
            gemm_phase<EPI_MIX>(gd); break;
        default: gemm_phase<EPI_KV>(gd); break;
        }
        if (ph == 1) rw0_phase(p.in[0], H, rowss);
    }
    else if (kind == 1) { if (g > 0) rw0_phase(xin, H, rowss); }
    else if (kind == 2) {
        conv_phase(PROJ, CV, p.in[8] + (size_t)l * 31 * 512, p.in[9] + l * 512, p.in[10] + l * 512, p.in[11] + l * 512, S);
        r1_phase(PROJ, rot, KVST, p.in[13] + l * 8, p.in[14] + l * 8, S);
    } else if (kind == 3) {
#if PROBE == 11
        r2_phase(KVST, PREV, p.in[13] + l * 8, p.in[14] + l * 8, S);
#endif
        r2_phase(KVST, PREV, p.in[13] + l * 8, p.in[14] + l * 8, S);
    }
    else r3_phase(PROJ, rot, PREV, RT, p.in[13] + l * 8, p.in[14] + l * 8, p.in[15] + l * 512, S);
}

#ifndef PROBE_MASK
#define PROBE_MASK 0
#endif
__global__ void __launch_bounds__(NTHREADS) mega(const Params p) {
#if SINGLE_LAUNCH
    volatile LAS unsigned* st = (volatile LAS unsigned*)((LAS unsigned char*)g_lds + 131072);
    if (threadIdx.x == 0) { st[0] = 0u; st[1] = 0u; }
    __syncthreads();
    const XcdBarrier xb = xcd_barrier_post((unsigned*)(p.ws + WS_BAR), st);
#endif
#if PROBE_MASK
    unsigned long long t_prev = __builtin_amdgcn_s_memrealtime(), t_acc = 0ull;
#endif
    for (int ph = p.ph_begin; ph < p.ph_end; ++ph) {
        run_phase(p, ph);
#if SINGLE_LAUNCH
        if (ph + 1 < p.ph_end) {
            if (p.ph_begin > p.ph_end) cg::this_grid().sync();
            xcd_barrier(xb);
        }
#endif
#if PROBE_MASK
        {
            const unsigned long long t_now = __builtin_amdgcn_s_memrealtime();
            int slot;
            if (ph < 2) slot = 14 + ph; else { const int r = (ph - 2) % PH_PER_GROUP; slot = (r < 13) ? r : r - 12; }
            if ((PROBE_MASK >> slot) & 1) t_acc += t_now - t_prev;
            t_prev = t_now;
        }
#endif
    }
#if PROBE_MASK
    if (blockIdx.x == 0 && threadIdx.x == 0) {
        const unsigned long long t0 = __builtin_amdgcn_s_memrealtime();
        while (__builtin_amdgcn_s_memrealtime() - t0 < t_acc) __builtin_amdgcn_s_sleep(8);
    }
#endif
}

extern "C" void kernel_launch(void* const* d_in, const int* in_sizes, int n_in, void* d_out, int out_size, void* d_ws, size_t ws_size, hipStream_t stream) {
    static int grid = 0;
    if (grid == 0) {
        if (n_in != 25 || ws_size < WS_END) { fprintf(stderr, "kernel_launch: need 25 inputs and >= %zu bytes of workspace (got %d, %zu)\n", (size_t)WS_END, n_in, ws_size); grid = -1; return; }
        int dev = 0, cus = 0, per_cu = 0;
        hipGetDevice(&dev);
        hipDeviceGetAttribute(&cus, hipDeviceAttributeMultiprocessorCount, dev);
        if (hipFuncSetAttribute((const void*)mega, hipFuncAttributeMaxDynamicSharedMemorySize, LDS_BYTES) != hipSuccess) { fprintf(stderr, "kernel_launch: hipFuncSetAttribute failed\n"); grid = -1; return; }
        hipOccupancyMaxActiveBlocksPerMultiprocessor(&per_cu, (const void*)mega, NTHREADS, LDS_BYTES);
        if (per_cu < 1) per_cu = 1;
        (void)hipGetLastError();
        grid = cus * 1;
    }
    if (grid < 0) return;
    Params p{};
    for (int i = 0; i < 25; ++i) p.in[i] = (const float*)d_in[i];
    p.out = (float*)d_out; p.ws = (unsigned char*)d_ws;
    for (int i = 0; i < 32; ++i) p.inv_freq[i] = (float)pow(10000.0, -(double)i / 32.0);
#if SINGLE_LAUNCH
    p.ph_begin = 0; p.ph_end = N_PHASES;
    hipMemsetAsync((unsigned char*)d_ws + WS_BAR, 0, 16384 + 32768, stream);
    void* args[] = {&p};
    hipError_t e = hipLaunchCooperativeKernel((const void*)mega, dim3(grid), dim3(NTHREADS), args, LDS_BYTES, stream);
    if (e != hipSuccess) fprintf(stderr, "cooperative launch failed: %s (grid %d)\n", hipGetErrorString(e), grid);
#else
    for (int ph = 0; ph < N_PHASES; ++ph) {
        p.ph_begin = ph; p.ph_end = ph + 1;
        hipLaunchKernelGGL(mega, dim3(grid), dim3(NTHREADS), LDS_BYTES, stream, p);
    }
#endif
}
```
